# Optimizing an MI355X kernel written in HIP

```python
import math
import jax, jax.numpy as jnp
from jax import lax
import numpy as np

D_MODEL = 1024
BATCH = 8
SEQ = 4096
DEPTH = 2

GRID_W = 64
Q_BLOCK = 128
HEAD_DIM = 64
N_HEADS_A = 8
N_KV_A = 2
N_HEADS_B = 4
MLA_Q_RANK = 192
MLA_KV_RANK = 128
MLA_NOPE = 64
MLA_ROPE = 32
MLA_V = 64
N_HEADS_C = 4
DIFF_QK = 32
DIFF_V = 64
D_FF = 2816
CONV_W = 3
ROPE_BASE = 10000.0
EPS = 1e-6
A_WIDTH = N_HEADS_A * HEAD_DIM + 2 * N_KV_A * HEAD_DIM
B_WIDTH = MLA_Q_RANK + MLA_KV_RANK + MLA_ROPE
C_WIDTH = 2 * N_HEADS_C * 2 * DIFF_QK + N_HEADS_C * DIFF_V
IN_WIDTH = A_WIDTH + B_WIDTH + C_WIDTH
MIX_WIDTH = N_HEADS_A * HEAD_DIM + N_HEADS_B * MLA_V + N_HEADS_C * DIFF_V

kernel_name = 'hybrid_parallel_heads_encoder'


def rmsnorm(x, g):
    xf = x.astype(jnp.float32)
    y = xf * lax.rsqrt(jnp.mean(xf * xf, axis=-1, keepdims=True) + EPS)
    return (y * g.astype(jnp.float32)).astype(x.dtype)


def softmax_f32(logits, scale, dtype):
    return jax.nn.softmax(logits.astype(jnp.float32) * scale, axis=-1).astype(dtype)


def axial_rope_tables(rows, cols, dim):
    nf = dim // 4
    inv = ROPE_BASE ** (-jnp.arange(nf, dtype=jnp.float32) / nf)
    ar = rows.astype(jnp.float32)[:, None] * inv
    ac = cols.astype(jnp.float32)[:, None] * inv
    return (jnp.cos(ar), jnp.sin(ar), jnp.cos(ac), jnp.sin(ac))


def _rotate(v, c, s):
    h = v.shape[-1] // 2
    v1, v2 = v[..., :h], v[..., h:]
    return jnp.concatenate([v1 * c - v2 * s, v2 * c + v1 * s], axis=-1)


def apply_axial_rope(x, tabs):
    S = x.shape[1]
    shp = (S,) + (1,) * (x.ndim - 3) + (-1,)
    cr, sr, cc, sc = [t.reshape(shp) for t in tabs]
    xf = x.astype(jnp.float32)
    half = x.shape[-1] // 2
    out = jnp.concatenate([_rotate(xf[..., :half], cr, sr), _rotate(xf[..., half:], cc, sc)], axis=-1)
    return out.astype(x.dtype)


def to_blocks(x):
    B, S = x.shape[:2]
    return jnp.moveaxis(x.reshape((B, S // Q_BLOCK, Q_BLOCK) + x.shape[2:]), 1, 0)


def from_blocks(o):
    nb, B, blk = o.shape[:3]
    return jnp.moveaxis(o, 0, 1).reshape((B, nb * blk) + o.shape[3:])


def gqa_axial_mixer(qa, ka, va, q_gain, k_gain, tabs):
    B, S, _ = qa.shape
    G = N_HEADS_A // N_KV_A
    q = apply_axial_rope(rmsnorm(qa.reshape(B, S, N_HEADS_A, HEAD_DIM), q_gain), tabs)
    k = apply_axial_rope(rmsnorm(ka.reshape(B, S, N_KV_A, HEAD_DIM), k_gain), tabs)
    v = va.reshape(B, S, N_KV_A, HEAD_DIM)
    scale = HEAD_DIM ** -0.5

    def block(qb):
        qg = qb.reshape(qb.shape[0], Q_BLOCK, N_KV_A, G, HEAD_DIM)
        logits = jnp.einsum('bqkgd,bskd->bkgqs', qg, k)
        p = softmax_f32(logits, scale, v.dtype)
        o = jnp.einsum('bkgqs,bskd->bqkgd', p, v)
        return o.reshape(qb.shape[0], Q_BLOCK, N_HEADS_A * HEAD_DIM)

    return from_blocks(lax.map(block, to_blocks(q)))


def mla_mixer(cq, ckv, kr, q_gain, w_uq, kv_gain, w_ukv, tabs):
    B, S, _ = cq.shape
    q = (rmsnorm(cq, q_gain) @ w_uq).reshape(B, S, N_HEADS_B, MLA_NOPE + MLA_ROPE)
    qn = q[..., :MLA_NOPE]
    qr = apply_axial_rope(q[..., MLA_NOPE:], tabs)
    kv = (rmsnorm(ckv, kv_gain) @ w_ukv).reshape(B, S, N_HEADS_B, MLA_NOPE + MLA_V)
    kn, v = kv[..., :MLA_NOPE], kv[..., MLA_NOPE:]
    kr = apply_axial_rope(kr, tabs)
    scale = (MLA_NOPE + MLA_ROPE) ** -0.5

    def block(args):
        qnb, qrb = args
        logits = jnp.einsum('bqhd,bshd->bhqs', qnb, kn) + jnp.einsum('bqhr,bsr->bhqs', qrb, kr)
        p = softmax_f32(logits, scale, v.dtype)
        return jnp.einsum('bhqs,bshe->bqhe', p, v)

    o = from_blocks(lax.map(block, (to_blocks(qn), to_blocks(qr))))
    return o.reshape(B, S, N_HEADS_B * MLA_V)


def diff_alibi_mixer(qc, kc, vc, lq1, lk1, lq2, lk2, subln, lam_init, pos):
    B, S, _ = qc.shape
    q = qc.reshape(B, S, N_HEADS_C, 2, DIFF_QK)
    k = kc.reshape(B, S, N_HEADS_C, 2, DIFF_QK)
    v = vc.reshape(B, S, N_HEADS_C, DIFF_V)
    f32 = jnp.float32
    lam = (jnp.exp(jnp.sum(lq1.astype(f32) * lk1.astype(f32)))
           - jnp.exp(jnp.sum(lq2.astype(f32) * lk2.astype(f32))) + lam_init)
    slopes = 2.0 ** (-8.0 * jnp.arange(1, N_HEADS_C + 1, dtype=f32) / N_HEADS_C)
    scale = DIFF_QK ** -0.5

    def block(args):
        qb, qp = args
        logits = jnp.einsum('bqhid,bshid->bhiqs', qb, k).astype(f32) * scale
        bias = -slopes[:, None, None, None] * jnp.abs(qp[:, None] - pos[None, :])[None, None]
        p = jax.nn.softmax(logits + bias, axis=-1)
        a = (p[:, :, 0] - lam * p[:, :, 1]).astype(v.dtype)
        return jnp.einsum('bhqs,bshe->bqhe', a, v)

    o = from_blocks(lax.map(block, (to_blocks(q), pos.reshape(S // Q_BLOCK, Q_BLOCK))))
    o = rmsnorm(o, subln) * (1.0 - lam_init)
    return o.reshape(B, S, N_HEADS_C * DIFF_V)


def conv_gated_mlp(h, w_up, conv_w, conv_b, w_down):
    u = h @ w_up
    up = jnp.pad(u, ((0, 0), (1, 1), (0, 0)))
    u = up[:, :-2] * conv_w[0] + up[:, 1:-1] * conv_w[1] + up[:, 2:] * conv_w[2] + conv_b
    g, val = u[..., :D_FF], u[..., D_FF:]
    return (jax.nn.silu(g) * val) @ w_down


def setup_inputs(seed: int = 0) -> dict:
    key = jax.random.key(seed)
    ks = jax.random.split(key, 21)

    def nrm(k, shape, scale):
        return scale * jax.random.normal(k, shape, jnp.float32)

    def gain(k, shape):
        return 1.0 + 0.02 * jax.random.normal(k, shape, jnp.float32)

    L = DEPTH
    return dict(
        x=jax.random.normal(ks[0], (BATCH, SEQ, D_MODEL), jnp.float32),
        norm_attn=gain(ks[1], (L, D_MODEL)),
        w_in=nrm(ks[2], (L, D_MODEL, IN_WIDTH), D_MODEL ** -0.5),
        q_norm_a=gain(ks[3], (L, HEAD_DIM)),
        k_norm_a=gain(ks[4], (L, HEAD_DIM)),
        q_a_norm_b=gain(ks[5], (L, MLA_Q_RANK)),
        w_uq_b=nrm(ks[6], (L, MLA_Q_RANK, N_HEADS_B * (MLA_NOPE + MLA_ROPE)), MLA_Q_RANK ** -0.5),
        kv_a_norm_b=gain(ks[7], (L, MLA_KV_RANK)),
        w_ukv_b=nrm(ks[8], (L, MLA_KV_RANK, N_HEADS_B * (MLA_NOPE + MLA_V)), MLA_KV_RANK ** -0.5),
        lambda_q1_c=nrm(ks[9], (L, DIFF_QK), 0.1),
        lambda_k1_c=nrm(ks[10], (L, DIFF_QK), 0.1),
        lambda_q2_c=nrm(ks[11], (L, DIFF_QK), 0.1),
        lambda_k2_c=nrm(ks[12], (L, DIFF_QK), 0.1),
        subln_c=gain(ks[13], (L, DIFF_V)),
        w_out=nrm(ks[14], (L, MIX_WIDTH, D_MODEL), MIX_WIDTH ** -0.5),
        norm_ffn=gain(ks[15], (L, D_MODEL)),
        w_up=nrm(ks[16], (L, D_MODEL, 2 * D_FF), D_MODEL ** -0.5),
        conv_w=nrm(ks[17], (L, CONV_W, 2 * D_FF), CONV_W ** -0.5),
        conv_b=nrm(ks[18], (L, 2 * D_FF), 0.01),
        w_down=nrm(ks[19], (L, D_FF, D_MODEL), D_FF ** -0.5),
        final_norm=gain(ks[20], (D_MODEL,)),
    )


def reference(x, norm_attn, w_in, q_norm_a, k_norm_a, q_a_norm_b, w_uq_b, kv_a_norm_b, w_ukv_b,
              lambda_q1_c, lambda_k1_c, lambda_q2_c, lambda_k2_c, subln_c, w_out,
              norm_ffn, w_up, conv_w, conv_b, w_down, final_norm):
    B, S, _ = x.shape
    ROWS = S // GRID_W
    rows = jnp.repeat(jnp.arange(ROWS, dtype=jnp.int32), GRID_W)
    cols = jnp.tile(jnp.arange(GRID_W, dtype=jnp.int32), ROWS)
    tabs_a = axial_rope_tables(rows, cols, HEAD_DIM)
    tabs_b = axial_rope_tables(rows, cols, MLA_ROPE)
    pos = jnp.arange(S, dtype=jnp.float32)
    sizes = [N_HEADS_A * HEAD_DIM, N_KV_A * HEAD_DIM, N_KV_A * HEAD_DIM,
             MLA_Q_RANK, MLA_KV_RANK, MLA_ROPE,
             N_HEADS_C * 2 * DIFF_QK, N_HEADS_C * 2 * DIFF_QK, N_HEADS_C * DIFF_V]
    splits = [int(c) for c in np.cumsum(sizes)[:-1]]

    for l in range(DEPTH):
        lam_init = 0.8 - 0.6 * math.exp(-0.3 * l)
        h = rmsnorm(x, norm_attn[l])
        z = h @ w_in[l]
        qa, ka, va, cq, ckv, kr, qc, kc, vc = jnp.split(z, splits, axis=-1)
        o_a = gqa_axial_mixer(qa, ka, va, q_norm_a[l], k_norm_a[l], tabs_a)
        o_b = mla_mixer(cq, ckv, kr, q_a_norm_b[l], w_uq_b[l], kv_a_norm_b[l], w_ukv_b[l], tabs_b)
        o_c = diff_alibi_mixer(qc, kc, vc, lambda_q1_c[l], lambda_k1_c[l], lambda_q2_c[l],
                               lambda_k2_c[l], subln_c[l], lam_init, pos)
        x = x + jnp.concatenate([o_a, o_b, o_c], axis=-1) @ w_out[l]
        h = rmsnorm(x, norm_ffn[l])
        x = x + conv_gated_mlp(h, w_up[l], conv_w[l], conv_b[l], w_down[l])

    return rmsnorm(x, final_norm)
```

```cpp
#include <hip/hip_runtime.h>
#include <hip/hip_cooperative_groups.h>
#include <stdint.h>
#include <math.h>
#include <stdio.h>
namespace cg = cooperative_groups;

typedef unsigned short bf16_t;
typedef short bf16x8 __attribute__((ext_vector_type(8)));
typedef short s16x4 __attribute__((ext_vector_type(4)));
typedef float f32x4 __attribute__((ext_vector_type(4)));
typedef float f32x16 __attribute__((ext_vector_type(16)));
typedef unsigned u32x4 __attribute__((ext_vector_type(4)));
typedef unsigned u32x2 __attribute__((ext_vector_type(2)));
typedef __bf16 bf2_t __attribute__((ext_vector_type(2)));
typedef float f32x2 __attribute__((ext_vector_type(2)));
#define DI __device__ __forceinline__

constexpr int M_TOK = 32768, SEQ = 4096, DM = 1024, INW = 1888, INWP = 1920, DFF = 2816, DFF2 = 5632;
constexpr float EPS = 1e-6f;
constexpr float LOG2E = 1.4426950408889634f;
constexpr int NTHR = 256;

constexpr size_t SZ_WIN = (size_t)2 * INWP * 1024 * 2, SZ_WUQ = (size_t)2 * 384 * 192 * 2, SZ_WUKV = (size_t)2 * 512 * 128 * 2,
                 SZ_WOUT = (size_t)2 * 1024 * 1024 * 2, SZ_WUP = (size_t)2 * DFF2 * 1024 * 2, SZ_WDN = (size_t)2 * 1024 * DFF * 2;
constexpr size_t OFF_WIN = 0, OFF_WUQ = OFF_WIN + SZ_WIN, OFF_WUKV = OFF_WUQ + SZ_WUQ, OFF_WOUT = OFF_WUKV + SZ_WUKV,
                 OFF_WUP = OFF_WOUT + SZ_WOUT, OFF_WDN = OFF_WUP + SZ_WUP, OFF_TAB = OFF_WDN + SZ_WDN, OFF_H = OFF_TAB + 16384;
constexpr size_t OFF_BIG = OFF_H + (size_t)M_TOK * 1024 * 2;
constexpr size_t OFF_Z = OFF_BIG, OFF_QA = OFF_Z + (size_t)M_TOK * INWP * 2, OFF_KA = OFF_QA + (size_t)M_TOK * 512 * 2,
                 OFF_VA = OFF_KA + (size_t)M_TOK * 128 * 2, OFF_CQN = OFF_VA + (size_t)M_TOK * 128 * 2, OFF_CKVN = OFF_CQN + (size_t)M_TOK * 192 * 2,
                 OFF_QB = OFF_CKVN + (size_t)M_TOK * 128 * 2, OFF_KB = OFF_QB + (size_t)M_TOK * 384 * 2, OFF_VB = OFF_KB + (size_t)M_TOK * 384 * 2,
                 OFF_QC = OFF_VB + (size_t)M_TOK * 256 * 2, OFF_KC = OFF_QC + (size_t)M_TOK * 256 * 2, OFF_VC = OFF_KC + (size_t)M_TOK * 256 * 2,
                 OFF_MIX = OFF_VC + (size_t)M_TOK * 256 * 2, OFF_END1 = OFF_MIX + (size_t)M_TOK * 1024 * 2;
constexpr int MH = M_TOK / 2;
constexpr size_t OFF_U = OFF_BIG, OFF_ACT = OFF_U + (size_t)MH * DFF2 * 2, OFF_END2 = OFF_ACT + (size_t)MH * DFF * 2;
static_assert(OFF_END1 <= (size_t)512 * 1024 * 1024 && OFF_END2 <= (size_t)512 * 1024 * 1024, "workspace");

struct Params {
    const float *x, *norm_attn, *w_in, *qn_a, *kn_a, *qan_b, *w_uq, *kvn_b, *w_ukv, *lq1, *lk1, *lq2, *lk2, *subln, *w_out, *norm_ffn, *w_up,
        *conv_w, *conv_b, *w_down, *final_norm;
    float* out;
    unsigned char* ws;
};

DI unsigned pk2(float a, float b) { f32x2 v = {a, b}; bf2_t r = __builtin_convertvector(v, bf2_t); return __builtin_bit_cast(unsigned, r); }
DI void unpack8(u32x4 r, float* v) {
    v[0] = __uint_as_float(r.x << 16); v[1] = __uint_as_float(r.x & 0xffff0000u);
    v[2] = __uint_as_float(r.y << 16); v[3] = __uint_as_float(r.y & 0xffff0000u);
    v[4] = __uint_as_float(r.z << 16); v[5] = __uint_as_float(r.z & 0xffff0000u);
    v[6] = __uint_as_float(r.w << 16); v[7] = __uint_as_float(r.w & 0xffff0000u);
}
DI u32x4 pack8(const float* v) { u32x4 r; r.x = pk2(v[0], v[1]); r.y = pk2(v[2], v[3]); r.z = pk2(v[4], v[5]); r.w = pk2(v[6], v[7]); return r; }
DI int tid_opaque() { int t = threadIdx.x; asm volatile("" : "+v"(t)); return t; }
DI int bid_opaque() { int b = blockIdx.x; asm volatile("" : "+s"(b)); return b; }
DI float wave_sum(float v) {
#pragma unroll
    for (int o = 32; o >= 1; o >>= 1) v += __shfl_xor(v, o);
    return v;
}

DI void prep_weight(const float* __restrict__ W, bf16_t* __restrict__ Wt, int K, int N, int Npad, int gtid, int gthreads) {
    const int total = Npad * (K / 8);
    for (int idx = gtid; idx < total; idx += gthreads) {
        const int n = idx % Npad, kc = idx / Npad;
        float v[8];
#pragma unroll
        for (int j = 0; j < 8; ++j) v[j] = (n < N) ? W[(size_t)(kc * 8 + j) * N + n] : 0.f;
        *(u32x4*)(Wt + (size_t)n * K + kc * 8) = pack8(v);
    }
}

template <bool OUT_F32>
DI void rmsnorm_rows(const float* X, const float* __restrict__ g, bf16_t* H, float* Of) {
    const int tid_ = tid_opaque();
    const int lane = tid_ & 63, gw = bid_opaque() * 4 + (tid_ >> 6), nw = gridDim.x * 4;
    for (int row = gw; row < M_TOK; row += nw) {
        const f32x4* xr = (const f32x4*)(X + (size_t)row * 1024);
        f32x4 v[4];
        float ss = 0.f;
#pragma unroll
        for (int i = 0; i < 4; ++i) { v[i] = xr[lane + 64 * i]; ss += v[i][0] * v[i][0] + v[i][1] * v[i][1] + v[i][2] * v[i][2] + v[i][3] * v[i][3]; }
        ss = wave_sum(ss);
        const float rstd = rsqrtf(ss * (1.0f / 1024.0f) + EPS);
#pragma unroll
        for (int i = 0; i < 4; ++i) {
            const f32x4 gv = ((const f32x4*)g)[lane + 64 * i];
            f32x4 o = v[i] * rstd * gv;
            if (OUT_F32) ((f32x4*)(Of + (size_t)row * 1024))[lane + 64 * i] = o;
            else { u32x2 w; w.x = pk2(o[0], o[1]); w.y = pk2(o[2], o[3]); *(u32x2*)(H + (size_t)row * 1024 + (lane + 64 * i) * 4) = w; }
        }
    }
}

constexpr int GSTR = 144, GOP = 128 * GSTR;
constexpr int SMEM_BYTES = 4 * GOP;

template <class Epi>
DI void gemm_tile(const bf16_t* __restrict__ A, int lda, const bf16_t* __restrict__ Bt, int ldb, int K, int m0, int n0, unsigned char* smem, const Epi& epi) {
    const int tid = tid_opaque(), lane = tid & 63, wid = tid >> 6, wr = wid >> 1, wc = wid & 1;
    const int lrow = tid >> 3, lc = tid & 7;
    const bf16_t* ga = A + (size_t)(m0 + lrow) * lda + lc * 8;
    const bf16_t* gb = Bt + (size_t)(n0 + lrow) * ldb + lc * 8;
    u32x4 ra[4], rb[4];
    f32x4 acc[4][4];
#pragma unroll
    for (int i = 0; i < 4; ++i)
#pragma unroll
        for (int j = 0; j < 4; ++j) acc[i][j] = (f32x4){0.f, 0.f, 0.f, 0.f};
    const int nk = K / 64;
#pragma unroll
    for (int i = 0; i < 4; ++i) { ra[i] = *(const u32x4*)(ga + (size_t)i * 32 * lda); rb[i] = *(const u32x4*)(gb + (size_t)i * 32 * ldb); }
    unsigned char* wbase = smem + lrow * GSTR + lc * 16;
#pragma unroll
    for (int i = 0; i < 4; ++i) { *(u32x4*)(wbase + i * 32 * GSTR) = ra[i]; *(u32x4*)(wbase + GOP + i * 32 * GSTR) = rb[i]; }
    __syncthreads();
    const int foff = (lane & 15) * GSTR + (lane >> 4) * 16;
    for (int kt = 0; kt < nk; ++kt) {
        const unsigned char* cur = smem + (kt & 1) * 2 * GOP;
        const bool more = (kt + 1 < nk);
        if (more) {
#pragma unroll
            for (int i = 0; i < 4; ++i) { ra[i] = *(const u32x4*)(ga + (size_t)i * 32 * lda + (kt + 1) * 64); rb[i] = *(const u32x4*)(gb + (size_t)i * 32 * ldb + (kt + 1) * 64); }
        }
        const unsigned char* sa = cur + wr * 64 * GSTR + foff;
        const unsigned char* sb = cur + GOP + wc * 64 * GSTR + foff;
#pragma unroll
        for (int kk = 0; kk < 2; ++kk) {
            bf16x8 af[4], bfr[4];
#pragma unroll
            for (int i = 0; i < 4; ++i) { af[i] = *(const bf16x8*)(sa + i * 16 * GSTR + kk * 64); bfr[i] = *(const bf16x8*)(sb + i * 16 * GSTR + kk * 64); }
#pragma unroll
            for (int mi = 0; mi < 4; ++mi)
#pragma unroll
                for (int ni = 0; ni < 4; ++ni) acc[mi][ni] = __builtin_amdgcn_mfma_f32_16x16x32_bf16(bfr[ni], af[mi], acc[mi][ni], 0, 0, 0);
        }
        if (more) {
            unsigned char* wb = wbase + ((kt + 1) & 1) * 2 * GOP;
#pragma unroll
            for (int i = 0; i < 4; ++i) { *(u32x4*)(wb + i * 32 * GSTR) = ra[i]; *(u32x4*)(wb + GOP + i * 32 * GSTR) = rb[i]; }
        }
        __syncthreads();
    }
    epi(acc, m0 + wr * 64, n0 + wc * 64, lane);
}

template <class Epi>
DI void gemm_phase(const bf16_t* A, int lda, const bf16_t* Bt, int ldb, int K, int Mrows, int Ncols, unsigned char* smem, const Epi& epi) {
    const int nN = Ncols / 128, ntiles = (Mrows / 128) * nN;
    for (int t = bid_opaque(); t < ntiles; t += gridDim.x) gemm_tile(A, lda, Bt, ldb, K, (t / nN) * 128, (t % nN) * 128, smem, epi);
}

struct EpiStoreBf16 {
    bf16_t* O; int ldo;
    DI void operator()(const f32x4 (&acc)[4][4], int mb, int nb, int lane) const {
#pragma unroll
        for (int mi = 0; mi < 4; ++mi)
#pragma unroll
            for (int ni = 0; ni < 4; ++ni) {
                const int m = mb + mi * 16 + (lane & 15), n = nb + ni * 16 + (lane >> 4) * 4;
                u32x2 w; w.x = pk2(acc[mi][ni][0], acc[mi][ni][1]); w.y = pk2(acc[mi][ni][2], acc[mi][ni][3]);
                *(u32x2*)(O + (size_t)m * ldo + n) = w;
            }
    }
};
struct EpiResid {
    const float* Xin; float* Xout;
    DI void operator()(const f32x4 (&acc)[4][4], int mb, int nb, int lane) const {
#pragma unroll
        for (int mi = 0; mi < 4; ++mi)
#pragma unroll
            for (int ni = 0; ni < 4; ++ni) {
                const size_t o = (size_t)(mb + mi * 16 + (lane & 15)) * 1024 + nb + ni * 16 + (lane >> 4) * 4;
                f32x4 r = *(const f32x4*)(Xin + o);
                r += acc[mi][ni];
                *(f32x4*)(Xout + o) = r;
            }
    }
};
struct EpiMlaQ {
    bf16_t* QB; const float* tab; float qscale;
    DI void operator()(const f32x4 (&acc)[4][4], int mb, int nb, int lane) const {
#pragma unroll
        for (int mi = 0; mi < 4; ++mi)
#pragma unroll
            for (int ni = 0; ni < 4; ++ni) {
                const int m = mb + mi * 16 + (lane & 15), q = lane >> 4, nt = nb + ni * 16;
                const int head = nt / 96, dt = nt - head * 96;
                const int b = m >> 12, s = m & 4095;
                f32x4 v = acc[mi][ni];
                f32x4 pr;
#pragma unroll
                for (int i = 0; i < 4; ++i) pr[i] = __shfl_xor(v[i], 32);
                if (dt >= 64) {
                    const int pos = (dt >= 80) ? (s & 63) : (s >> 6);
                    const float* tc = tab + 2048 + pos * 8 + (q & 1) * 4;
#pragma unroll
                    for (int i = 0; i < 4; ++i) {
                        const float c = tc[i], sn = tc[512 + i];
                        v[i] = (q < 2) ? (v[i] * c - pr[i] * sn) : (v[i] * c + pr[i] * sn);
                    }
                }
                u32x2 w; w.x = pk2(v[0] * qscale, v[1] * qscale); w.y = pk2(v[2] * qscale, v[3] * qscale);
                *(u32x2*)(QB + ((size_t)(b * 4 + head) * SEQ + s) * 96 + dt + q * 4) = w;
            }
    }
};
struct EpiMlaKV {
    bf16_t* KB; bf16_t* VB;
    DI void operator()(const f32x4 (&acc)[4][4], int mb, int nb, int lane) const {
#pragma unroll
        for (int mi = 0; mi < 4; ++mi)
#pragma unroll
            for (int ni = 0; ni < 4; ++ni) {
                const int m = mb + mi * 16 + (lane & 15), n = nb + ni * 16 + (lane >> 4) * 4;
                const int head = n >> 7, d = n & 127, b = m >> 12, s = m & 4095;
                u32x2 w; w.x = pk2(acc[mi][ni][0], acc[mi][ni][1]); w.y = pk2(acc[mi][ni][2], acc[mi][ni][3]);
                const size_t rowi = (size_t)(b * 4 + head) * SEQ + s;
                if (d < 64) *(u32x2*)(KB + rowi * 96 + d) = w;
                else *(u32x2*)(VB + rowi * 64 + (d - 64)) = w;
            }
    }
};

DI void post_phase(const Params& p, int layer, unsigned char* smem) {
    float* zs = (float*)smem;
    float* ssq = zs + INW;
    unsigned char* ws = p.ws;
    const bf16_t* Z = (const bf16_t*)(ws + OFF_Z);
    const float* tab = (const float*)(ws + OFF_TAB);
    bf16_t *QA = (bf16_t*)(ws + OFF_QA), *KA = (bf16_t*)(ws + OFF_KA), *VA = (bf16_t*)(ws + OFF_VA), *CQN = (bf16_t*)(ws + OFF_CQN), *CKVN = (bf16_t*)(ws + OFF_CKVN),
           *KB = (bf16_t*)(ws + OFF_KB), *QC = (bf16_t*)(ws + OFF_QC), *KC = (bf16_t*)(ws + OFF_KC), *VC = (bf16_t*)(ws + OFF_VC);
    const float* gqa = p.qn_a + layer * 64; const float* gka = p.kn_a + layer * 64;
    const float* gqb = p.qan_b + layer * 192; const float* gkvb = p.kvn_b + layer * 128;
    const float qsA = 0.125f * LOG2E, qsC = 0.17677669529663687f * LOG2E;
    const int c = tid_opaque();
    for (int t = bid_opaque(); t < M_TOK; t += gridDim.x) {
        const int b = t >> 12, s = t & 4095, prow = s >> 6, pcol = s & 63;
        float v[8];
        if (c < 236) {
            const u32x4 raw = *(const u32x4*)(Z + (size_t)t * INWP + c * 8);
            unpack8(raw, v);
            float ss = 0.f;
#pragma unroll
            for (int j = 0; j < 8; ++j) { ss += v[j] * v[j]; zs[c * 8 + j] = v[j]; }
            ssq[c] = ss;
        }
        __syncthreads();
        if (c < 80) {
            const bool isq = c < 64;
            const int cl = isq ? c : c - 64, head = cl >> 3, cc = cl & 7;
            const float* g = isq ? gqa : gka;
            float ss = 0.f;
#pragma unroll
            for (int j = 0; j < 8; ++j) ss += ssq[(c & ~7) + j];
            const float rstd = rsqrtf(ss * (1.0f / 64.0f) + EPS);
            const int pos = (cc < 4) ? prow : pcol;
            const float* tc = tab + pos * 16 + (cc & 1) * 8;
            float o[8];
#pragma unroll
            for (int j = 0; j < 8; ++j) {
                const float own = v[j] * rstd * g[cc * 8 + j];
                const float part = zs[(c ^ 2) * 8 + j] * rstd * g[(cc ^ 2) * 8 + j];
                const float cs = tc[j], sn = tc[1024 + j];
                float r = ((cc & 2) == 0) ? (own * cs - part * sn) : (own * cs + part * sn);
                o[j] = isq ? r * qsA : r;
            }
            if (isq) *(u32x4*)(QA + ((size_t)(b * 8 + head) * SEQ + s) * 64 + cc * 8) = pack8(o);
            else *(u32x4*)(KA + ((size_t)(b * 2 + head) * SEQ + s) * 64 + cc * 8) = pack8(o);
        } else if (c < 96) {
            const int cl = c - 80, head = cl >> 3, cc = cl & 7;
            *(u32x4*)(VA + ((size_t)(b * 2 + head) * SEQ + s) * 64 + cc * 8) = pack8(v);
        } else if (c < 120) {
            float ss = 0.f;
            for (int j = 96; j < 120; ++j) ss += ssq[j];
            const float rstd = rsqrtf(ss * (1.0f / 192.0f) + EPS);
            float o[8];
#pragma unroll
            for (int j = 0; j < 8; ++j) o[j] = v[j] * rstd * gqb[(c - 96) * 8 + j];
            *(u32x4*)(CQN + (size_t)t * 192 + (c - 96) * 8) = pack8(o);
        } else if (c < 136) {
            float ss = 0.f;
            for (int j = 120; j < 136; ++j) ss += ssq[j];
            const float rstd = rsqrtf(ss * (1.0f / 128.0f) + EPS);
            float o[8];
#pragma unroll
            for (int j = 0; j < 8; ++j) o[j] = v[j] * rstd * gkvb[(c - 120) * 8 + j];
            *(u32x4*)(CKVN + (size_t)t * 128 + (c - 120) * 8) = pack8(o);
        } else if (c < 140) {
            const int cc = c - 136;
            const int pos = (cc < 2) ? prow : pcol;
            const float* tc = tab + 2048 + pos * 8;
            float o[8];
#pragma unroll
            for (int j = 0; j < 8; ++j) {
                const float own = v[j], part = zs[(c ^ 1) * 8 + j];
                const float cs = tc[j], sn = tc[512 + j];
                o[j] = ((cc & 1) == 0) ? (own * cs - part * sn) : (own * cs + part * sn);
            }
            const u32x4 w = pack8(o);
#pragma unroll
            for (int hh = 0; hh < 4; ++hh) *(u32x4*)(KB + ((size_t)(b * 4 + hh) * SEQ + s) * 96 + 64 + cc * 8) = w;
        } else if (c < 172) {
            const int cl = c - 140, head = cl >> 3, cc = cl & 7;
            float o[8];
#pragma unroll
            for (int j = 0; j < 8; ++j) o[j] = v[j] * qsC;
            *(u32x4*)(QC + ((size_t)(b * 4 + head) * SEQ + s) * 64 + cc * 8) = pack8(o);
        } else if (c < 204) {
            const int cl = c - 172, head = cl >> 3, cc = cl & 7;
            *(u32x4*)(KC + ((size_t)(b * 4 + head) * SEQ + s) * 64 + cc * 8) = pack8(v);
        } else if (c < 236) {
            const int cl = c - 204, head = cl >> 3, cc = cl & 7;
            *(u32x4*)(VC + ((size_t)(b * 4 + head) * SEQ + s) * 64 + cc * 8) = pack8(v);
        }
        __syncthreads();
    }
}

constexpr int ATT_STAGE = 64 * 208 + 8192;

template <int DQK, bool DIFF>
DI void attn_unit(const bf16_t* __restrict__ Qg, const bf16_t* __restrict__ Kg, const bf16_t* __restrict__ Vg, int q0, bf16_t* __restrict__ outp,
                  float slope2, float lam, float outmul, const float* __restrict__ subln, unsigned char* smem) {
    constexpr int NQT = DIFF ? 2 : 1, KS = DIFF ? 2 : DQK / 16, KSTR = DQK * 2 + 16, CPR = DQK / 8, KCH = 64 * CPR / 256, KBYTES = 64 * 208;
    const int tid = tid_opaque(), lane = tid & 63, wid = tid >> 6, r = lane & 31, h = lane >> 5;
    const int qrow = q0 + wid * 32 + r;
    bf16x8 qf[NQT][KS];
#pragma unroll
    for (int qt = 0; qt < NQT; ++qt)
#pragma unroll
        for (int ks = 0; ks < KS; ++ks) qf[qt][ks] = *(const bf16x8*)(Qg + (size_t)qrow * DQK + qt * 32 + ks * 16 + h * 8);
    f32x16 O[NQT][2];
    float mrun[NQT], lsum[NQT];
#pragma unroll
    for (int qt = 0; qt < NQT; ++qt) {
        mrun[qt] = -1e30f; lsum[qt] = 0.f;
#pragma unroll
        for (int d = 0; d < 2; ++d)
#pragma unroll
            for (int i = 0; i < 16; ++i) O[qt][d][i] = 0.f;
    }
    int koff[KCH], voff[2];
#pragma unroll
    for (int i = 0; i < KCH; ++i) { const int id = tid + 256 * i, key = id / CPR, c = id % CPR; koff[i] = key * KSTR + c * 16; }
#pragma unroll
    for (int i = 0; i < 2; ++i) { const int id = tid + 256 * i, key = id >> 3, c = id & 7; voff[i] = KBYTES + key * 128 + ((c ^ (((key >> 1) & 1) << 2)) * 16); }
    u32x4 rk[KCH], rv[2];
#pragma unroll
    for (int i = 0; i < KCH; ++i) rk[i] = *(const u32x4*)(Kg + (size_t)(tid + 256 * i) * 8);
#pragma unroll
    for (int i = 0; i < 2; ++i) rv[i] = *(const u32x4*)(Vg + (size_t)(tid + 256 * i) * 8);
#pragma unroll
    for (int i = 0; i < KCH; ++i) *(u32x4*)(smem + koff[i]) = rk[i];
#pragma unroll
    for (int i = 0; i < 2; ++i) *(u32x4*)(smem + voff[i]) = rv[i];
    __syncthreads();
    const int kfo = r * KSTR + h * 16;
    const int qq = (lane >> 2) & 3;
    const int colb0 = ((qq >> 1) & 1) * 64 + 32 * ((lane >> 4) & 1) + 8 * (lane & 3);
    const int vfo0 = KBYTES + (4 * h + qq) * 128 + colb0, vfo1 = KBYTES + (4 * h + qq) * 128 + (colb0 ^ 64);
    const float qpos = (float)qrow;

    for (int kt = 0; kt < SEQ / 64; ++kt) {
        const unsigned char* cur = smem + (kt & 1) * ATT_STAGE;
        const bool more = (kt + 1 < SEQ / 64);
        if (more) {
#pragma unroll
            for (int i = 0; i < KCH; ++i) rk[i] = *(const u32x4*)(Kg + (size_t)(kt + 1) * 64 * DQK + (size_t)(tid + 256 * i) * 8);
#pragma unroll
            for (int i = 0; i < 2; ++i) rv[i] = *(const u32x4*)(Vg + (size_t)(kt + 1) * 64 * 64 + (size_t)(tid + 256 * i) * 8);
        }
#pragma unroll
        for (int qt = 0; qt < NQT; ++qt) {
            bf16x8 pf[2][2];
            f32x16 S[2];
#pragma unroll
            for (int kh = 0; kh < 2; ++kh) {
#pragma unroll
                for (int i = 0; i < 16; ++i) S[kh][i] = 0.f;
#pragma unroll
                for (int ks = 0; ks < KS; ++ks) {
                    const bf16x8 kf = *(const bf16x8*)(cur + kfo + kh * 32 * KSTR + (qt * 32 + ks * 16) * 2);
                    S[kh] = __builtin_amdgcn_mfma_f32_32x32x16_bf16(kf, qf[qt][ks], S[kh], 0, 0, 0);
                }
            }
            if (DIFF) {
#pragma unroll
                for (int kh = 0; kh < 2; ++kh)
#pragma unroll
                    for (int i = 0; i < 16; ++i) {
                        const float kpos = (float)(kt * 64 + kh * 32 + (i & 3) + 8 * (i >> 2) + 4 * h);
                        S[kh][i] -= slope2 * fabsf(qpos - kpos);
                    }
            }
            float mx = S[0][0];
#pragma unroll
            for (int kh = 0; kh < 2; ++kh)
#pragma unroll
                for (int i = 0; i < 16; ++i) mx = fmaxf(mx, S[kh][i]);
            mx = fmaxf(mx, __shfl_xor(mx, 32));
            const float mnew = fmaxf(mrun[qt], mx);
            const float alpha = __builtin_amdgcn_exp2f(mrun[qt] - mnew);
            mrun[qt] = mnew;
            float ps = 0.f;
#pragma unroll
            for (int kh = 0; kh < 2; ++kh)
#pragma unroll
                for (int i = 0; i < 16; ++i) { const float pv = __builtin_amdgcn_exp2f(S[kh][i] - mnew); S[kh][i] = pv; ps += pv; }
            lsum[qt] = lsum[qt] * alpha + ps;
#pragma unroll
            for (int d = 0; d < 2; ++d)
#pragma unroll
                for (int i = 0; i < 16; ++i) O[qt][d][i] *= alpha;
#pragma unroll
            for (int kh = 0; kh < 2; ++kh)
#pragma unroll
                for (int s2 = 0; s2 < 2; ++s2) {
                    u32x4 w;
                    w.x = pk2(S[kh][8 * s2 + 0], S[kh][8 * s2 + 1]); w.y = pk2(S[kh][8 * s2 + 2], S[kh][8 * s2 + 3]);
                    w.z = pk2(S[kh][8 * s2 + 4], S[kh][8 * s2 + 5]); w.w = pk2(S[kh][8 * s2 + 6], S[kh][8 * s2 + 7]);
                    pf[kh][s2] = __builtin_bit_cast(bf16x8, w);
                }
#pragma unroll
            for (int kh = 0; kh < 2; ++kh)
#pragma unroll
                for (int s2 = 0; s2 < 2; ++s2)
#pragma unroll
                    for (int d = 0; d < 2; ++d) {
                        const unsigned char* va = cur + (d ? vfo1 : vfo0) + (kh * 32 + 16 * s2) * 128;
                        const s16x4 lo = __builtin_amdgcn_ds_read_tr16_b64_v4i16((__attribute__((address_space(3))) s16x4*)(va));
                        const s16x4 hi = __builtin_amdgcn_ds_read_tr16_b64_v4i16((__attribute__((address_space(3))) s16x4*)(va + 8 * 128));
                        const bf16x8 vf = __builtin_shufflevector(lo, hi, 0, 1, 2, 3, 4, 5, 6, 7);
                        O[qt][d] = __builtin_amdgcn_mfma_f32_32x32x16_bf16(vf, pf[kh][s2], O[qt][d], 0, 0, 0);
                    }
        }
        if (more) {
            unsigned char* nx = smem + ((kt + 1) & 1) * ATT_STAGE;
#pragma unroll
            for (int i = 0; i < KCH; ++i) *(u32x4*)(nx + koff[i]) = rk[i];
#pragma unroll
            for (int i = 0; i < 2; ++i) *(u32x4*)(nx + voff[i]) = rv[i];
        }
        __syncthreads();
    }
    float inv[NQT];
#pragma unroll
    for (int qt = 0; qt < NQT; ++qt) { const float lt = lsum[qt] + __shfl_xor(lsum[qt], 32); inv[qt] = 1.0f / lt; }
    float o[2][16];
    if (DIFF) {
        float ss = 0.f;
#pragma unroll
        for (int d = 0; d < 2; ++d)
#pragma unroll
            for (int i = 0; i < 16; ++i) { const float x = O[0][d][i] * inv[0] - lam * (O[NQT - 1][d][i] * inv[NQT - 1]); o[d][i] = x; ss += x * x; }
        ss += __shfl_xor(ss, 32);
        const float rstd = rsqrtf(ss * (1.0f / 64.0f) + EPS) * outmul;
#pragma unroll
        for (int d = 0; d < 2; ++d)
#pragma unroll
            for (int i = 0; i < 16; ++i) o[d][i] *= rstd * subln[d * 32 + (i & 3) + 8 * (i >> 2) + 4 * h];
    } else {
#pragma unroll
        for (int d = 0; d < 2; ++d)
#pragma unroll
            for (int i = 0; i < 16; ++i) o[d][i] = O[0][d][i] * inv[0];
    }
    bf16_t* orow = outp + (size_t)qrow * 1024;
#pragma unroll
    for (int d = 0; d < 2; ++d)
#pragma unroll
        for (int g = 0; g < 4; ++g) {
            u32x2 w; w.x = pk2(o[d][4 * g], o[d][4 * g + 1]); w.y = pk2(o[d][4 * g + 2], o[d][4 * g + 3]);
            *(u32x2*)(orow + d * 32 + 8 * g + 4 * h) = w;
        }
}

DI void attn_phase(const Params& p, int layer, float lam_init, unsigned char* smem) {
    unsigned char* ws = p.ws;
    const bf16_t *QA = (const bf16_t*)(ws + OFF_QA), *KA = (const bf16_t*)(ws + OFF_KA), *VA = (const bf16_t*)(ws + OFF_VA), *QB = (const bf16_t*)(ws + OFF_QB),
                 *KB = (const bf16_t*)(ws + OFF_KB), *VB = (const bf16_t*)(ws + OFF_VB), *QC = (const bf16_t*)(ws + OFF_QC), *KC = (const bf16_t*)(ws + OFF_KC),
                 *VC = (const bf16_t*)(ws + OFF_VC);
    bf16_t* MIX = (bf16_t*)(ws + OFF_MIX);
    float s1 = 0.f, s2 = 0.f;
    for (int j = 0; j < 32; ++j) { s1 += p.lq1[layer * 32 + j] * p.lk1[layer * 32 + j]; s2 += p.lq2[layer * 32 + j] * p.lk2[layer * 32 + j]; }
    const float lam = expf(s1) - expf(s2) + lam_init;
    for (int v = bid_opaque(); v < 4096; v += gridDim.x) {
        const int base = v & ~511, i = v & 511, j = i >> 3;
        const int u = base + ((i & 7) * 2 + (j >> 5)) * 32 + (j & 31);
        if (u < 1024) {
            const int qb = u & 31, hh = (u >> 5) & 3, b = u >> 7;
            const size_t ro = (size_t)(b * 4 + hh) * SEQ * 64;
            const float slope2 = exp2f(-2.0f * (float)(hh + 1)) * LOG2E;
            attn_unit<64, true>(QC + ro, KC + ro, VC + ro, qb * 128, MIX + (size_t)b * SEQ * 1024 + 768 + hh * 64, slope2, lam, 1.0f - lam_init,
                                p.subln + layer * 64, smem);
        } else if (u < 2048) {
            const int w = u - 1024, qb = w & 31, hh = (w >> 5) & 3, b = w >> 7;
            const size_t rq = (size_t)(b * 4 + hh) * SEQ;
            attn_unit<96, false>(QB + rq * 96, KB + rq * 96, VB + rq * 64, qb * 128, MIX + (size_t)b * SEQ * 1024 + 512 + hh * 64, 0.f, 0.f, 0.f, nullptr, smem);
        } else {
            const int w = u - 2048, qb = w & 31, hh = (w >> 5) & 7, b = w >> 8;
            const size_t rq = (size_t)(b * 8 + hh) * SEQ, rk = (size_t)(b * 2 + (hh >> 2)) * SEQ;
            attn_unit<64, false>(QA + rq * 64, KA + rk * 64, VA + rk * 64, qb * 128, MIX + (size_t)b * SEQ * 1024 + hh * 64, 0.f, 0.f, 0.f, nullptr, smem);
        }
    }
}

DI void conv_phase(const Params& p, int layer, int half) {
    const bf16_t* U = (const bf16_t*)(p.ws + OFF_U);
    bf16_t* ACT = (bf16_t*)(p.ws + OFF_ACT);
    const float* cw = p.conv_w + (size_t)layer * 3 * DFF2;
    const float* cb = p.conv_b + (size_t)layer * DFF2;
    constexpr int T = 32, NCH = DFF / 8, NSEG = MH / T;
    const int gtid = bid_opaque() * NTHR + tid_opaque(), gthreads = gridDim.x * NTHR;
    for (int task = gtid; task < NCH * NSEG; task += gthreads) {
        const int c8 = task % NCH, seg = task / NCH, t0 = seg * T, ch = c8 * 8;
        float wg[3][8], wv[3][8], bg[8], bv[8];
#pragma unroll
        for (int j = 0; j < 8; ++j) {
#pragma unroll
            for (int k = 0; k < 3; ++k) { wg[k][j] = cw[k * DFF2 + ch + j]; wv[k][j] = cw[k * DFF2 + DFF + ch + j]; }
            bg[j] = cb[ch + j]; bv[j] = cb[DFF + ch + j];
        }
        float gm[8], g0[8], gp[8], vm[8], v0[8], vp[8];
        const bool first = ((t0 & 4095) == 0);
        if (first) {
#pragma unroll
            for (int j = 0; j < 8; ++j) { gm[j] = 0.f; vm[j] = 0.f; }
        } else {
            unpack8(*(const u32x4*)(U + (size_t)(t0 - 1) * DFF2 + ch), gm);
            unpack8(*(const u32x4*)(U + (size_t)(t0 - 1) * DFF2 + DFF + ch), vm);
        }
        unpack8(*(const u32x4*)(U + (size_t)t0 * DFF2 + ch), g0);
        unpack8(*(const u32x4*)(U + (size_t)t0 * DFF2 + DFF + ch), v0);
        for (int tt = 0; tt < T; ++tt) {
            const int t = t0 + tt;
            if ((t & 4095) == 4095) {
#pragma unroll
                for (int j = 0; j < 8; ++j) { gp[j] = 0.f; vp[j] = 0.f; }
            } else {
                unpack8(*(const u32x4*)(U + (size_t)(t + 1) * DFF2 + ch), gp);
                unpack8(*(const u32x4*)(U + (size_t)(t + 1) * DFF2 + DFF + ch), vp);
            }
            float o[8];
#pragma unroll
            for (int j = 0; j < 8; ++j) {
                const float g = wg[0][j] * gm[j] + wg[1][j] * g0[j] + wg[2][j] * gp[j] + bg[j];
                const float vv = wv[0][j] * vm[j] + wv[1][j] * v0[j] + wv[2][j] * vp[j] + bv[j];
                o[j] = g / (1.0f + __expf(-g)) * vv;
                gm[j] = g0[j]; g0[j] = gp[j]; vm[j] = v0[j]; v0[j] = vp[j];
            }
            *(u32x4*)(ACT + (size_t)t * DFF + ch) = pack8(o);
        }
    }
    (void)half;
}

__global__ void __launch_bounds__(NTHR, 2) mega(Params p) {
    extern __shared__ __attribute__((aligned(16))) unsigned char smem[];
    cg::grid_group grid = cg::this_grid();
    unsigned char* ws = p.ws;
    const int gtid = blockIdx.x * NTHR + threadIdx.x, gthreads = gridDim.x * NTHR;
    bf16_t* H = (bf16_t*)(ws + OFF_H);
    float* tab = (float*)(ws + OFF_TAB);

    for (int l = 0; l < 2; ++l) {
        prep_weight(p.w_in + (size_t)l * 1024 * INW, (bf16_t*)(ws + OFF_WIN) + (size_t)l * INWP * 1024, 1024, INW, INWP, gtid, gthreads);
        prep_weight(p.w_uq + (size_t)l * 192 * 384, (bf16_t*)(ws + OFF_WUQ) + (size_t)l * 384 * 192, 192, 384, 384, gtid, gthreads);
        prep_weight(p.w_ukv + (size_t)l * 128 * 512, (bf16_t*)(ws + OFF_WUKV) + (size_t)l * 512 * 128, 128, 512, 512, gtid, gthreads);
        prep_weight(p.w_out + (size_t)l * 1024 * 1024, (bf16_t*)(ws + OFF_WOUT) + (size_t)l * 1024 * 1024, 1024, 1024, 1024, gtid, gthreads);
        prep_weight(p.w_up + (size_t)l * 1024 * DFF2, (bf16_t*)(ws + OFF_WUP) + (size_t)l * DFF2 * 1024, 1024, DFF2, DFF2, gtid, gthreads);
        prep_weight(p.w_down + (size_t)l * DFF * 1024, (bf16_t*)(ws + OFF_WDN) + (size_t)l * 1024 * DFF, DFF, 1024, 1024, gtid, gthreads);
    }
    for (int idx = gtid; idx < 1024 + 512; idx += gthreads) {
        if (idx < 1024) { const int pos = idx >> 4, f = idx & 15; const float ang = (float)pos * powf(10000.0f, -(float)f / 16.0f); tab[idx] = cosf(ang); tab[1024 + idx] = sinf(ang); }
        else { const int k = idx - 1024, pos = k >> 3, f = k & 7; const float ang = (float)pos * powf(10000.0f, -(float)f / 8.0f); tab[2048 + k] = cosf(ang); tab[2560 + k] = sinf(ang); }
    }
    rmsnorm_rows<false>(p.x, p.norm_attn, H, nullptr);
    grid.sync();

    for (int l = 0; l < 2; ++l) {
        const float lam_init = (l == 0) ? 0.2f : 0.35550906759096984f;
        const float* xin = (l == 0) ? p.x : p.out;
        if (l > 0) { rmsnorm_rows<false>(p.out, p.norm_attn + l * 1024, H, nullptr); grid.sync(); }
        gemm_phase(H, 1024, (const bf16_t*)(ws + OFF_WIN) + (size_t)l * INWP * 1024, 1024, 1024, M_TOK, INWP, smem, EpiStoreBf16{(bf16_t*)(ws + OFF_Z), INWP});
        grid.sync();
        post_phase(p, l, smem);
        grid.sync();
        gemm_phase((const bf16_t*)(ws + OFF_CQN), 192, (const bf16_t*)(ws + OFF_WUQ) + (size_t)l * 384 * 192, 192, 192, M_TOK, 384, smem,
                   EpiMlaQ{(bf16_t*)(ws + OFF_QB), tab, 0.10206207261596575f * LOG2E});
        gemm_phase((const bf16_t*)(ws + OFF_CKVN), 128, (const bf16_t*)(ws + OFF_WUKV) + (size_t)l * 512 * 128, 128, 128, M_TOK, 512, smem,
                   EpiMlaKV{(bf16_t*)(ws + OFF_KB), (bf16_t*)(ws + OFF_VB)});
        grid.sync();
        attn_phase(p, l, lam_init, smem);
        grid.sync();
        gemm_phase((const bf16_t*)(ws + OFF_MIX), 1024, (const bf16_t*)(ws + OFF_WOUT) + (size_t)l * 1024 * 1024, 1024, 1024, M_TOK, 1024, smem, EpiResid{xin, p.out});
        grid.sync();
        rmsnorm_rows<false>(p.out, p.norm_ffn + l * 1024, H, nullptr);
        grid.sync();
        for (int hf = 0; hf < 2; ++hf) {
            gemm_phase(H + (size_t)hf * MH * 1024, 1024, (const bf16_t*)(ws + OFF_WUP) + (size_t)l * DFF2 * 1024, 1024, 1024, MH, DFF2, smem,
                       EpiStoreBf16{(bf16_t*)(ws + OFF_U), DFF2});
            grid.sync();
            conv_phase(p, l, hf);
            grid.sync();
            gemm_phase((const bf16_t*)(ws + OFF_ACT), DFF, (const bf16_t*)(ws + OFF_WDN) + (size_t)l * 1024 * DFF, DFF, DFF, MH, 1024, smem,
                       EpiResid{p.out + (size_t)hf * MH * 1024, p.out + (size_t)hf * MH * 1024});
            grid.sync();
        }
    }
    rmsnorm_rows<true>(p.out, p.final_norm, nullptr, p.out);
}

extern "C" void kernel_launch(void* const* d_in, const int* in_sizes, int n_in, void* d_out, int out_size, void* d_ws, size_t ws_size, hipStream_t stream) {
    static int grid_blocks = 0;
    if (!grid_blocks) {
        int dev = 0, cus = 0, per_cu = 0;
        hipGetDevice(&dev);
        hipDeviceGetAttribute(&cus, hipDeviceAttributeMultiprocessorCount, dev);
        hipFuncSetAttribute((const void*)mega, hipFuncAttributeMaxDynamicSharedMemorySize, SMEM_BYTES);
        hipOccupancyMaxActiveBlocksPerMultiprocessor(&per_cu, mega, NTHR, SMEM_BYTES);
        if (per_cu > 2) per_cu = 2;
        if (per_cu < 1) per_cu = 1;
        grid_blocks = cus * per_cu;
    }
    Params p{};
    const float** pp = (const float**)&p;
    for (int i = 0; i < 21; ++i) pp[i] = (const float*)d_in[i];
    p.out = (float*)d_out;
    p.ws = (unsigned char*)d_ws;
    void* args[] = {&p};
    hipError_t e = hipLaunchCooperativeKernel((void*)mega, dim3(grid_blocks), dim3(NTHR), args, SMEM_BYTES, stream);
    if (e != hipSuccess) fprintf(stderr, "cooperative launch failed: %s (grid %d)\n", hipGetErrorString(e), grid_blocks);
}
```

```cpp
#include <hip/hip_runtime.h>
#include <hip/hip_cooperative_groups.h>
#include <stdint.h>
#include <math.h>
#include <stdio.h>
namespace cg = cooperative_groups;

typedef unsigned short bf16_t;
typedef short bf16x8 __attribute__((ext_vector_type(8)));
typedef short s16x4 __attribute__((ext_vector_type(4)));
typedef float f32x4 __attribute__((ext_vector_type(4)));
typedef float f32x16 __attribute__((ext_vector_type(16)));
typedef unsigned u32x4 __attribute__((ext_vector_type(4)));
typedef unsigned u32x2 __attribute__((ext_vector_type(2)));
typedef __bf16 bf2_t __attribute__((ext_vector_type(2)));
typedef float f32x2 __attribute__((ext_vector_type(2)));
#define DI __device__ __forceinline__

constexpr int M_TOK = 32768, SEQ = 4096, DM = 1024, INW = 1888, INWP = 1920, DFF = 2816, DFF2 = 5632;
constexpr float EPS = 1e-6f;
constexpr float LOG2E = 1.4426950408889634f;
constexpr int NTHR = 256;

constexpr size_t SZ_WIN = (size_t)2 * INWP * 1024 * 2, SZ_WUQ = (size_t)2 * 384 * 192 * 2, SZ_WUKV = (size_t)2 * 512 * 128 * 2,
                 SZ_WOUT = (size_t)2 * 1024 * 1024 * 2, SZ_WUP = (size_t)2 * DFF2 * 1024 * 2, SZ_WDN = (size_t)2 * 1024 * DFF * 2;
constexpr size_t OFF_WIN = 0, OFF_WUQ = OFF_WIN + SZ_WIN, OFF_WUKV = OFF_WUQ + SZ_WUQ, OFF_WOUT = OFF_WUKV + SZ_WUKV,
                 OFF_WUP = OFF_WOUT + SZ_WOUT, OFF_WDN = OFF_WUP + SZ_WUP, OFF_TAB = OFF_WDN + SZ_WDN, OFF_XB = OFF_TAB + 16384;
constexpr size_t OFF_SSX = OFF_XB + (size_t)M_TOK * 1024 * 2, OFF_SSCQ = OFF_SSX + (size_t)M_TOK * 16 * 4, OFF_SSCKV = OFF_SSCQ + (size_t)M_TOK * 4 * 4,
                 OFF_BIG = OFF_SSCKV + (size_t)M_TOK * 2 * 4;
constexpr size_t OFF_QA = OFF_BIG, OFF_KA = OFF_QA + (size_t)M_TOK * 512 * 2,
                 OFF_VA = OFF_KA + (size_t)M_TOK * 128 * 2, OFF_CQ = OFF_VA + (size_t)M_TOK * 128 * 2, OFF_CKV = OFF_CQ + (size_t)M_TOK * 192 * 2,
                 OFF_QB = OFF_CKV + (size_t)M_TOK * 128 * 2, OFF_KB = OFF_QB + (size_t)M_TOK * 384 * 2, OFF_VB = OFF_KB + (size_t)M_TOK * 384 * 2,
                 OFF_QC = OFF_VB + (size_t)M_TOK * 256 * 2, OFF_KC = OFF_QC + (size_t)M_TOK * 256 * 2, OFF_VC = OFF_KC + (size_t)M_TOK * 256 * 2,
                 OFF_MIX = OFF_VC + (size_t)M_TOK * 256 * 2, OFF_END1 = OFF_MIX + (size_t)M_TOK * 1024 * 2;
constexpr size_t OFF_ACT = OFF_BIG, OFF_END2 = OFF_ACT + (size_t)M_TOK * DFF * 2;
static_assert(OFF_END1 <= (size_t)512 * 1024 * 1024 && OFF_END2 <= (size_t)512 * 1024 * 1024, "workspace");

struct Params {
    const float *x, *norm_attn, *w_in, *qn_a, *kn_a, *qan_b, *w_uq, *kvn_b, *w_ukv, *lq1, *lk1, *lq2, *lk2, *subln, *w_out, *norm_ffn, *w_up,
        *conv_w, *conv_b, *w_down, *final_norm;
    float* out;
    unsigned char* ws;
};

DI unsigned pk2(float a, float b) { f32x2 v = {a, b}; bf2_t r = __builtin_convertvector(v, bf2_t); return __builtin_bit_cast(unsigned, r); }
DI void unpack8(u32x4 r, float* v) {
    v[0] = __uint_as_float(r.x << 16); v[1] = __uint_as_float(r.x & 0xffff0000u);
    v[2] = __uint_as_float(r.y << 16); v[3] = __uint_as_float(r.y & 0xffff0000u);
    v[4] = __uint_as_float(r.z << 16); v[5] = __uint_as_float(r.z & 0xffff0000u);
    v[6] = __uint_as_float(r.w << 16); v[7] = __uint_as_float(r.w & 0xffff0000u);
}
DI u32x4 pack8(const float* v) { u32x4 r; r.x = pk2(v[0], v[1]); r.y = pk2(v[2], v[3]); r.z = pk2(v[4], v[5]); r.w = pk2(v[6], v[7]); return r; }
DI int tid_opaque(int wv) { int t = (wv << 6) | (int)__builtin_amdgcn_mbcnt_hi(~0u, __builtin_amdgcn_mbcnt_lo(~0u, 0u)); asm volatile("" : "+v"(t)); return t; }
DI int bid_opaque() { int b = blockIdx.x; asm volatile("" : "+s"(b)); return b; }
DI float shflx(float v, int mask, int lane) { return __int_as_float(__builtin_amdgcn_ds_bpermute((lane ^ mask) << 2, __float_as_int(v))); }
DI float wave_sum(float v, int lane) {
#pragma unroll
    for (int o = 32; o >= 1; o >>= 1) v += shflx(v, o, lane);
    return v;
}

template <bool UPPERM>
DI void prep_weight(const float* __restrict__ W, const float* __restrict__ gain, bf16_t* __restrict__ Wt, int K, int N, int Npad, int gtid, int gthreads) {
    const int total = Npad * (K / 8);
    for (int idx = gtid; idx < total; idx += gthreads) {
        const int n = idx % Npad, kc = idx / Npad;
        int ns = n;
        if (UPPERM) { const int j = n >> 7, r = n & 127; ns = (r < 64) ? (64 * j + r) : (DFF + 64 * j + r - 64); }
        float v[8];
#pragma unroll
        for (int j = 0; j < 8; ++j) { const int k = kc * 8 + j; v[j] = (n < N) ? W[(size_t)k * N + ns] * (gain ? gain[k] : 1.0f) : 0.f; }
        *(u32x4*)(Wt + (size_t)n * K + kc * 8) = pack8(v);
    }
}

DI void convert_x(const float* X, bf16_t* XB, float* SSX, int wv) {
    const int tid_ = tid_opaque(wv);
    const int lane = tid_ & 63, gw = bid_opaque() * 4 + (tid_ >> 6), nw = gridDim.x * 4;
    for (int row = gw; row < M_TOK; row += nw) {
        const f32x4* xr = (const f32x4*)(X + (size_t)row * 1024);
        float ss = 0.f;
#pragma unroll
        for (int i = 0; i < 4; ++i) {
            const f32x4 v = xr[lane + 64 * i];
            ss += v[0] * v[0] + v[1] * v[1] + v[2] * v[2] + v[3] * v[3];
            u32x2 w; w.x = pk2(v[0], v[1]); w.y = pk2(v[2], v[3]);
            *(u32x2*)(XB + (size_t)row * 1024 + (lane + 64 * i) * 4) = w;
        }
        ss = wave_sum(ss, lane);
        if (lane < 16) SSX[(size_t)row * 16 + lane] = (lane == 0) ? ss : 0.f;
    }
}
DI void final_norm(float* X, const float* __restrict__ g, const float* SSX, int wv) {
    const int tid_ = tid_opaque(wv);
    const int lane = tid_ & 63, gw = bid_opaque() * 4 + (tid_ >> 6), nw = gridDim.x * 4;
    for (int row = gw; row < M_TOK; row += nw) {
        float ss = (lane < 16) ? SSX[(size_t)row * 16 + lane] : 0.f;
        ss = wave_sum(ss, lane);
        const float rstd = rsqrtf(ss * (1.0f / 1024.0f) + EPS);
        f32x4* xr = (f32x4*)(X + (size_t)row * 1024);
#pragma unroll
        for (int i = 0; i < 4; ++i) { const f32x4 gv = ((const f32x4*)g)[lane + 64 * i]; xr[lane + 64 * i] = xr[lane + 64 * i] * rstd * gv; }
    }
}
DI float row_rstd(const float* ssx, int m) {
    const f32x4* pp = (const f32x4*)(ssx + (size_t)m * 16);
    const f32x4 a = (pp[0] + pp[1]) + (pp[2] + pp[3]);
    return rsqrtf(((a[0] + a[1]) + (a[2] + a[3])) * (1.0f / 1024.0f) + EPS);
}

constexpr int GSTR = 128, GOP = 128 * GSTR;
constexpr int SMEM_BYTES = 4 * GOP;

constexpr int SMEM_CONV = 128 * 132 * 4;
constexpr int SMEM_TOTAL = SMEM_CONV > SMEM_BYTES ? SMEM_CONV : SMEM_BYTES;

DI void gemm_mainloop(const bf16_t* const (&gap)[4], const bool (&av)[4], const bf16_t* __restrict__ gb, int ldb, int nk, unsigned char* smem, f32x4 (&acc)[4][4], int tid) {
    const int lane = tid & 63, wid = tid >> 6, wr = wid >> 1, wc = wid & 1;
    const int lrow = tid >> 3, lc = tid & 7;
    u32x4 ra0[4], rb0[4], ra1[4], rb1[4];
#pragma unroll
    for (int i = 0; i < 4; ++i)
#pragma unroll
        for (int j = 0; j < 4; ++j) acc[i][j] = (f32x4){0.f, 0.f, 0.f, 0.f};
    const u32x4 zero4 = {0u, 0u, 0u, 0u};
#define G_LOAD(RA, RB, KT) { _Pragma("unroll") for (int i = 0; i < 4; ++i) { const u32x4 t_ = *(const u32x4*)(gap[i] + (KT) * 64); RA[i] = av[i] ? t_ : zero4; RB[i] = *(const u32x4*)(gb + (size_t)i * 32 * ldb + (KT) * 64); } }
#define G_WRITE(BUF, RA, RB) { unsigned char* wb_ = smem + (BUF) * 2 * GOP + lrow * GSTR + ((lc ^ (lrow & 7)) << 4); _Pragma("unroll") for (int i = 0; i < 4; ++i) { *(u32x4*)(wb_ + i * 32 * GSTR) = RA[i]; *(u32x4*)(wb_ + GOP + i * 32 * GSTR) = RB[i]; } }
#define G_COMPUTE(BUF) { const unsigned char* sa = smem + (BUF) * 2 * GOP + wr * 64 * GSTR + foff; const unsigned char* sb = smem + (BUF) * 2 * GOP + GOP + wc * 64 * GSTR + foff; \
        _Pragma("unroll") for (int kk = 0; kk < 2; ++kk) { bf16x8 af[4], bfr[4]; \
            _Pragma("unroll") for (int i = 0; i < 4; ++i) { af[i] = *(const bf16x8*)(sa + i * 16 * GSTR + fsw[kk]); bfr[i] = *(const bf16x8*)(sb + i * 16 * GSTR + fsw[kk]); } \
            _Pragma("unroll") for (int mi = 0; mi < 4; ++mi) _Pragma("unroll") for (int ni = 0; ni < 4; ++ni) acc[mi][ni] = __builtin_amdgcn_mfma_f32_16x16x32_bf16(bfr[ni], af[mi], acc[mi][ni], 0, 0, 0); } }
    const int foff = (lane & 15) * GSTR;
    const int fsw[2] = {(((lane >> 4)) ^ (lane & 7)) << 4, (((lane >> 4) + 4) ^ (lane & 7)) << 4};
    G_LOAD(ra0, rb0, 0);
    G_LOAD(ra1, rb1, 1);
    G_WRITE(0, ra0, rb0);
    __syncthreads();
    for (int kt = 0; kt < nk; kt += 2) {
        { const int kl = (kt + 2 < nk) ? kt + 2 : nk - 1; G_LOAD(ra0, rb0, kl); }
        G_COMPUTE(0);
        G_WRITE(1, ra1, rb1);
        __syncthreads();
        if (kt + 1 >= nk) break;
        { const int kl = (kt + 3 < nk) ? kt + 3 : nk - 1; G_LOAD(ra1, rb1, kl); }
        G_COMPUTE(1);
        G_WRITE(0, ra0, rb0);
        __syncthreads();
    }
#undef G_LOAD
#undef G_WRITE
#undef G_COMPUTE
}

template <class Epi>
DI void gemm_tile(const bf16_t* __restrict__ A, int lda, const bf16_t* __restrict__ Bt, int ldb, int K, int m0, int n0, unsigned char* smem, const Epi& epi, int wv) {
    const int tid = tid_opaque(wv), lane = tid & 63, wid = tid >> 6, wr = wid >> 1, wc = wid & 1;
    const int lrow = tid >> 3, lc = tid & 7;
    const bf16_t* gap[4];
    const bool av[4] = {true, true, true, true};
#pragma unroll
    for (int i = 0; i < 4; ++i) gap[i] = A + (size_t)(m0 + lrow + 32 * i) * lda + lc * 8;
    const bf16_t* gb = Bt + (size_t)(n0 + lrow) * ldb + lc * 8;
    f32x4 acc[4][4];
    gemm_mainloop(gap, av, gb, ldb, K / 64, smem, acc, tid);
    epi(acc, m0 + wr * 64, n0 + wc * 64, lane);
}

template <class Epi>
DI void gemm_phase(const bf16_t* A, int lda, const bf16_t* Bt, int ldb, int K, int Mrows, int Ncols, unsigned char* smem, const Epi& epi, int wv) {
    const int nN = Ncols / 128, nM = Mrows / 128;
    const int bid = bid_opaque(), G = gridDim.x;
    {
        const int xcd = bid & 7, lb = bid >> 3, nlb = G >> 3, mper = nM >> 3, nloc = mper * nN;
        for (int j = lb; j < nloc; j += nlb) {
            const int g = j / (8 * nN), rem = j - g * 8 * nN;
            const int mt = xcd * mper + g * 8 + (rem & 7), nt = rem >> 3;
            gemm_tile(A, lda, Bt, ldb, K, mt * 128, nt * 128, smem, epi, wv);
        }
    }
}

DI float dot4(f32x4 a) { return (a[0] * a[0] + a[1] * a[1]) + (a[2] * a[2] + a[3] * a[3]); }
DI void st4bf(bf16_t* dst, f32x4 v) { u32x2 w; w.x = pk2(v[0], v[1]); w.y = pk2(v[2], v[3]); *(u32x2*)dst = w; }

struct EpiResid2 {
    const float* Xin; float* Xout; bf16_t* XB; float* SSX;
    DI void operator()(const f32x4 (&acc)[4][4], int mb, int nb, int lane) const {
        const int q = lane >> 4;
#pragma unroll
        for (int mi = 0; mi < 4; ++mi) {
            const int m = mb + mi * 16 + (lane & 15);
            float ss = 0.f;
#pragma unroll
            for (int ni = 0; ni < 4; ++ni) {
                const size_t o = (size_t)m * 1024 + nb + ni * 16 + q * 4;
                f32x4 r = *(const f32x4*)(Xin + o);
                r += acc[mi][ni];
                *(f32x4*)(Xout + o) = r;
                st4bf(XB + o, r);
                ss += dot4(r);
            }
            ss += shflx(ss, 16, lane); ss += shflx(ss, 32, lane);
            if (q == 0) SSX[(size_t)m * 16 + (nb >> 6)] = ss;
        }
    }
};

struct EpiInProj {
    const float *ssx, *tab, *gq, *gk;
    bf16_t *QA, *KA, *VA, *CQ, *CKV, *KB, *QC, *KC, *VC;
    float *sscq, *ssckv;
    DI void operator()(const f32x4 (&acc)[4][4], int mb, int nb, int lane) const {
        const int q = lane >> 4, ml = lane & 15;
        const float qsA = 0.125f * LOG2E, qsC = 0.17677669529663687f * LOG2E;
        if (nb < 640) {
            const bool isq = nb < 512;
            const int head = isq ? (nb >> 6) : ((nb - 512) >> 6);
            const float* g = isq ? gq : gk;
            f32x4 gv[4];
#pragma unroll
            for (int ni = 0; ni < 4; ++ni) gv[ni] = *(const f32x4*)(g + ni * 16 + q * 4);
#pragma unroll
            for (int mi = 0; mi < 4; ++mi) {
                const int m = mb + mi * 16 + ml, b = m >> 12, s = m & 4095;
                const float rs = row_rstd(ssx, m);
                f32x4 v[4];
                float ss = 0.f;
#pragma unroll
                for (int ni = 0; ni < 4; ++ni) { v[ni] = acc[mi][ni] * rs; ss += dot4(v[ni]); }
                ss += shflx(ss, 16, lane); ss += shflx(ss, 32, lane);
                const float r2 = rsqrtf(ss * (1.0f / 64.0f) + EPS);
#pragma unroll
                for (int ni = 0; ni < 4; ++ni) v[ni] = v[ni] * r2 * gv[ni];
                const float* tr = tab + (s >> 6) * 16 + q * 4;
                const float* tq = tab + (s & 63) * 16 + q * 4;
                const f32x4 c0 = *(const f32x4*)tr, s0 = *(const f32x4*)(tr + 1024), c1 = *(const f32x4*)tq, s1 = *(const f32x4*)(tq + 1024);
                f32x4 o0 = v[0] * c0 - v[1] * s0, o1 = v[1] * c0 + v[0] * s0, o2 = v[2] * c1 - v[3] * s1, o3 = v[3] * c1 + v[2] * s1;
                bf16_t* dst;
                if (isq) { o0 *= qsA; o1 *= qsA; o2 *= qsA; o3 *= qsA; dst = QA + ((size_t)(b * 8 + head) * SEQ + s) * 64 + q * 4; }
                else dst = KA + ((size_t)(b * 2 + head) * SEQ + s) * 64 + q * 4;
                st4bf(dst, o0); st4bf(dst + 16, o1); st4bf(dst + 32, o2); st4bf(dst + 48, o3);
            }
        } else if (nb < 768) {
            const int head = (nb - 640) >> 6;
#pragma unroll
            for (int mi = 0; mi < 4; ++mi) {
                const int m = mb + mi * 16 + ml, b = m >> 12, s = m & 4095;
                const float rs = row_rstd(ssx, m);
                bf16_t* dst = VA + ((size_t)(b * 2 + head) * SEQ + s) * 64 + q * 4;
#pragma unroll
                for (int ni = 0; ni < 4; ++ni) st4bf(dst + ni * 16, acc[mi][ni] * rs);
            }
        } else {
            const bool sq = nb < 1088;
#pragma unroll
            for (int mi = 0; mi < 4; ++mi) {
                const int m = mb + mi * 16 + ml, b = m >> 12, s = m & 4095;
                const float rs = row_rstd(ssx, m);
                float ss = 0.f;
#pragma unroll
                for (int ni = 0; ni < 4; ++ni) {
                    const int n16 = nb + ni * 16;
                    f32x4 v = acc[mi][ni] * rs;
                    if (n16 < 960) { st4bf(CQ + (size_t)m * 192 + (n16 - 768) + q * 4, v); ss += dot4(v); }
                    else if (n16 < 1088) { st4bf(CKV + (size_t)m * 128 + (n16 - 960) + q * 4, v); ss += dot4(v); }
                    else if (n16 < 1120) {
                        f32x4 pr;
#pragma unroll
                        for (int i = 0; i < 4; ++i) pr[i] = shflx(v[i], 32, lane);
                        const int pos = (n16 >= 1104) ? (s & 63) : (s >> 6);
                        const float* tc = tab + 2048 + pos * 8 + (q & 1) * 4;
                        const f32x4 c = *(const f32x4*)tc, sn = *(const f32x4*)(tc + 512);
                        const f32x4 o = (q < 2) ? (v * c - pr * sn) : (v * c + pr * sn);
#pragma unroll
                        for (int hh = 0; hh < 4; ++hh) st4bf(KB + ((size_t)(b * 4 + hh) * SEQ + s) * 96 + 64 + (n16 - 1088) + q * 4, o);
                    } else if (n16 < 1376) { const int c = n16 - 1120 + q * 4; st4bf(QC + ((size_t)(b * 4 + (c >> 6)) * SEQ + s) * 64 + (c & 63), v * qsC); }
                    else if (n16 < 1632) { const int c = n16 - 1376 + q * 4; st4bf(KC + ((size_t)(b * 4 + (c >> 6)) * SEQ + s) * 64 + (c & 63), v); }
                    else if (n16 < 1888) { const int c = n16 - 1632 + q * 4; st4bf(VC + ((size_t)(b * 4 + (c >> 6)) * SEQ + s) * 64 + (c & 63), v); }
                }
                if (sq) {
                    ss += shflx(ss, 16, lane); ss += shflx(ss, 32, lane);
                    if (q == 0) { if (nb < 960) sscq[(size_t)m * 4 + ((nb - 768) >> 6)] = ss; else ssckv[(size_t)m * 2 + ((nb - 960) >> 6)] = ss; }
                }
            }
        }
    }
};
struct EpiMlaQ {
    bf16_t* QB; const float* tab; const float* sscq; float qscale;
    DI void operator()(const f32x4 (&acc)[4][4], int mb, int nb, int lane) const {
#pragma unroll
        for (int mi = 0; mi < 4; ++mi) {
            const int m = mb + mi * 16 + (lane & 15), q = lane >> 4, b = m >> 12, s = m & 4095;
            const f32x4 sp = *(const f32x4*)(sscq + (size_t)m * 4);
            const float rs = rsqrtf((sp[0] + sp[1] + sp[2]) * (1.0f / 192.0f) + EPS) * qscale;
#pragma unroll
            for (int ni = 0; ni < 4; ++ni) {
                const int nt = nb + ni * 16;
                const int head = nt / 96, dt = nt - head * 96;
                f32x4 v = acc[mi][ni] * rs;
                f32x4 pr;
#pragma unroll
                for (int i = 0; i < 4; ++i) pr[i] = shflx(v[i], 32, lane);
                if (dt >= 64) {
                    const int pos = (dt >= 80) ? (s & 63) : (s >> 6);
                    const float* tc = tab + 2048 + pos * 8 + (q & 1) * 4;
                    const f32x4 c = *(const f32x4*)tc, sn = *(const f32x4*)(tc + 512);
                    v = (q < 2) ? (v * c - pr * sn) : (v * c + pr * sn);
                }
                st4bf(QB + ((size_t)(b * 4 + head) * SEQ + s) * 96 + dt + q * 4, v);
            }
        }
    }
};
struct EpiMlaKV {
    bf16_t* KB; bf16_t* VB; const float* ssckv;
    DI void operator()(const f32x4 (&acc)[4][4], int mb, int nb, int lane) const {
#pragma unroll
        for (int mi = 0; mi < 4; ++mi) {
            const int m = mb + mi * 16 + (lane & 15), b = m >> 12, s = m & 4095;
            const f32x2 sp = *(const f32x2*)(ssckv + (size_t)m * 2);
            const float rs = rsqrtf((sp[0] + sp[1]) * (1.0f / 128.0f) + EPS);
#pragma unroll
            for (int ni = 0; ni < 4; ++ni) {
                const int n = nb + ni * 16 + (lane >> 4) * 4;
                const int head = n >> 7, d = n & 127;
                const size_t rowi = (size_t)(b * 4 + head) * SEQ + s;
                if (d < 64) st4bf(KB + rowi * 96 + d, acc[mi][ni] * rs);
                else st4bf(VB + rowi * 64 + (d - 64), acc[mi][ni] * rs);
            }
        }
    }
};

DI void up_conv_tile(const bf16_t* __restrict__ XB, const bf16_t* __restrict__ Wt, const float* __restrict__ ssx, const float* __restrict__ cw, const float* __restrict__ cb,
                     bf16_t* __restrict__ ACT, int b, int jt, int nt, unsigned char* smem, int wv) {
    const int tid = tid_opaque(wv), lane = tid & 63, wid = tid >> 6, wr = wid >> 1, wc = wid & 1;
    const int lrow = tid >> 3, lc = tid & 7;
    const int tbase = jt * 126 - 1;
    const bf16_t* gap[4];
    bool av[4];
#pragma unroll
    for (int i = 0; i < 4; ++i) {
        const int tl = tbase + lrow + 32 * i;
        av[i] = (unsigned)tl < 4096u;
        const int tc = tl < 0 ? 0 : (tl > 4095 ? 4095 : tl);
        gap[i] = XB + ((size_t)b * SEQ + tc) * 1024 + lc * 8;
    }
    const bf16_t* gb = Wt + (size_t)(nt * 128 + lrow) * 1024 + lc * 8;
    f32x4 acc[4][4];
    gemm_mainloop(gap, av, gb, 1024, 16, smem, acc, tid);
    float* T = (float*)smem;
    {
        const int q = lane >> 4, ml = lane & 15;
#pragma unroll
        for (int mi = 0; mi < 4; ++mi) {
            const int il = wr * 64 + mi * 16 + ml, tl = tbase + il;
            const int tc = tl < 0 ? 0 : (tl > 4095 ? 4095 : tl);
            const float rs = row_rstd(ssx, b * SEQ + tc);
#pragma unroll
            for (int ni = 0; ni < 4; ++ni) *(f32x4*)(T + il * 132 + wc * 64 + ni * 16 + q * 4) = acc[mi][ni] * rs;
        }
    }
    __syncthreads();
    {
        const int cq = tid & 15, rg = tid >> 4, ch = nt * 64 + cq * 4;
        const f32x4 wg0 = *(const f32x4*)(cw + ch), wg1 = *(const f32x4*)(cw + DFF2 + ch), wg2 = *(const f32x4*)(cw + 2 * DFF2 + ch), bg = *(const f32x4*)(cb + ch);
        const f32x4 wv0 = *(const f32x4*)(cw + DFF + ch), wv1 = *(const f32x4*)(cw + DFF2 + DFF + ch), wv2 = *(const f32x4*)(cw + 2 * DFF2 + DFF + ch), bv = *(const f32x4*)(cb + DFF + ch);
        const int r0 = rg * 8, rm = r0 > 0 ? r0 - 1 : 0;
        f32x4 gm = *(const f32x4*)(T + rm * 132 + cq * 4), vm = *(const f32x4*)(T + rm * 132 + 64 + cq * 4);
        f32x4 g0 = *(const f32x4*)(T + r0 * 132 + cq * 4), v0 = *(const f32x4*)(T + r0 * 132 + 64 + cq * 4);
#pragma unroll
        for (int rr = 0; rr < 8; ++rr) {
            const int r = r0 + rr, rp = r < 127 ? r + 1 : 127;
            const f32x4 gp = *(const f32x4*)(T + rp * 132 + cq * 4), vp = *(const f32x4*)(T + rp * 132 + 64 + cq * 4);
            const f32x4 gg = wg0 * gm + wg1 * g0 + wg2 * gp + bg;
            const f32x4 vv = wv0 * vm + wv1 * v0 + wv2 * vp + bv;
            f32x4 o;
#pragma unroll
            for (int e = 0; e < 4; ++e) o[e] = gg[e] / (1.0f + __expf(-gg[e])) * vv[e];
            const int tl = tbase + r;
            if (r >= 1 && r <= 126 && tl <= 4095) st4bf(ACT + ((size_t)b * SEQ + tl) * DFF + ch, o);
            gm = g0; g0 = gp; vm = v0; v0 = vp;
        }
    }
    __syncthreads();
}
DI void up_conv_phase(const bf16_t* XB, const bf16_t* Wt, const float* ssx, const float* cw, const float* cb, bf16_t* ACT, unsigned char* smem, int wv) {
    constexpr int NT = DFF / 64, MT = 33;
    const int bid = bid_opaque(), G = gridDim.x;
    {
        const int xcd = bid & 7, lb = bid >> 3, nlb = G >> 3, nloc = MT * NT, full = (MT / 8) * 8 * NT, gs = MT - (MT / 8) * 8;
        for (int j = lb; j < nloc; j += nlb) {
            int jt, nt;
            if (j < full) { const int g = j / (8 * NT), rem = j - g * 8 * NT; jt = g * 8 + (rem & 7); nt = rem >> 3; }
            else { const int j2 = j - full; jt = (MT / 8) * 8 + j2 % gs; nt = j2 / gs; }
            up_conv_tile(XB, Wt, ssx, cw, cb, ACT, xcd, jt, nt, smem, wv);
        }
    }
}

constexpr int ATT_STAGE = 64 * 208 + 8192;

template <int DQK, bool DIFF>
DI void attn_unit(const bf16_t* __restrict__ Qg, const bf16_t* __restrict__ Kg, const bf16_t* __restrict__ Vg, int q0, bf16_t* __restrict__ outp,
                  float slope2, float lam, float outmul, const float* __restrict__ subln, unsigned char* smem, int wv) {
    constexpr int NQT = DIFF ? 2 : 1, KS = DIFF ? 2 : DQK / 16, KSTR = DQK * 2 + 16, CPR = DQK / 8, KCH = 64 * CPR / 256, KBYTES = 64 * 208;
    const int tid = tid_opaque(wv), lane = tid & 63, wid = tid >> 6, r = lane & 31, h = lane >> 5;
    const int qrow = q0 + wid * 32 + r;
    bf16x8 qf[NQT][KS];
#pragma unroll
    for (int qt = 0; qt < NQT; ++qt)
#pragma unroll
        for (int ks = 0; ks < KS; ++ks) qf[qt][ks] = *(const bf16x8*)(Qg + (size_t)qrow * DQK + qt * 32 + ks * 16 + h * 8);
    f32x16 O[NQT][2];
    float mrun[NQT], lsum[NQT];
#pragma unroll
    for (int qt = 0; qt < NQT; ++qt) {
        mrun[qt] = -1e30f; lsum[qt] = 0.f;
#pragma unroll
        for (int d = 0; d < 2; ++d)
#pragma unroll
            for (int i = 0; i < 16; ++i) O[qt][d][i] = 0.f;
    }
    int koff[KCH], voff[2];
#pragma unroll
    for (int i = 0; i < KCH; ++i) { const int id = tid + 256 * i, key = id / CPR, c = id % CPR; koff[i] = key * KSTR + c * 16; }
#pragma unroll
    for (int i = 0; i < 2; ++i) { const int id = tid + 256 * i, key = id >> 3, c = id & 7; voff[i] = KBYTES + key * 128 + ((c ^ (((key >> 1) & 1) << 2)) * 16); }
    u32x4 rk[KCH], rv[2];
#pragma unroll
    for (int i = 0; i < KCH; ++i) rk[i] = *(const u32x4*)(Kg + (size_t)(tid + 256 * i) * 8);
#pragma unroll
    for (int i = 0; i < 2; ++i) rv[i] = *(const u32x4*)(Vg + (size_t)(tid + 256 * i) * 8);
#pragma unroll
    for (int i = 0; i < KCH; ++i) *(u32x4*)(smem + koff[i]) = rk[i];
#pragma unroll
    for (int i = 0; i < 2; ++i) *(u32x4*)(smem + voff[i]) = rv[i];
    __syncthreads();
    const int kfo = r * KSTR + h * 16;
    const int qq = (lane >> 2) & 3;
    const int colb0 = ((qq >> 1) & 1) * 64 + 32 * ((lane >> 4) & 1) + 8 * (lane & 3);
    const int vfo0 = KBYTES + (4 * h + qq) * 128 + colb0, vfo1 = KBYTES + (4 * h + qq) * 128 + (colb0 ^ 64);
    const float qpos = (float)qrow;

    for (int kt = 0; kt < SEQ / 64; ++kt) {
        const unsigned char* cur = smem + (kt & 1) * ATT_STAGE;
        const bool more = (kt + 1 < SEQ / 64);
        if (more) {
#pragma unroll
            for (int i = 0; i < KCH; ++i) rk[i] = *(const u32x4*)(Kg + (size_t)(kt + 1) * 64 * DQK + (size_t)(tid + 256 * i) * 8);
#pragma unroll
            for (int i = 0; i < 2; ++i) rv[i] = *(const u32x4*)(Vg + (size_t)(kt + 1) * 64 * 64 + (size_t)(tid + 256 * i) * 8);
        }
#pragma unroll
        for (int qt = 0; qt < NQT; ++qt) {
            bf16x8 pf[2][2];
            f32x16 S[2];
#pragma unroll
            for (int kh = 0; kh < 2; ++kh) {
#pragma unroll
                for (int i = 0; i < 16; ++i) S[kh][i] = 0.f;
#pragma unroll
                for (int ks = 0; ks < KS; ++ks) {
                    const bf16x8 kf = *(const bf16x8*)(cur + kfo + kh * 32 * KSTR + (qt * 32 + ks * 16) * 2);
                    S[kh] = __builtin_amdgcn_mfma_f32_32x32x16_bf16(kf, qf[qt][ks], S[kh], 0, 0, 0);
                }
            }
            if (DIFF) {
#pragma unroll
                for (int kh = 0; kh < 2; ++kh)
#pragma unroll
                    for (int i = 0; i < 16; ++i) {
                        const float kpos = (float)(kt * 64 + kh * 32 + (i & 3) + 8 * (i >> 2) + 4 * h);
                        S[kh][i] -= slope2 * fabsf(qpos - kpos);
                    }
            }
            float mx = S[0][0];
#pragma unroll
            for (int kh = 0; kh < 2; ++kh)
#pragma unroll
                for (int i = 0; i < 16; ++i) mx = fmaxf(mx, S[kh][i]);
            mx = fmaxf(mx, shflx(mx, 32, lane));
            const float mnew = fmaxf(mrun[qt], mx);
            const float alpha = __builtin_amdgcn_exp2f(mrun[qt] - mnew);
            mrun[qt] = mnew;
            float ps = 0.f;
#pragma unroll
            for (int kh = 0; kh < 2; ++kh)
#pragma unroll
                for (int i = 0; i < 16; ++i) { const float pv = __builtin_amdgcn_exp2f(S[kh][i] - mnew); S[kh][i] = pv; ps += pv; }
            lsum[qt] = lsum[qt] * alpha + ps;
#pragma unroll
            for (int d = 0; d < 2; ++d)
#pragma unroll
                for (int i = 0; i < 16; ++i) O[qt][d][i] *= alpha;
#pragma unroll
            for (int kh = 0; kh < 2; ++kh)
#pragma unroll
                for (int s2 = 0; s2 < 2; ++s2) {
                    u32x4 w;
                    w.x = pk2(S[kh][8 * s2 + 0], S[kh][8 * s2 + 1]); w.y = pk2(S[kh][8 * s2 + 2], S[kh][8 * s2 + 3]);
                    w.z = pk2(S[kh][8 * s2 + 4], S[kh][8 * s2 + 5]); w.w = pk2(S[kh][8 * s2 + 6], S[kh][8 * s2 + 7]);
                    pf[kh][s2] = __builtin_bit_cast(bf16x8, w);
                }
#pragma unroll
            for (int kh = 0; kh < 2; ++kh)
#pragma unroll
                for (int s2 = 0; s2 < 2; ++s2)
#pragma unroll
                    for (int d = 0; d < 2; ++d) {
                        const unsigned char* va = cur + (d ? vfo1 : vfo0) + (kh * 32 + 16 * s2) * 128;
                        const s16x4 lo = __builtin_amdgcn_ds_read_tr16_b64_v4i16((__attribute__((address_space(3))) s16x4*)(va));
                        const s16x4 hi = __builtin_amdgcn_ds_read_tr16_b64_v4i16((__attribute__((address_space(3))) s16x4*)(va + 8 * 128));
                        const bf16x8 vf = __builtin_shufflevector(lo, hi, 0, 1, 2, 3, 4, 5, 6, 7);
                        O[qt][d] = __builtin_amdgcn_mfma_f32_32x32x16_bf16(vf, pf[kh][s2], O[qt][d], 0, 0, 0);
                    }
            if (DIFF) __builtin_amdgcn_sched_barrier(0);
        }
        if (more) {
            unsigned char* nx = smem + ((kt + 1) & 1) * ATT_STAGE;
#pragma unroll
            for (int i = 0; i < KCH; ++i) *(u32x4*)(nx + koff[i]) = rk[i];
#pragma unroll
            for (int i = 0; i < 2; ++i) *(u32x4*)(nx + voff[i]) = rv[i];
        }
        __syncthreads();
    }
    const int tid2 = tid_opaque(wv), lane2 = tid2 & 63;
    const int h2 = lane2 >> 5;
    float inv[NQT];
#pragma unroll
    for (int qt = 0; qt < NQT; ++qt) { const float lt = lsum[qt] + shflx(lsum[qt], 32, lane2); inv[qt] = 1.0f / lt; }
    float o[2][16];
    if (DIFF) {
        float ss = 0.f;
#pragma unroll
        for (int d = 0; d < 2; ++d)
#pragma unroll
            for (int i = 0; i < 16; ++i) { const float x = O[0][d][i] * inv[0] - lam * (O[NQT - 1][d][i] * inv[NQT - 1]); o[d][i] = x; ss += x * x; }
        ss += shflx(ss, 32, lane2);
        const float rstd = rsqrtf(ss * (1.0f / 64.0f) + EPS) * outmul;
#pragma unroll
        for (int d = 0; d < 2; ++d)
#pragma unroll
            for (int i = 0; i < 16; ++i) o[d][i] *= rstd * subln[d * 32 + (i & 3) + 8 * (i >> 2) + 4 * h2];
    } else {
#pragma unroll
        for (int d = 0; d < 2; ++d)
#pragma unroll
            for (int i = 0; i < 16; ++i) o[d][i] = O[0][d][i] * inv[0];
    }
    const int qrow2 = q0 + (lane2 & 31) + ((tid2 >> 6) << 5);
    bf16_t* orow = outp + (size_t)qrow2 * 1024;
#pragma unroll
    for (int d = 0; d < 2; ++d)
#pragma unroll
        for (int g = 0; g < 4; ++g) {
            u32x2 w; w.x = pk2(o[d][4 * g], o[d][4 * g + 1]); w.y = pk2(o[d][4 * g + 2], o[d][4 * g + 3]);
            *(u32x2*)(orow + d * 32 + 8 * g + 4 * h2) = w;
        }
}

DI void attn_phase(const Params& p, int layer, float lam_init, float outmul, unsigned char* smem, int wv) {
    unsigned char* ws = p.ws;
    const bf16_t *QA = (const bf16_t*)(ws + OFF_QA), *KA = (const bf16_t*)(ws + OFF_KA), *VA = (const bf16_t*)(ws + OFF_VA), *QB = (const bf16_t*)(ws + OFF_QB),
                 *KB = (const bf16_t*)(ws + OFF_KB), *VB = (const bf16_t*)(ws + OFF_VB), *QC = (const bf16_t*)(ws + OFF_QC), *KC = (const bf16_t*)(ws + OFF_KC),
                 *VC = (const bf16_t*)(ws + OFF_VC);
    bf16_t* MIX = (bf16_t*)(ws + OFF_MIX);
    float s1 = 0.f, s2 = 0.f;
    for (int j = 0; j < 32; ++j) { s1 += p.lq1[layer * 32 + j] * p.lk1[layer * 32 + j]; s2 += p.lq2[layer * 32 + j] * p.lk2[layer * 32 + j]; }
    const float lam = __int_as_float(__builtin_amdgcn_readfirstlane(__float_as_int(expf(s1) - expf(s2) + lam_init)));
    for (int v = bid_opaque(); v < 4096; v += gridDim.x) {
        const int base = v & ~511, i = v & 511, j = i >> 3;
        const int u = base + ((i & 7) * 2 + (j >> 5)) * 32 + (j & 31);
        if (u < 1024) {
            const int qb = u & 31, hh = (u >> 5) & 3, b = u >> 7;
            const size_t ro = (size_t)(b * 4 + hh) * SEQ * 64;
            const float slope2 = __int_as_float(__builtin_amdgcn_readfirstlane(__float_as_int(exp2f(-2.0f * (float)(hh + 1)) * LOG2E)));
            attn_unit<64, true>(QC + ro, KC + ro, VC + ro, qb * 128, MIX + (size_t)b * SEQ * 1024 + 768 + hh * 64, slope2, lam, outmul,
                                p.subln + layer * 64, smem, wv);
        } else if (u < 2048) {
            const int w = u - 1024, qb = w & 31, hh = (w >> 5) & 3, b = w >> 7;
            const size_t rq = (size_t)(b * 4 + hh) * SEQ;
            attn_unit<96, false>(QB + rq * 96, KB + rq * 96, VB + rq * 64, qb * 128, MIX + (size_t)b * SEQ * 1024 + 512 + hh * 64, 0.f, 0.f, 0.f, nullptr, smem, wv);
        } else {
            const int w = u - 2048, qb = w & 31, hh = (w >> 5) & 7, b = w >> 8;
            const size_t rq = (size_t)(b * 8 + hh) * SEQ, rk = (size_t)(b * 2 + (hh >> 2)) * SEQ;
            attn_unit<64, false>(QA + rq * 64, KA + rk * 64, VA + rk * 64, qb * 128, MIX + (size_t)b * SEQ * 1024 + hh * 64, 0.f, 0.f, 0.f, nullptr, smem, wv);
        }
    }
}

__global__ void __launch_bounds__(NTHR, 2) mega(Params p) {
    extern __shared__ __attribute__((aligned(16))) unsigned char smem[];
    cg::grid_group grid = cg::this_grid();
    unsigned char* ws = p.ws;
    const int gtid = blockIdx.x * NTHR + threadIdx.x, gthreads = gridDim.x * NTHR;
    const int wv = __builtin_amdgcn_readfirstlane((int)(threadIdx.x >> 6));
    bf16_t* XB = (bf16_t*)(ws + OFF_XB);
    float* SSX = (float*)(ws + OFF_SSX);
    float* tab = (float*)(ws + OFF_TAB);

    for (int l = 0; l < 2; ++l) {
        prep_weight<false>(p.w_in + (size_t)l * 1024 * INW, p.norm_attn + l * 1024, (bf16_t*)(ws + OFF_WIN) + (size_t)l * INWP * 1024, 1024, INW, INWP, gtid, gthreads);
        prep_weight<false>(p.w_uq + (size_t)l * 192 * 384, p.qan_b + l * 192, (bf16_t*)(ws + OFF_WUQ) + (size_t)l * 384 * 192, 192, 384, 384, gtid, gthreads);
        prep_weight<false>(p.w_ukv + (size_t)l * 128 * 512, p.kvn_b + l * 128, (bf16_t*)(ws + OFF_WUKV) + (size_t)l * 512 * 128, 128, 512, 512, gtid, gthreads);
        prep_weight<false>(p.w_out + (size_t)l * 1024 * 1024, nullptr, (bf16_t*)(ws + OFF_WOUT) + (size_t)l * 1024 * 1024, 1024, 1024, 1024, gtid, gthreads);
        prep_weight<true>(p.w_up + (size_t)l * 1024 * DFF2, p.norm_ffn + l * 1024, (bf16_t*)(ws + OFF_WUP) + (size_t)l * DFF2 * 1024, 1024, DFF2, DFF2, gtid, gthreads);
        prep_weight<false>(p.w_down + (size_t)l * DFF * 1024, nullptr, (bf16_t*)(ws + OFF_WDN) + (size_t)l * 1024 * DFF, DFF, 1024, 1024, gtid, gthreads);
    }
    for (int idx = gtid; idx < 1024 + 512; idx += gthreads) {
        if (idx < 1024) { const int pos = idx >> 4, f = idx & 15; const float ang = (float)pos * powf(10000.0f, -(float)f / 16.0f); tab[idx] = cosf(ang); tab[1024 + idx] = sinf(ang); }
        else { const int k = idx - 1024, pos = k >> 3, f = k & 7; const float ang = (float)pos * powf(10000.0f, -(float)f / 8.0f); tab[2048 + k] = cosf(ang); tab[2560 + k] = sinf(ang); }
    }
    convert_x(p.x, XB, SSX, wv);
    grid.sync();

    for (int l = 0; l < 2; ++l) {
        const float lam_init = __int_as_float(__builtin_amdgcn_readfirstlane(__float_as_int((l == 0) ? 0.2f : 0.35550906759096984f)));
        const float* xin = (l == 0) ? p.x : p.out;
        gemm_phase(XB, 1024, (const bf16_t*)(ws + OFF_WIN) + (size_t)l * INWP * 1024, 1024, 1024, M_TOK, INWP, smem,
                   EpiInProj{SSX, tab, p.qn_a + l * 64, p.kn_a + l * 64, (bf16_t*)(ws + OFF_QA), (bf16_t*)(ws + OFF_KA), (bf16_t*)(ws + OFF_VA), (bf16_t*)(ws + OFF_CQ),
                             (bf16_t*)(ws + OFF_CKV), (bf16_t*)(ws + OFF_KB), (bf16_t*)(ws + OFF_QC), (bf16_t*)(ws + OFF_KC), (bf16_t*)(ws + OFF_VC),
                             (float*)(ws + OFF_SSCQ), (float*)(ws + OFF_SSCKV)}, wv);
        grid.sync();
        gemm_phase((const bf16_t*)(ws + OFF_CQ), 192, (const bf16_t*)(ws + OFF_WUQ) + (size_t)l * 384 * 192, 192, 192, M_TOK, 384, smem,
                   EpiMlaQ{(bf16_t*)(ws + OFF_QB), tab, (const float*)(ws + OFF_SSCQ), 0.10206207261596575f * LOG2E}, wv);
        gemm_phase((const bf16_t*)(ws + OFF_CKV), 128, (const bf16_t*)(ws + OFF_WUKV) + (size_t)l * 512 * 128, 128, 128, M_TOK, 512, smem,
                   EpiMlaKV{(bf16_t*)(ws + OFF_KB), (bf16_t*)(ws + OFF_VB), (const float*)(ws + OFF_SSCKV)}, wv);
        grid.sync();
        attn_phase(p, l, lam_init, __int_as_float(__builtin_amdgcn_readfirstlane(__float_as_int((l == 0) ? 0.8f : 0.64449093240903016f))), smem, wv);
        grid.sync();
        gemm_phase((const bf16_t*)(ws + OFF_MIX), 1024, (const bf16_t*)(ws + OFF_WOUT) + (size_t)l * 1024 * 1024, 1024, 1024, M_TOK, 1024, smem, EpiResid2{xin, p.out, XB, SSX}, wv);
        grid.sync();
        up_conv_phase(XB, (const bf16_t*)(ws + OFF_WUP) + (size_t)l * DFF2 * 1024, SSX, p.conv_w + (size_t)l * 3 * DFF2, p.conv_b + (size_t)l * DFF2, (bf16_t*)(ws + OFF_ACT), smem, wv);
        grid.sync();
        gemm_phase((const bf16_t*)(ws + OFF_ACT), DFF, (const bf16_t*)(ws + OFF_WDN) + (size_t)l * 1024 * DFF, DFF, DFF, M_TOK, 1024, smem, EpiResid2{p.out, p.out, XB, SSX}, wv);
        grid.sync();
    }
    final_norm(p.out, p.final_norm, SSX, wv);
}

extern "C" void kernel_launch(void* const* d_in, const int* in_sizes, int n_in, void* d_out, int out_size, void* d_ws, size_t ws_size, hipStream_t stream) {
    static int grid_blocks = 0;
    if (!grid_blocks) {
        int dev = 0, cus = 0, per_cu = 0;
        hipGetDevice(&dev);
        hipDeviceGetAttribute(&cus, hipDeviceAttributeMultiprocessorCount, dev);
        hipFuncSetAttribute((const void*)mega, hipFuncAttributeMaxDynamicSharedMemorySize, SMEM_TOTAL);
        hipOccupancyMaxActiveBlocksPerMultiprocessor(&per_cu, mega, NTHR, SMEM_TOTAL);
        if (per_cu > 2) per_cu = 2;
        if (per_cu < 1) per_cu = 1;
        grid_blocks = (cus * per_cu) & ~7;
    }
    Params p{};
    const float** pp = (const float**)&p;
    for (int i = 0; i < 21; ++i) pp[i] = (const float*)d_in[i];
    p.out = (float*)d_out;
    p.ws = (unsigned char*)d_ws;
    void* args[] = {&p};
    hipError_t e = hipLaunchCooperativeKernel((void*)mega, dim3(grid_blocks), dim3(NTHR), args, SMEM_TOTAL, stream);
    if (e != hipSuccess) fprintf(stderr, "cooperative launch failed: %s (grid %d)\n", hipGetErrorString(e), grid_blocks);
}
```

```cpp
#include <hip/hip_runtime.h>
#include <hip/hip_cooperative_groups.h>
#include <stdint.h>
#include <math.h>
#include <stdio.h>
namespace cg = cooperative_groups;

typedef unsigned short bf16_t;
typedef short bf16x8 __attribute__((ext_vector_type(8)));
typedef short s16x4 __attribute__((ext_vector_type(4)));
typedef float f32x4 __attribute__((ext_vector_type(4)));
typedef float f32x16 __attribute__((ext_vector_type(16)));
typedef unsigned u32x4 __attribute__((ext_vector_type(4)));
typedef unsigned u32x2 __attribute__((ext_vector_type(2)));
typedef __bf16 bf2_t __attribute__((ext_vector_type(2)));
typedef float f32x2 __attribute__((ext_vector_type(2)));
#define DI __device__ __forceinline__

constexpr int M_TOK = 32768, SEQ = 4096, DM = 1024, INW = 1888, INWP = 2048, DFF = 2816, DFF2 = 5632;
constexpr float EPS = 1e-6f;
constexpr float LOG2E = 1.4426950408889634f;
constexpr int NTHR = 512, NWAVE = NTHR / 64;

constexpr size_t SZ_WIN = (size_t)2 * INWP * 1024 * 2, SZ_WUQ = (size_t)2 * 512 * 192 * 2, SZ_WUKV = (size_t)2 * 512 * 128 * 2,
                 SZ_WOUT = (size_t)2 * 1024 * 1024 * 2, SZ_WUP = (size_t)2 * DFF2 * 1024 * 2, SZ_WDN = (size_t)2 * 1024 * DFF * 2;
constexpr size_t OFF_WIN = 0, OFF_WUQ = OFF_WIN + SZ_WIN, OFF_WUKV = OFF_WUQ + SZ_WUQ, OFF_WOUT = OFF_WUKV + SZ_WUKV,
                 OFF_WUP = OFF_WOUT + SZ_WOUT, OFF_WDN = OFF_WUP + SZ_WUP, OFF_TAB = OFF_WDN + SZ_WDN, OFF_XB = OFF_TAB + 16384;
constexpr size_t OFF_SSX = OFF_XB + (size_t)M_TOK * 1024 * 2, OFF_SSCQ = OFF_SSX + (size_t)M_TOK * 16 * 4, OFF_SSCKV = OFF_SSCQ + (size_t)M_TOK * 4 * 4,
                 OFF_BIG = OFF_SSCKV + (size_t)M_TOK * 2 * 4;
constexpr size_t OFF_QA = OFF_BIG, OFF_KA = OFF_QA + (size_t)M_TOK * 512 * 2,
                 OFF_VA = OFF_KA + (size_t)M_TOK * 128 * 2, OFF_CQ = OFF_VA + (size_t)M_TOK * 128 * 2, OFF_CKV = OFF_CQ + (size_t)M_TOK * 192 * 2,
                 OFF_QB = OFF_CKV + (size_t)M_TOK * 128 * 2, OFF_KB = OFF_QB + (size_t)M_TOK * 384 * 2, OFF_VB = OFF_KB + (size_t)M_TOK * 384 * 2,
                 OFF_QC = OFF_VB + (size_t)M_TOK * 256 * 2, OFF_KC = OFF_QC + (size_t)M_TOK * 256 * 2, OFF_VC = OFF_KC + (size_t)M_TOK * 256 * 2,
                 OFF_MIX = OFF_VC + (size_t)M_TOK * 256 * 2, OFF_END1 = OFF_MIX + (size_t)M_TOK * 1024 * 2;
constexpr size_t OFF_ACT = OFF_BIG, OFF_END2 = OFF_ACT + (size_t)M_TOK * DFF * 2;
static_assert(OFF_END1 <= (size_t)512 * 1024 * 1024 && OFF_END2 <= (size_t)512 * 1024 * 1024, "workspace");

struct Params {
    const float *x, *norm_attn, *w_in, *qn_a, *kn_a, *qan_b, *w_uq, *kvn_b, *w_ukv, *lq1, *lk1, *lq2, *lk2, *subln, *w_out, *norm_ffn, *w_up,
        *conv_w, *conv_b, *w_down, *final_norm;
    float* out;
    unsigned char* ws;
};

DI unsigned pk2(float a, float b) { f32x2 v = {a, b}; bf2_t r = __builtin_convertvector(v, bf2_t); return __builtin_bit_cast(unsigned, r); }
DI void unpack8(u32x4 r, float* v) {
    v[0] = __uint_as_float(r.x << 16); v[1] = __uint_as_float(r.x & 0xffff0000u);
    v[2] = __uint_as_float(r.y << 16); v[3] = __uint_as_float(r.y & 0xffff0000u);
    v[4] = __uint_as_float(r.z << 16); v[5] = __uint_as_float(r.z & 0xffff0000u);
    v[6] = __uint_as_float(r.w << 16); v[7] = __uint_as_float(r.w & 0xffff0000u);
}
DI u32x4 pack8(const float* v) { u32x4 r; r.x = pk2(v[0], v[1]); r.y = pk2(v[2], v[3]); r.z = pk2(v[4], v[5]); r.w = pk2(v[6], v[7]); return r; }
DI int tid_opaque(int wv) { int t; asm volatile("v_mbcnt_lo_u32_b32 %0, -1, 0\n\tv_mbcnt_hi_u32_b32 %0, -1, %0" : "=v"(t)); return t | (wv << 6); }
DI int bid_opaque() { int b = blockIdx.x; asm volatile("" : "+s"(b)); return b; }
DI float shflx(float v, int mask, int lane) { return __int_as_float(__builtin_amdgcn_ds_bpermute((lane ^ mask) << 2, __float_as_int(v))); }
DI float wave_sum(float v, int lane) {
#pragma unroll
    for (int o = 32; o >= 1; o >>= 1) v += shflx(v, o, lane);
    return v;
}

template <bool UPPERM>
DI void prep_weight(const float* __restrict__ W, const float* __restrict__ gain, bf16_t* __restrict__ Wt, int K, int N, int Npad, int gtid, int gthreads) {
    const int total = Npad * (K / 8);
    for (int idx = gtid; idx < total; idx += gthreads) {
        const int n = idx % Npad, kc = idx / Npad;
        int ns = n;
        if (UPPERM) { const int j = n >> 8, r = n & 255; ns = (r < 128) ? (128 * j + r) : (DFF + 128 * j + r - 128); }
        float v[8];
#pragma unroll
        for (int j = 0; j < 8; ++j) { const int k = kc * 8 + j; v[j] = (n < N) ? W[(size_t)k * N + ns] * (gain ? gain[k] : 1.0f) : 0.f; }
        *(u32x4*)(Wt + (size_t)n * K + kc * 8) = pack8(v);
    }
}

DI void convert_x(const float* X, bf16_t* XB, float* SSX, int wv) {
    const int tid_ = tid_opaque(wv);
    const int lane = tid_ & 63, gw = bid_opaque() * NWAVE + (tid_ >> 6), nw = gridDim.x * NWAVE;
    for (int row = gw; row < M_TOK; row += nw) {
        const f32x4* xr = (const f32x4*)(X + (size_t)row * 1024);
        float ss = 0.f;
#pragma unroll
        for (int i = 0; i < 4; ++i) {
            const f32x4 v = xr[lane + 64 * i];
            ss += v[0] * v[0] + v[1] * v[1] + v[2] * v[2] + v[3] * v[3];
            u32x2 w; w.x = pk2(v[0], v[1]); w.y = pk2(v[2], v[3]);
            *(u32x2*)(XB + (size_t)row * 1024 + (lane + 64 * i) * 4) = w;
        }
        ss = wave_sum(ss, lane);
        if (lane < 16) SSX[(size_t)row * 16 + lane] = (lane == 0) ? ss : 0.f;
    }
}
DI void final_norm(float* X, const float* __restrict__ g, const float* SSX, int wv) {
    const int tid_ = tid_opaque(wv);
    const int lane = tid_ & 63, gw = bid_opaque() * NWAVE + (tid_ >> 6), nw = gridDim.x * NWAVE;
    for (int row = gw; row < M_TOK; row += nw) {
        float ss = (lane < 16) ? SSX[(size_t)row * 16 + lane] : 0.f;
        ss = wave_sum(ss, lane);
        const float rstd = rsqrtf(ss * (1.0f / 1024.0f) + EPS);
        f32x4* xr = (f32x4*)(X + (size_t)row * 1024);
#pragma unroll
        for (int i = 0; i < 4; ++i) { const f32x4 gv = ((const f32x4*)g)[lane + 64 * i]; xr[lane + 64 * i] = xr[lane + 64 * i] * rstd * gv; }
    }
}
DI float row_rstd(const float* ssx, int m) {
    const f32x4* pp = (const f32x4*)(ssx + (size_t)m * 16);
    const f32x4 a = (pp[0] + pp[1]) + (pp[2] + pp[3]);
    return rsqrtf(((a[0] + a[1]) + (a[2] + a[3])) * (1.0f / 1024.0f) + EPS);
}

constexpr int GSTR = 128, GOP = 256 * GSTR;
constexpr int SMEM_BYTES = 4 * GOP;
constexpr int SMEM_CONV = 256 * 132 * 4;
constexpr int SMEM_TOTAL = SMEM_CONV > SMEM_BYTES ? SMEM_CONV : SMEM_BYTES;

DI void gemm_mainloop(const bf16_t* const (&gap)[4], const bool (&av)[4], const bf16_t* __restrict__ gb, int ldb, int nk, unsigned char* smem, f32x4 (&acc)[8][4], int tid) {
    const int lane = tid & 63, wid = tid >> 6, wr = wid >> 2, wc = wid & 3;
    const int lrow = tid >> 3, lc = tid & 7;
    u32x4 ra[4], rb[4];
#pragma unroll
    for (int i = 0; i < 8; ++i)
#pragma unroll
        for (int j = 0; j < 4; ++j) acc[i][j] = (f32x4){0.f, 0.f, 0.f, 0.f};
    const u32x4 zero4 = {0u, 0u, 0u, 0u};
#define G_LOAD(KT) { _Pragma("unroll") for (int i = 0; i < 4; ++i) { const u32x4 t_ = *(const u32x4*)(gap[i] + (KT) * 64); ra[i] = av[i] ? t_ : zero4; rb[i] = *(const u32x4*)(gb + (size_t)i * 64 * ldb + (KT) * 64); } }
#define G_WRITE(BUF) { int so_ = (BUF) * 2 * GOP + wboff; asm volatile("" : "+v"(so_)); unsigned char* wb_ = smem + so_; _Pragma("unroll") for (int i = 0; i < 4; ++i) { *(u32x4*)(wb_ + i * 64 * GSTR) = ra[i]; *(u32x4*)(wb_ + GOP + i * 64 * GSTR) = rb[i]; } }
    const int wboff = lrow * GSTR + ((lc ^ (lrow & 7)) << 4);
    const int foff = (lane & 15) * GSTR;
    const int fsw[2] = {(((lane >> 4)) ^ (lane & 7)) << 4, (((lane >> 4) + 4) ^ (lane & 7)) << 4};
    G_LOAD(0);
    G_WRITE(0);
    __syncthreads();
    for (int kt = 0; kt < nk; ++kt) {
        { const int kl = (kt + 1 < nk) ? kt + 1 : nk - 1; G_LOAD(kl); }
        const unsigned char* sa = smem + (kt & 1) * 2 * GOP + wr * 128 * GSTR + foff;
        const unsigned char* sb = smem + (kt & 1) * 2 * GOP + GOP + wc * 64 * GSTR + foff;
#pragma unroll
        for (int kk = 0; kk < 2; ++kk) {
            bf16x8 af[8], bfr[4];
#pragma unroll
            for (int i = 0; i < 4; ++i) bfr[i] = *(const bf16x8*)(sb + i * 16 * GSTR + fsw[kk]);
#pragma unroll
            for (int i = 0; i < 8; ++i) af[i] = *(const bf16x8*)(sa + i * 16 * GSTR + fsw[kk]);
            __builtin_amdgcn_s_setprio(1);
#pragma unroll
            for (int mi = 0; mi < 8; ++mi)
#pragma unroll
                for (int ni = 0; ni < 4; ++ni) acc[mi][ni] = __builtin_amdgcn_mfma_f32_16x16x32_bf16(bfr[ni], af[mi], acc[mi][ni], 0, 0, 0);
            __builtin_amdgcn_s_setprio(0);
        }
        G_WRITE((kt + 1) & 1);
        __syncthreads();
    }
#undef G_LOAD
#undef G_WRITE
}

template <class Epi>
DI void gemm_tile(const bf16_t* __restrict__ A, int lda, const bf16_t* __restrict__ Bt, int ldb, int K, int m0, int n0, unsigned char* smem, const Epi& epi, int wv) {
    const int tid = tid_opaque(wv), lane = tid & 63, wid = tid >> 6, wr = wid >> 2, wc = wid & 3;
    const int lrow = tid >> 3, lc = tid & 7;
    const bf16_t* gap[4];
    const bool av[4] = {true, true, true, true};
#pragma unroll
    for (int i = 0; i < 4; ++i) gap[i] = A + (size_t)(m0 + lrow + 64 * i) * lda + lc * 8;
    const bf16_t* gb = Bt + (size_t)(n0 + lrow) * ldb + lc * 8;
    f32x4 acc[8][4];
    gemm_mainloop(gap, av, gb, ldb, K / 64, smem, acc, tid);
    epi(acc, m0 + wr * 128, n0 + wc * 64, lane);
}

template <class Epi>
DI void gemm_phase(const bf16_t* A, int lda, const bf16_t* Bt, int ldb, int K, int Mrows, int Ncols, unsigned char* smem, const Epi& epi, int wv) {
    const int nN = Ncols / 256, nM = Mrows / 256;
    const int bid = bid_opaque(), G = gridDim.x;
    const int xcd = bid & 7, lb = bid >> 3, nlb = G >> 3, mper = nM >> 3, nloc = mper * nN;
    for (int j = lb; j < nloc; j += nlb) {
        const int g = j / (4 * nN), rem = j - g * 4 * nN;
        const int mt = xcd * mper + g * 4 + (rem & 3), nt = rem >> 2;
        gemm_tile(A, lda, Bt, ldb, K, mt * 256, nt * 256, smem, epi, wv);
    }
}

DI float dot4(f32x4 a) { return (a[0] * a[0] + a[1] * a[1]) + (a[2] * a[2] + a[3] * a[3]); }
DI void st4bf(bf16_t* dst, f32x4 v) { u32x2 w; w.x = pk2(v[0], v[1]); w.y = pk2(v[2], v[3]); *(u32x2*)dst = w; }

struct EpiResid2 {
    const float* Xin; float* Xout; bf16_t* XB; float* SSX;
    DI void operator()(const f32x4 (&acc)[8][4], int mb, int nb, int lane) const {
        const int q = lane >> 4;
#pragma unroll
        for (int mi = 0; mi < 8; ++mi) {
            const int m = mb + mi * 16 + (lane & 15);
            float ss = 0.f;
#pragma unroll
            for (int ni = 0; ni < 4; ++ni) {
                const size_t o = (size_t)m * 1024 + nb + ni * 16 + q * 4;
                f32x4 r = *(const f32x4*)(Xin + o);
                r += acc[mi][ni];
                *(f32x4*)(Xout + o) = r;
                st4bf(XB + o, r);
                ss += dot4(r);
            }
            ss += shflx(ss, 16, lane); ss += shflx(ss, 32, lane);
            if (q == 0) SSX[(size_t)m * 16 + (nb >> 6)] = ss;
        }
    }
};

struct EpiInProj {
    const float *ssx, *tab, *gq, *gk;
    bf16_t *QA, *KA, *VA, *CQ, *CKV, *KB, *QC, *KC, *VC;
    float *sscq, *ssckv;
    DI void operator()(const f32x4 (&acc)[8][4], int mb, int nb, int lane) const {
        const int q = lane >> 4, ml = lane & 15;
        const float qsA = 0.125f * LOG2E, qsC = 0.17677669529663687f * LOG2E;
        if (nb < 640) {
            const bool isq = nb < 512;
            const int head = isq ? (nb >> 6) : ((nb - 512) >> 6);
            const float* g = isq ? gq : gk;
            f32x4 gv[4];
#pragma unroll
            for (int ni = 0; ni < 4; ++ni) gv[ni] = *(const f32x4*)(g + ni * 16 + q * 4);
#pragma unroll
            for (int mi = 0; mi < 8; ++mi) {
                const int m = mb + mi * 16 + ml, b = m >> 12, s = m & 4095;
                const float rs = row_rstd(ssx, m);
                f32x4 v[4];
                float ss = 0.f;
#pragma unroll
                for (int ni = 0; ni < 4; ++ni) { v[ni] = acc[mi][ni] * rs; ss += dot4(v[ni]); }
                ss += shflx(ss, 16, lane); ss += shflx(ss, 32, lane);
                const float r2 = rsqrtf(ss * (1.0f / 64.0f) + EPS);
#pragma unroll
                for (int ni = 0; ni < 4; ++ni) v[ni] = v[ni] * r2 * gv[ni];
                const float* tr = tab + (s >> 6) * 16 + q * 4;
                const float* tq = tab + (s & 63) * 16 + q * 4;
                const f32x4 c0 = *(const f32x4*)tr, s0 = *(const f32x4*)(tr + 1024), c1 = *(const f32x4*)tq, s1 = *(const f32x4*)(tq + 1024);
                f32x4 o0 = v[0] * c0 - v[1] * s0, o1 = v[1] * c0 + v[0] * s0, o2 = v[2] * c1 - v[3] * s1, o3 = v[3] * c1 + v[2] * s1;
                bf16_t* dst;
                if (isq) { o0 *= qsA; o1 *= qsA; o2 *= qsA; o3 *= qsA; dst = QA + ((size_t)(b * 8 + head) * SEQ + s) * 64 + q * 4; }
                else dst = KA + ((size_t)(b * 2 + head) * SEQ + s) * 64 + q * 4;
                st4bf(dst, o0); st4bf(dst + 16, o1); st4bf(dst + 32, o2); st4bf(dst + 48, o3);
            }
        } else if (nb < 768) {
            const int head = (nb - 640) >> 6;
#pragma unroll
            for (int mi = 0; mi < 8; ++mi) {
                const int m = mb + mi * 16 + ml, b = m >> 12, s = m & 4095;
                const float rs = row_rstd(ssx, m);
                bf16_t* dst = VA + ((size_t)(b * 2 + head) * SEQ + s) * 64 + q * 4;
#pragma unroll
                for (int ni = 0; ni < 4; ++ni) st4bf(dst + ni * 16, acc[mi][ni] * rs);
            }
        } else {
            const bool sq = nb < 1088;
#pragma unroll
            for (int mi = 0; mi < 8; ++mi) {
                const int m = mb + mi * 16 + ml, b = m >> 12, s = m & 4095;
                const float rs = row_rstd(ssx, m);
                float ss = 0.f;
#pragma unroll
                for (int ni = 0; ni < 4; ++ni) {
                    const int n16 = nb + ni * 16;
                    f32x4 v = acc[mi][ni] * rs;
                    if (n16 < 960) { st4bf(CQ + (size_t)m * 192 + (n16 - 768) + q * 4, v); ss += dot4(v); }
                    else if (n16 < 1088) { st4bf(CKV + (size_t)m * 128 + (n16 - 960) + q * 4, v); ss += dot4(v); }
                    else if (n16 < 1120) {
                        f32x4 pr;
#pragma unroll
                        for (int i = 0; i < 4; ++i) pr[i] = shflx(v[i], 32, lane);
                        const int pos = (n16 >= 1104) ? (s & 63) : (s >> 6);
                        const float* tc = tab + 2048 + pos * 8 + (q & 1) * 4;
                        const f32x4 c = *(const f32x4*)tc, sn = *(const f32x4*)(tc + 512);
                        const f32x4 o = (q < 2) ? (v * c - pr * sn) : (v * c + pr * sn);
#pragma unroll
                        for (int hh = 0; hh < 4; ++hh) st4bf(KB + ((size_t)(b * 4 + hh) * SEQ + s) * 96 + 64 + (n16 - 1088) + q * 4, o);
                    } else if (n16 < 1376) { const int c = n16 - 1120 + q * 4; st4bf(QC + ((size_t)(b * 4 + (c >> 6)) * SEQ + s) * 64 + (c & 63), v * qsC); }
                    else if (n16 < 1632) { const int c = n16 - 1376 + q * 4; st4bf(KC + ((size_t)(b * 4 + (c >> 6)) * SEQ + s) * 64 + (c & 63), v); }
                    else if (n16 < 1888) { const int c = n16 - 1632 + q * 4; st4bf(VC + ((size_t)(b * 4 + (c >> 6)) * SEQ + s) * 64 + (c & 63), v); }
                }
                if (sq) {
                    ss += shflx(ss, 16, lane); ss += shflx(ss, 32, lane);
                    if (q == 0) { if (nb < 960) sscq[(size_t)m * 4 + ((nb - 768) >> 6)] = ss; else ssckv[(size_t)m * 2 + ((nb - 960) >> 6)] = ss; }
                }
            }
        }
    }
};
struct EpiMlaQ {
    bf16_t* QB; const float* tab; const float* sscq; float qscale;
    DI void operator()(const f32x4 (&acc)[8][4], int mb, int nb, int lane) const {
#pragma unroll
        for (int mi = 0; mi < 8; ++mi) {
            const int m = mb + mi * 16 + (lane & 15), q = lane >> 4, b = m >> 12, s = m & 4095;
            const f32x4 sp = *(const f32x4*)(sscq + (size_t)m * 4);
            const float rs = rsqrtf((sp[0] + sp[1] + sp[2]) * (1.0f / 192.0f) + EPS) * qscale;
#pragma unroll
            for (int ni = 0; ni < 4; ++ni) {
                const int nt = nb + ni * 16;
                if (nt >= 384) continue;
                const int head = nt / 96, dt = nt - head * 96;
                f32x4 v = acc[mi][ni] * rs;
                f32x4 pr;
#pragma unroll
                for (int i = 0; i < 4; ++i) pr[i] = shflx(v[i], 32, lane);
                if (dt >= 64) {
                    const int pos = (dt >= 80) ? (s & 63) : (s >> 6);
                    const float* tc = tab + 2048 + pos * 8 + (q & 1) * 4;
                    const f32x4 c = *(const f32x4*)tc, sn = *(const f32x4*)(tc + 512);
                    v = (q < 2) ? (v * c - pr * sn) : (v * c + pr * sn);
                }
                st4bf(QB + ((size_t)(b * 4 + head) * SEQ + s) * 96 + dt + q * 4, v);
            }
        }
    }
};
struct EpiMlaKV {
    bf16_t* KB; bf16_t* VB; const float* ssckv;
    DI void operator()(const f32x4 (&acc)[8][4], int mb, int nb, int lane) const {
#pragma unroll
        for (int mi = 0; mi < 8; ++mi) {
            const int m = mb + mi * 16 + (lane & 15), b = m >> 12, s = m & 4095;
            const f32x2 sp = *(const f32x2*)(ssckv + (size_t)m * 2);
            const float rs = rsqrtf((sp[0] + sp[1]) * (1.0f / 128.0f) + EPS);
#pragma unroll
            for (int ni = 0; ni < 4; ++ni) {
                const int n = nb + ni * 16 + (lane >> 4) * 4;
                const int head = n >> 7, d = n & 127;
                const size_t rowi = (size_t)(b * 4 + head) * SEQ + s;
                if (d < 64) st4bf(KB + rowi * 96 + d, acc[mi][ni] * rs);
                else st4bf(VB + rowi * 64 + (d - 64), acc[mi][ni] * rs);
            }
        }
    }
};

DI void up_conv_tile(const bf16_t* __restrict__ XB, const bf16_t* __restrict__ Wt, const float* __restrict__ ssx, const float* __restrict__ cw, const float* __restrict__ cb,
                     bf16_t* __restrict__ ACT, int b, int jt, int nt, unsigned char* smem, int wv) {
    const int tid = tid_opaque(wv), lane = tid & 63, wid = tid >> 6, wr = wid >> 2, wc = wid & 3;
    const int lrow = tid >> 3, lc = tid & 7;
    const int tbase = jt * 254 - 1;
    const bf16_t* gap[4];
    bool av[4];
#pragma unroll
    for (int i = 0; i < 4; ++i) {
        const int tl = tbase + lrow + 64 * i;
        av[i] = (unsigned)tl < 4096u;
        const int tc = tl < 0 ? 0 : (tl > 4095 ? 4095 : tl);
        gap[i] = XB + ((size_t)b * SEQ + tc) * 1024 + lc * 8;
    }
    const bf16_t* gb = Wt + (size_t)(nt * 256 + lrow) * 1024 + lc * 8;
    f32x4 acc[8][4];
    gemm_mainloop(gap, av, gb, 1024, 16, smem, acc, tid);
    float* T = (float*)smem;
    const int q = lane >> 4, ml = lane & 15;
    float rs[8];
#pragma unroll
    for (int mi = 0; mi < 8; ++mi) {
        const int tl = tbase + wr * 128 + mi * 16 + ml;
        const int tc = tl < 0 ? 0 : (tl > 4095 ? 4095 : tl);
        rs[mi] = row_rstd(ssx, b * SEQ + tc);
    }
#pragma unroll
    for (int h = 0; h < 2; ++h) {
        if ((wc & 1) == h) {
#pragma unroll
            for (int mi = 0; mi < 8; ++mi)
#pragma unroll
                for (int ni = 0; ni < 4; ++ni) *(f32x4*)(T + (wr * 128 + mi * 16 + ml) * 132 + (wc >> 1) * 64 + ni * 16 + q * 4) = acc[mi][ni] * rs[mi];
        }
        __syncthreads();
        {
            const int cq = tid & 15, rg = tid >> 4, ch = nt * 128 + h * 64 + cq * 4;
            const f32x4 wg0 = *(const f32x4*)(cw + ch), wg1 = *(const f32x4*)(cw + DFF2 + ch), wg2 = *(const f32x4*)(cw + 2 * DFF2 + ch), bg = *(const f32x4*)(cb + ch);
            const f32x4 wv0 = *(const f32x4*)(cw + DFF + ch), wv1 = *(const f32x4*)(cw + DFF2 + DFF + ch), wv2 = *(const f32x4*)(cw + 2 * DFF2 + DFF + ch), bv = *(const f32x4*)(cb + DFF + ch);
            const int r0 = rg * 8, rm = r0 > 0 ? r0 - 1 : 0;
            f32x4 gm = *(const f32x4*)(T + rm * 132 + cq * 4), vm = *(const f32x4*)(T + rm * 132 + 64 + cq * 4);
            f32x4 g0 = *(const f32x4*)(T + r0 * 132 + cq * 4), v0 = *(const f32x4*)(T + r0 * 132 + 64 + cq * 4);
#pragma unroll
            for (int rr = 0; rr < 8; ++rr) {
                const int r = r0 + rr, rp = r < 255 ? r + 1 : 255;
                const f32x4 gp = *(const f32x4*)(T + rp * 132 + cq * 4), vp = *(const f32x4*)(T + rp * 132 + 64 + cq * 4);
                const f32x4 gg = wg0 * gm + wg1 * g0 + wg2 * gp + bg;
                const f32x4 vv = wv0 * vm + wv1 * v0 + wv2 * vp + bv;
                f32x4 o;
#pragma unroll
                for (int e = 0; e < 4; ++e) o[e] = gg[e] / (1.0f + __expf(-gg[e])) * vv[e];
                const int tl = tbase + r;
                if (r >= 1 && r <= 254 && tl <= 4095) st4bf(ACT + ((size_t)b * SEQ + tl) * DFF + ch, o);
                gm = g0; g0 = gp; vm = v0; v0 = vp;
            }
        }
        __syncthreads();
    }
}
DI void up_conv_phase(const bf16_t* XB, const bf16_t* Wt, const float* ssx, const float* cw, const float* cb, bf16_t* ACT, unsigned char* smem, int wv) {
    constexpr int NT = DFF / 128, MT = 17;
    const int bid = bid_opaque(), G = gridDim.x;
    const int xcd = bid & 7, lb = bid >> 3, nlb = G >> 3, nloc = MT * NT, full = (MT / 4) * 4 * NT, gs = MT - (MT / 4) * 4;
    for (int j = lb; j < nloc; j += nlb) {
        int jt, nt;
        if (j < full) { const int g = j / (4 * NT), rem = j - g * 4 * NT; jt = g * 4 + (rem & 3); nt = rem >> 2; }
        else { const int j2 = j - full; jt = (MT / 4) * 4 + j2 % gs; nt = j2 / gs; }
        up_conv_tile(XB, Wt, ssx, cw, cb, ACT, xcd, jt, nt, smem, wv);
    }
}

constexpr int ATT_STAGE = 64 * 208 + 8192;

template <int DQK, bool DIFF>
DI void attn_unit(const bf16_t* __restrict__ Qg, const bf16_t* __restrict__ Kg, const bf16_t* __restrict__ Vg, int q0, bf16_t* __restrict__ outp,
                  float slope2, float lam, float outmul, const float* __restrict__ subln, unsigned char* smem, int wv) {
    constexpr int NQT = DIFF ? 2 : 1, KS = DIFF ? 2 : DQK / 16, KSTR = DQK * 2 + 16, CPR = DQK / 8, KCH = (64 * CPR + NTHR - 1) / NTHR, KBYTES = 64 * 208;
    const int tid = tid_opaque(wv), lane = tid & 63, wid = tid >> 6, r = lane & 31, h = lane >> 5;
    const int qrow = q0 + wid * 32 + r;
    bf16x8 qf[NQT][KS];
#pragma unroll
    for (int qt = 0; qt < NQT; ++qt)
#pragma unroll
        for (int ks = 0; ks < KS; ++ks) qf[qt][ks] = *(const bf16x8*)(Qg + (size_t)qrow * DQK + qt * 32 + ks * 16 + h * 8);
    f32x16 O[NQT][2];
    float mrun[NQT], lsum[NQT];
#pragma unroll
    for (int qt = 0; qt < NQT; ++qt) {
        mrun[qt] = -1e30f; lsum[qt] = 0.f;
#pragma unroll
        for (int d = 0; d < 2; ++d)
#pragma unroll
            for (int i = 0; i < 16; ++i) O[qt][d][i] = 0.f;
    }
    int koff[KCH], voff;
    bool kval[KCH];
#pragma unroll
    for (int i = 0; i < KCH; ++i) { const int id = tid + NTHR * i, key = id / CPR, c = id % CPR; koff[i] = key * KSTR + c * 16; kval[i] = id < 64 * CPR; }
    { const int key = tid >> 3, c = tid & 7; voff = KBYTES + key * 128 + ((c ^ (((key >> 1) & 1) << 2)) * 16); }
    u32x4 rk[KCH], rv;
#pragma unroll
    for (int i = 0; i < KCH; ++i) if (kval[i]) rk[i] = *(const u32x4*)(Kg + (size_t)(tid + NTHR * i) * 8);
    rv = *(const u32x4*)(Vg + (size_t)tid * 8);
#pragma unroll
    for (int i = 0; i < KCH; ++i) if (kval[i]) *(u32x4*)(smem + koff[i]) = rk[i];
    *(u32x4*)(smem + voff) = rv;
    __syncthreads();
    const int kfo = r * KSTR + h * 16;
    const int qq = (lane >> 2) & 3;
    const int colb0 = ((qq >> 1) & 1) * 64 + 32 * ((lane >> 4) & 1) + 8 * (lane & 3);
    const int vfo0 = KBYTES + (4 * h + qq) * 128 + colb0, vfo1 = KBYTES + (4 * h + qq) * 128 + (colb0 ^ 64);
    const float qpos = (float)qrow;

    for (int kt = 0; kt < SEQ / 64; ++kt) {
        const unsigned char* cur = smem + (kt & 1) * ATT_STAGE;
        const bool more = (kt + 1 < SEQ / 64);
        {
            const int kn = more ? kt + 1 : kt;
#pragma unroll
            for (int i = 0; i < KCH; ++i) if (kval[i]) rk[i] = *(const u32x4*)(Kg + (size_t)kn * 64 * DQK + (size_t)(tid + NTHR * i) * 8);
            rv = *(const u32x4*)(Vg + (size_t)kn * 64 * 64 + (size_t)tid * 8);
        }
#pragma unroll
        for (int qt = 0; qt < NQT; ++qt) {
            bf16x8 pf[2][2];
            f32x16 S[2];
#pragma unroll
            for (int kh = 0; kh < 2; ++kh) {
#pragma unroll
                for (int i = 0; i < 16; ++i) S[kh][i] = 0.f;
#pragma unroll
                for (int ks = 0; ks < KS; ++ks) {
                    const bf16x8 kf = *(const bf16x8*)(cur + kfo + kh * 32 * KSTR + (qt * 32 + ks * 16) * 2);
                    S[kh] = __builtin_amdgcn_mfma_f32_32x32x16_bf16(kf, qf[qt][ks], S[kh], 0, 0, 0);
                }
            }
            if (DIFF) {
#pragma unroll
                for (int kh = 0; kh < 2; ++kh)
#pragma unroll
                    for (int i = 0; i < 16; ++i) {
                        const float kpos = (float)(kt * 64 + kh * 32 + (i & 3) + 8 * (i >> 2) + 4 * h);
                        S[kh][i] -= slope2 * fabsf(qpos - kpos);
                    }
            }
            float mx = S[0][0];
#pragma unroll
            for (int kh = 0; kh < 2; ++kh)
#pragma unroll
                for (int i = 0; i < 16; ++i) mx = fmaxf(mx, S[kh][i]);
            mx = fmaxf(mx, shflx(mx, 32, lane));
            const float mnew = fmaxf(mrun[qt], mx);
            const float alpha = __builtin_amdgcn_exp2f(mrun[qt] - mnew);
            mrun[qt] = mnew;
            float ps = 0.f;
#pragma unroll
            for (int kh = 0; kh < 2; ++kh)
#pragma unroll
                for (int i = 0; i < 16; ++i) { const float pv = __builtin_amdgcn_exp2f(S[kh][i] - mnew); S[kh][i] = pv; ps += pv; }
            lsum[qt] = lsum[qt] * alpha + ps;
#pragma unroll
            for (int d = 0; d < 2; ++d)
#pragma unroll
                for (int i = 0; i < 16; ++i) O[qt][d][i] *= alpha;
#pragma unroll
            for (int kh = 0; kh < 2; ++kh)
#pragma unroll
                for (int s2 = 0; s2 < 2; ++s2) {
                    u32x4 w;
                    w.x = pk2(S[kh][8 * s2 + 0], S[kh][8 * s2 + 1]); w.y = pk2(S[kh][8 * s2 + 2], S[kh][8 * s2 + 3]);
                    w.z = pk2(S[kh][8 * s2 + 4], S[kh][8 * s2 + 5]); w.w = pk2(S[kh][8 * s2 + 6], S[kh][8 * s2 + 7]);
                    pf[kh][s2] = __builtin_bit_cast(bf16x8, w);
                }
#pragma unroll
            for (int kh = 0; kh < 2; ++kh)
#pragma unroll
                for (int s2 = 0; s2 < 2; ++s2)
#pragma unroll
                    for (int d = 0; d < 2; ++d) {
                        const unsigned char* va = cur + (d ? vfo1 : vfo0) + (kh * 32 + 16 * s2) * 128;
                        const s16x4 lo = __builtin_amdgcn_ds_read_tr16_b64_v4i16((__attribute__((address_space(3))) s16x4*)(va));
                        const s16x4 hi = __builtin_amdgcn_ds_read_tr16_b64_v4i16((__attribute__((address_space(3))) s16x4*)(va + 8 * 128));
                        const bf16x8 vf = __builtin_shufflevector(lo, hi, 0, 1, 2, 3, 4, 5, 6, 7);
                        O[qt][d] = __builtin_amdgcn_mfma_f32_32x32x16_bf16(vf, pf[kh][s2], O[qt][d], 0, 0, 0);
                    }
            if (DIFF) __builtin_amdgcn_sched_barrier(0);
        }
        {
            unsigned char* nx = smem + ((kt + 1) & 1) * ATT_STAGE;
#pragma unroll
            for (int i = 0; i < KCH; ++i) if (kval[i]) *(u32x4*)(nx + koff[i]) = rk[i];
            *(u32x4*)(nx + voff) = rv;
        }
        __syncthreads();
    }
    const int tid2 = tid_opaque(wv), lane2 = tid2 & 63;
    const int h2 = lane2 >> 5;
    float inv[NQT];
#pragma unroll
    for (int qt = 0; qt < NQT; ++qt) { const float lt = lsum[qt] + shflx(lsum[qt], 32, lane2); inv[qt] = 1.0f / lt; }
    float o[2][16];
    if (DIFF) {
        float ss = 0.f;
#pragma unroll
        for (int d = 0; d < 2; ++d)
#pragma unroll
            for (int i = 0; i < 16; ++i) { const float x = O[0][d][i] * inv[0] - lam * (O[NQT - 1][d][i] * inv[NQT - 1]); o[d][i] = x; ss += x * x; }
        ss += shflx(ss, 32, lane2);
        const float rstd = rsqrtf(ss * (1.0f / 64.0f) + EPS) * outmul;
#pragma unroll
        for (int d = 0; d < 2; ++d)
#pragma unroll
            for (int i = 0; i < 16; ++i) o[d][i] *= rstd * subln[d * 32 + (i & 3) + 8 * (i >> 2) + 4 * h2];
    } else {
#pragma unroll
        for (int d = 0; d < 2; ++d)
#pragma unroll
            for (int i = 0; i < 16; ++i) o[d][i] = O[0][d][i] * inv[0];
    }
    const int qrow2 = q0 + (lane2 & 31) + ((tid2 >> 6) << 5);
    bf16_t* orow = outp + (size_t)qrow2 * 1024;
#pragma unroll
    for (int d = 0; d < 2; ++d)
#pragma unroll
        for (int g = 0; g < 4; ++g) {
            u32x2 w; w.x = pk2(o[d][4 * g], o[d][4 * g + 1]); w.y = pk2(o[d][4 * g + 2], o[d][4 * g + 3]);
            *(u32x2*)(orow + d * 32 + 8 * g + 4 * h2) = w;
        }
}

DI void attn_phase(const Params& p, int layer, float lam_init, float outmul, unsigned char* smem, int wv) {
    unsigned char* ws = p.ws;
    const bf16_t *QA = (const bf16_t*)(ws + OFF_QA), *KA = (const bf16_t*)(ws + OFF_KA), *VA = (const bf16_t*)(ws + OFF_VA), *QB = (const bf16_t*)(ws + OFF_QB),
                 *KB = (const bf16_t*)(ws + OFF_KB), *VB = (const bf16_t*)(ws + OFF_VB), *QC = (const bf16_t*)(ws + OFF_QC), *KC = (const bf16_t*)(ws + OFF_KC),
                 *VC = (const bf16_t*)(ws + OFF_VC);
    bf16_t* MIX = (bf16_t*)(ws + OFF_MIX);
    float s1 = 0.f, s2 = 0.f;
    for (int j = 0; j < 32; ++j) { s1 += p.lq1[layer * 32 + j] * p.lk1[layer * 32 + j]; s2 += p.lq2[layer * 32 + j] * p.lk2[layer * 32 + j]; }
    const float lam = __int_as_float(__builtin_amdgcn_readfirstlane(__float_as_int(expf(s1) - expf(s2) + lam_init)));
    for (int v = bid_opaque(); v < 2048; v += gridDim.x) {
        const int base = v & ~255, i = v & 255, j = i >> 3;
        const int u = base + ((i & 7) * 2 + (j >> 4)) * 16 + (j & 15);
        if (u < 512) {
            const int qb = u & 15, hh = (u >> 4) & 3, b = u >> 6;
            const size_t ro = (size_t)(b * 4 + hh) * SEQ * 64;
            const float slope2 = __int_as_float(__builtin_amdgcn_readfirstlane(__float_as_int(exp2f(-2.0f * (float)(hh + 1)) * LOG2E)));
            attn_unit<64, true>(QC + ro, KC + ro, VC + ro, qb * 256, MIX + (size_t)b * SEQ * 1024 + 768 + hh * 64, slope2, lam, outmul,
                                p.subln + layer * 64, smem, wv);
        } else if (u < 1024) {
            const int w = u - 512, qb = w & 15, hh = (w >> 4) & 3, b = w >> 6;
            const size_t rq = (size_t)(b * 4 + hh) * SEQ;
            attn_unit<96, false>(QB + rq * 96, KB + rq * 96, VB + rq * 64, qb * 256, MIX + (size_t)b * SEQ * 1024 + 512 + hh * 64, 0.f, 0.f, 0.f, nullptr, smem, wv);
        } else {
            const int w = u - 1024, qb = w & 15, hh = (w >> 4) & 7, b = w >> 7;
            const size_t rq = (size_t)(b * 8 + hh) * SEQ, rk = (size_t)(b * 2 + (hh >> 2)) * SEQ;
            attn_unit<64, false>(QA + rq * 64, KA + rk * 64, VA + rk * 64, qb * 256, MIX + (size_t)b * SEQ * 1024 + hh * 64, 0.f, 0.f, 0.f, nullptr, smem, wv);
        }
    }
}

__global__ void __launch_bounds__(NTHR, 2) mega(Params p) {
    extern __shared__ __attribute__((aligned(16))) unsigned char smem[];
    cg::grid_group grid = cg::this_grid();
    unsigned char* ws = p.ws;
    const int gtid = blockIdx.x * NTHR + threadIdx.x, gthreads = gridDim.x * NTHR;
    const int wv = __builtin_amdgcn_readfirstlane((int)(threadIdx.x >> 6));
    bf16_t* XB = (bf16_t*)(ws + OFF_XB);
    float* SSX = (float*)(ws + OFF_SSX);
    float* tab = (float*)(ws + OFF_TAB);

    for (int l = 0; l < 2; ++l) {
        prep_weight<false>(p.w_in + (size_t)l * 1024 * INW, p.norm_attn + l * 1024, (bf16_t*)(ws + OFF_WIN) + (size_t)l * INWP * 1024, 1024, INW, INWP, gtid, gthreads);
        prep_weight<false>(p.w_uq + (size_t)l * 192 * 384, p.qan_b + l * 192, (bf16_t*)(ws + OFF_WUQ) + (size_t)l * 512 * 192, 192, 384, 512, gtid, gthreads);
        prep_weight<false>(p.w_ukv + (size_t)l * 128 * 512, p.kvn_b + l * 128, (bf16_t*)(ws + OFF_WUKV) + (size_t)l * 512 * 128, 128, 512, 512, gtid, gthreads);
        prep_weight<false>(p.w_out + (size_t)l * 1024 * 1024, nullptr, (bf16_t*)(ws + OFF_WOUT) + (size_t)l * 1024 * 1024, 1024, 1024, 1024, gtid, gthreads);
        prep_weight<true>(p.w_up + (size_t)l * 1024 * DFF2, p.norm_ffn + l * 1024, (bf16_t*)(ws + OFF_WUP) + (size_t)l * DFF2 * 1024, 1024, DFF2, DFF2, gtid, gthreads);
        prep_weight<false>(p.w_down + (size_t)l * DFF * 1024, nullptr, (bf16_t*)(ws + OFF_WDN) + (size_t)l * 1024 * DFF, DFF, 1024, 1024, gtid, gthreads);
    }
    for (int idx = gtid; idx < 1024 + 512; idx += gthreads) {
        if (idx < 1024) { const int pos = idx >> 4, f = idx & 15; const float ang = (float)pos * powf(10000.0f, -(float)f / 16.0f); tab[idx] = cosf(ang); tab[1024 + idx] = sinf(ang); }
        else { const int k = idx - 1024, pos = k >> 3, f = k & 7; const float ang = (float)pos * powf(10000.0f, -(float)f / 8.0f); tab[2048 + k] = cosf(ang); tab[2560 + k] = sinf(ang); }
    }
    convert_x(p.x, XB, SSX, wv);
    grid.sync();

    for (int l = 0; l < 2; ++l) {
        const float lam_init = __int_as_float(__builtin_amdgcn_readfirstlane(__float_as_int((l == 0) ? 0.2f : 0.35550906759096984f)));
        const float* xin = (l == 0) ? p.x : p.out;
        gemm_phase(XB, 1024, (const bf16_t*)(ws + OFF_WIN) + (size_t)l * INWP * 1024, 1024, 1024, M_TOK, INWP, smem,
                   EpiInProj{SSX, tab, p.qn_a + l * 64, p.kn_a + l * 64, (bf16_t*)(ws + OFF_QA), (bf16_t*)(ws + OFF_KA), (bf16_t*)(ws + OFF_VA), (bf16_t*)(ws + OFF_CQ),
                             (bf16_t*)(ws + OFF_CKV), (bf16_t*)(ws + OFF_KB), (bf16_t*)(ws + OFF_QC), (bf16_t*)(ws + OFF_KC), (bf16_t*)(ws + OFF_VC),
                             (float*)(ws + OFF_SSCQ), (float*)(ws + OFF_SSCKV)}, wv);
        grid.sync();
        gemm_phase((const bf16_t*)(ws + OFF_CQ), 192, (const bf16_t*)(ws + OFF_WUQ) + (size_t)l * 512 * 192, 192, 192, M_TOK, 512, smem,
                   EpiMlaQ{(bf16_t*)(ws + OFF_QB), tab, (const float*)(ws + OFF_SSCQ), 0.10206207261596575f * LOG2E}, wv);
        gemm_phase((const bf16_t*)(ws + OFF_CKV), 128, (const bf16_t*)(ws + OFF_WUKV) + (size_t)l * 512 * 128, 128, 128, M_TOK, 512, smem,
                   EpiMlaKV{(bf16_t*)(ws + OFF_KB), (bf16_t*)(ws + OFF_VB), (const float*)(ws + OFF_SSCKV)}, wv);
        grid.sync();
        attn_phase(p, l, lam_init, __int_as_float(__builtin_amdgcn_readfirstlane(__float_as_int((l == 0) ? 0.8f : 0.64449093240903016f))), smem, wv);
        grid.sync();
        gemm_phase((const bf16_t*)(ws + OFF_MIX), 1024, (const bf16_t*)(ws + OFF_WOUT) + (size_t)l * 1024 * 1024, 1024, 1024, M_TOK, 1024, smem, EpiResid2{xin, p.out, XB, SSX}, wv);
        grid.sync();
        up_conv_phase(XB, (const bf16_t*)(ws + OFF_WUP) + (size_t)l * DFF2 * 1024, SSX, p.conv_w + (size_t)l * 3 * DFF2, p.conv_b + (size_t)l * DFF2, (bf16_t*)(ws + OFF_ACT), smem, wv);
        grid.sync();
        gemm_phase((const bf16_t*)(ws + OFF_ACT), DFF, (const bf16_t*)(ws + OFF_WDN) + (size_t)l * 1024 * DFF, DFF, DFF, M_TOK, 1024, smem, EpiResid2{p.out, p.out, XB, SSX}, wv);
        grid.sync();
    }
    final_norm(p.out, p.final_norm, SSX, wv);
}

extern "C" void kernel_launch(void* const* d_in, const int* in_sizes, int n_in, void* d_out, int out_size, void* d_ws, size_t ws_size, hipStream_t stream) {
    static int grid_blocks = 0;
    if (!grid_blocks) {
        int dev = 0, cus = 0, per_cu = 0;
        hipGetDevice(&dev);
        hipDeviceGetAttribute(&cus, hipDeviceAttributeMultiprocessorCount, dev);
        hipFuncSetAttribute((const void*)mega, hipFuncAttributeMaxDynamicSharedMemorySize, SMEM_TOTAL);
        hipOccupancyMaxActiveBlocksPerMultiprocessor(&per_cu, mega, NTHR, SMEM_TOTAL);
        if (per_cu > 1) per_cu = 1;
        if (per_cu < 1) per_cu = 1;
        grid_blocks = (cus * per_cu) & ~7;
    }
    Params p{};
    const float** pp = (const float**)&p;
    for (int i = 0; i < 21; ++i) pp[i] = (const float*)d_in[i];
    p.out = (float*)d_out;
    p.ws = (unsigned char*)d_ws;
    void* args[] = {&p};
    hipError_t e = hipLaunchCooperativeKernel((void*)mega, dim3(grid_blocks), dim3(NTHR), args, SMEM_TOTAL, stream);
    if (e != hipSuccess) fprintf(stderr, "cooperative launch failed: %s (grid %d)\n", hipGetErrorString(e), grid_blocks);
}
```

```cpp
#include <hip/hip_runtime.h>
#include <hip/hip_cooperative_groups.h>
#include <stdint.h>
#include <math.h>
#include <stdio.h>
namespace cg = cooperative_groups;

typedef unsigned short bf16_t;
typedef short bf16x8 __attribute__((ext_vector_type(8)));
typedef short s16x4 __attribute__((ext_vector_type(4)));
typedef float f32x4 __attribute__((ext_vector_type(4)));
typedef float f32x16 __attribute__((ext_vector_type(16)));
typedef unsigned u32x4 __attribute__((ext_vector_type(4)));
typedef unsigned u32x2 __attribute__((ext_vector_type(2)));
typedef __bf16 bf2_t __attribute__((ext_vector_type(2)));
typedef float f32x2 __attribute__((ext_vector_type(2)));
#define DI __device__ __forceinline__

constexpr int M_TOK = 32768, SEQ = 4096, DM = 1024, INW = 1888, INWP = 2048, DFF = 2816, DFF2 = 5632;
constexpr float EPS = 1e-6f;
constexpr float LOG2E = 1.4426950408889634f;
constexpr int NTHR = 512, NWAVE = NTHR / 64;
constexpr int XLD = 1024 + 64, ALD = DFF + 64;

constexpr size_t SZ_WIN = (size_t)2 * INWP * XLD * 2, SZ_WUQ = (size_t)2 * 512 * 192 * 2, SZ_WUKV = (size_t)2 * 512 * 128 * 2,
                 SZ_WOUT = (size_t)2 * 1024 * XLD * 2, SZ_WUP = (size_t)2 * DFF2 * XLD * 2, SZ_WDN = (size_t)2 * 1024 * ALD * 2;
constexpr size_t OFF_WIN = 0, OFF_WUQ = OFF_WIN + SZ_WIN, OFF_WUKV = OFF_WUQ + SZ_WUQ, OFF_WOUT = OFF_WUKV + SZ_WUKV,
                 OFF_WUP = OFF_WOUT + SZ_WOUT, OFF_WDN = OFF_WUP + SZ_WUP, OFF_TAB = OFF_WDN + SZ_WDN, OFF_XB = OFF_TAB + 16384;
constexpr size_t OFF_SSX = OFF_XB + (size_t)M_TOK * XLD * 2, OFF_SSCQ = OFF_SSX + (size_t)M_TOK * 16 * 4, OFF_SSCKV = OFF_SSCQ + (size_t)M_TOK * 4 * 4,
                 OFF_BIG = OFF_SSCKV + (size_t)M_TOK * 2 * 4;
constexpr size_t OFF_QA = OFF_BIG, OFF_KA = OFF_QA + (size_t)M_TOK * 512 * 2,
                 OFF_VA = OFF_KA + (size_t)M_TOK * 128 * 2, OFF_CQ = OFF_VA + (size_t)M_TOK * 128 * 2, OFF_CKV = OFF_CQ + (size_t)M_TOK * 192 * 2,
                 OFF_QB = OFF_CKV + (size_t)M_TOK * 128 * 2, OFF_KB = OFF_QB + (size_t)M_TOK * 384 * 2, OFF_VB = OFF_KB + (size_t)M_TOK * 384 * 2,
                 OFF_QC = OFF_VB + (size_t)M_TOK * 256 * 2, OFF_KC = OFF_QC + (size_t)M_TOK * 256 * 2, OFF_VC = OFF_KC + (size_t)M_TOK * 256 * 2,
                 OFF_MIX = OFF_VC + (size_t)M_TOK * 256 * 2, OFF_END1 = OFF_MIX + (size_t)M_TOK * XLD * 2;
constexpr size_t OFF_ACT = OFF_BIG, OFF_END2 = OFF_ACT + (size_t)M_TOK * ALD * 2;
static_assert(OFF_END1 <= (size_t)512 * 1024 * 1024 && OFF_END2 <= (size_t)512 * 1024 * 1024, "workspace");

struct Params {
    const float *x, *norm_attn, *w_in, *qn_a, *kn_a, *qan_b, *w_uq, *kvn_b, *w_ukv, *lq1, *lk1, *lq2, *lk2, *subln, *w_out, *norm_ffn, *w_up,
        *conv_w, *conv_b, *w_down, *final_norm;
    float* out;
    unsigned char* ws;
};

DI unsigned pk2(float a, float b) { f32x2 v = {a, b}; bf2_t r = __builtin_convertvector(v, bf2_t); return __builtin_bit_cast(unsigned, r); }
DI void unpack8(u32x4 r, float* v) {
    v[0] = __uint_as_float(r.x << 16); v[1] = __uint_as_float(r.x & 0xffff0000u);
    v[2] = __uint_as_float(r.y << 16); v[3] = __uint_as_float(r.y & 0xffff0000u);
    v[4] = __uint_as_float(r.z << 16); v[5] = __uint_as_float(r.z & 0xffff0000u);
    v[6] = __uint_as_float(r.w << 16); v[7] = __uint_as_float(r.w & 0xffff0000u);
}
DI u32x4 pack8(const float* v) { u32x4 r; r.x = pk2(v[0], v[1]); r.y = pk2(v[2], v[3]); r.z = pk2(v[4], v[5]); r.w = pk2(v[6], v[7]); return r; }
DI int tid_opaque(int wv) { int t; asm volatile("v_mbcnt_lo_u32_b32 %0, -1, 0\n\tv_mbcnt_hi_u32_b32 %0, -1, %0" : "=v"(t)); return t | (wv << 6); }
DI int bid_opaque() { int b = blockIdx.x; asm volatile("" : "+s"(b)); return b; }
DI float shflx(float v, int mask, int lane) { return __int_as_float(__builtin_amdgcn_ds_bpermute((lane ^ mask) << 2, __float_as_int(v))); }
DI float wave_sum(float v, int lane) {
#pragma unroll
    for (int o = 32; o >= 1; o >>= 1) v += shflx(v, o, lane);
    return v;
}

template <bool UPPERM>
DI void prep_weight(const float* __restrict__ W, const float* __restrict__ gain, bf16_t* __restrict__ Wt, int ldw, int K, int N, int Npad, int gtid, int gthreads) {
    const int total = Npad * (K / 8);
    for (int idx = gtid; idx < total; idx += gthreads) {
        const int n = idx % Npad, kc = idx / Npad;
        int ns = n;
        if (UPPERM) { const int j = n >> 8, r = n & 255; ns = (r < 128) ? (128 * j + r) : (DFF + 128 * j + r - 128); }
        float v[8];
#pragma unroll
        for (int j = 0; j < 8; ++j) { const int k = kc * 8 + j; v[j] = (n < N) ? W[(size_t)k * N + ns] * (gain ? gain[k] : 1.0f) : 0.f; }
        *(u32x4*)(Wt + (size_t)n * ldw + kc * 8) = pack8(v);
    }
}

DI void convert_x(const float* X, bf16_t* XB, float* SSX, int wv) {
    const int tid_ = tid_opaque(wv);
    const int lane = tid_ & 63, gw = bid_opaque() * NWAVE + (tid_ >> 6), nw = gridDim.x * NWAVE;
    for (int row = gw; row < M_TOK; row += nw) {
        const f32x4* xr = (const f32x4*)(X + (size_t)row * 1024);
        float ss = 0.f;
#pragma unroll
        for (int i = 0; i < 4; ++i) {
            const f32x4 v = xr[lane + 64 * i];
            ss += v[0] * v[0] + v[1] * v[1] + v[2] * v[2] + v[3] * v[3];
            u32x2 w; w.x = pk2(v[0], v[1]); w.y = pk2(v[2], v[3]);
            *(u32x2*)(XB + (size_t)row * XLD + (lane + 64 * i) * 4) = w;
        }
        ss = wave_sum(ss, lane);
        if (lane < 16) SSX[(size_t)row * 16 + lane] = (lane == 0) ? ss : 0.f;
    }
}
DI void final_norm(float* X, const float* __restrict__ g, const float* SSX, int wv) {
    const int tid_ = tid_opaque(wv);
    const int lane = tid_ & 63, gw = bid_opaque() * NWAVE + (tid_ >> 6), nw = gridDim.x * NWAVE;
    for (int row = gw; row < M_TOK; row += nw) {
        float ss = (lane < 16) ? SSX[(size_t)row * 16 + lane] : 0.f;
        ss = wave_sum(ss, lane);
        const float rstd = rsqrtf(ss * (1.0f / 1024.0f) + EPS);
        f32x4* xr = (f32x4*)(X + (size_t)row * 1024);
#pragma unroll
        for (int i = 0; i < 4; ++i) { const f32x4 gv = ((const f32x4*)g)[lane + 64 * i]; xr[lane + 64 * i] = xr[lane + 64 * i] * rstd * gv; }
    }
}
DI float row_rstd(const float* ssx, int m) {
    const f32x4* pp = (const f32x4*)(ssx + (size_t)m * 16);
    const f32x4 a = (pp[0] + pp[1]) + (pp[2] + pp[3]);
    return rsqrtf(((a[0] + a[1]) + (a[2] + a[3])) * (1.0f / 1024.0f) + EPS);
}

constexpr int GSTR = 128, GOP = 256 * GSTR;
constexpr int SMEM_BYTES = 4 * GOP;
constexpr int SMEM_CONV = 256 * 132 * 4;
constexpr int SMEM_TOTAL = SMEM_CONV > SMEM_BYTES ? SMEM_CONV : SMEM_BYTES;

DI void gemm_mainloop(const bf16_t* __restrict__ Ab, const unsigned (&aoff)[4], const bool (&av)[4], const bf16_t* __restrict__ Bb, unsigned boff, int ldb, int nk, unsigned char* smem, f32x4 (&acc)[8][4], int tid) {
    const int lane = tid & 63, wid = tid >> 6, wr = wid >> 2, wc = wid & 3;
    const int lrow = tid >> 3, lc = tid & 7;
    u32x4 ra[4], rb[4];
#pragma unroll
    for (int i = 0; i < 8; ++i)
#pragma unroll
        for (int j = 0; j < 4; ++j) acc[i][j] = (f32x4){0.f, 0.f, 0.f, 0.f};
    const u32x4 zero4 = {0u, 0u, 0u, 0u};
#define G_LOAD(KT) { _Pragma("unroll") for (int i = 0; i < 4; ++i) { const u32x4 t_ = *(const u32x4*)((const unsigned char*)Ab + (size_t)(aoff[i] + (unsigned)((KT) * 128))); ra[i] = av[i] ? t_ : zero4; rb[i] = *(const u32x4*)((const unsigned char*)Bb + (size_t)(boff + (unsigned)(i * 128 * ldb) + (unsigned)((KT) * 128))); } }
#define G_WRITE(BUF) { int so_ = (BUF) * 2 * GOP + wboff; asm volatile("" : "+v"(so_)); unsigned char* wb_ = smem + so_; _Pragma("unroll") for (int i = 0; i < 4; ++i) { *(u32x4*)(wb_ + i * 64 * GSTR) = ra[i]; *(u32x4*)(wb_ + GOP + i * 64 * GSTR) = rb[i]; } }
    const int wboff = lrow * GSTR + ((lc ^ (lrow & 7)) << 4);
    const int foff = (lane & 15) * GSTR;
    const int fsw[2] = {(((lane >> 4)) ^ (lane & 7)) << 4, (((lane >> 4) + 4) ^ (lane & 7)) << 4};
    G_LOAD(0);
    G_WRITE(0);
    __syncthreads();
    for (int kt = 0; kt < nk; ++kt) {
        { const int kl = (kt + 1 < nk) ? kt + 1 : nk - 1; G_LOAD(kl); }
        const unsigned char* sa = smem + (kt & 1) * 2 * GOP + wr * 128 * GSTR + foff;
        const unsigned char* sb = smem + (kt & 1) * 2 * GOP + GOP + wc * 64 * GSTR + foff;
        int so_ = ((kt + 1) & 1) * 2 * GOP + wboff; asm volatile("" : "+v"(so_));
        unsigned char* wb_ = smem + so_;
#pragma unroll
        for (int kk = 0; kk < 2; ++kk) {
            bf16x8 af[8], bfr[4];
#pragma unroll
            for (int i = 0; i < 4; ++i) bfr[i] = *(const bf16x8*)(sb + i * 16 * GSTR + fsw[kk]);
#pragma unroll
            for (int i = 0; i < 8; ++i) af[i] = *(const bf16x8*)(sa + i * 16 * GSTR + fsw[kk]);
#pragma unroll
            for (int mi = 0; mi < 8; ++mi) {
#pragma unroll
                for (int ni = 0; ni < 4; ++ni) acc[mi][ni] = __builtin_amdgcn_mfma_f32_16x16x32_bf16(bfr[ni], af[mi], acc[mi][ni], 0, 0, 0);
                if (kk == 1) { if (mi < 4) *(u32x4*)(wb_ + mi * 64 * GSTR) = ra[mi]; else *(u32x4*)(wb_ + GOP + (mi - 4) * 64 * GSTR) = rb[mi - 4]; }
            }
        }
        __builtin_amdgcn_sched_group_barrier(0x008, 32, 0);
#pragma unroll
        for (int g = 0; g < 8; ++g) { __builtin_amdgcn_sched_group_barrier(0x008, 4, 0); __builtin_amdgcn_sched_group_barrier(0x200, 1, 0); }
        __syncthreads();
    }
#undef G_LOAD
#undef G_WRITE
}

template <class Epi>
DI void gemm_tile(const bf16_t* __restrict__ A, int lda, const bf16_t* __restrict__ Bt, int ldb, int K, int m0, int n0, unsigned char* smem, const Epi& epi, int wv) {
    const int tid = tid_opaque(wv), lane = tid & 63, wid = tid >> 6, wr = wid >> 2, wc = wid & 3;
    const int lrow = tid >> 3, lc = tid & 7;
    unsigned aoff[4];
    const bool av[4] = {true, true, true, true};
#pragma unroll
    for (int i = 0; i < 4; ++i) aoff[i] = (unsigned)((lrow + 64 * i) * lda + lc * 8) * 2u;
    const unsigned boff = (unsigned)(lrow * ldb + lc * 8) * 2u;
    f32x4 acc[8][4];
    gemm_mainloop(A + (size_t)m0 * lda, aoff, av, Bt + (size_t)n0 * ldb, boff, ldb, K / 64, smem, acc, tid);
    epi(acc, m0 + wr * 128, n0 + wc * 64, lane);
}

template <class Epi>
DI void gemm_phase(const bf16_t* A, int lda, const bf16_t* Bt, int ldb, int K, int Mrows, int Ncols, unsigned char* smem, const Epi& epi, int wv) {
    const int nN = Ncols / 256, nM = Mrows / 256;
    const int bid = bid_opaque(), G = gridDim.x;
    const int xcd = bid & 7, lb = bid >> 3, nlb = G >> 3, mper = nM >> 3, nloc = mper * nN;
    for (int j = lb; j < nloc; j += nlb) {
        const int g = j / (4 * nN), rem = j - g * 4 * nN;
        const int mt = xcd * mper + g * 4 + (rem & 3), nt = rem >> 2;
        gemm_tile(A, lda, Bt, ldb, K, mt * 256, nt * 256, smem, epi, wv);
    }
}

DI float dot4(f32x4 a) { return (a[0] * a[0] + a[1] * a[1]) + (a[2] * a[2] + a[3] * a[3]); }
DI void st4bf(bf16_t* dst, f32x4 v) { u32x2 w; w.x = pk2(v[0], v[1]); w.y = pk2(v[2], v[3]); *(u32x2*)dst = w; }

struct EpiResid2 {
    const float* Xin; float* Xout; bf16_t* XB; float* SSX;
    DI void operator()(const f32x4 (&acc)[8][4], int mb, int nb, int lane) const {
        const int q = lane >> 4;
#pragma unroll
        for (int mi = 0; mi < 8; ++mi) {
            const int m = mb + mi * 16 + (lane & 15);
            float ss = 0.f;
#pragma unroll
            for (int ni = 0; ni < 4; ++ni) {
                const size_t o = (size_t)m * 1024 + nb + ni * 16 + q * 4;
                f32x4 r = *(const f32x4*)(Xin + o);
                r += acc[mi][ni];
                *(f32x4*)(Xout + o) = r;
                st4bf(XB + (size_t)m * XLD + nb + ni * 16 + q * 4, r);
                ss += dot4(r);
            }
            ss += shflx(ss, 16, lane); ss += shflx(ss, 32, lane);
            if (q == 0) SSX[(size_t)m * 16 + (nb >> 6)] = ss;
        }
    }
};

struct EpiInProj {
    const float *ssx, *tab, *gq, *gk;
    bf16_t *QA, *KA, *VA, *CQ, *CKV, *KB, *QC, *KC, *VC;
    float *sscq, *ssckv;
    DI void operator()(const f32x4 (&acc)[8][4], int mb, int nb, int lane) const {
        const int q = lane >> 4, ml = lane & 15;
        const float qsA = 0.125f * LOG2E, qsC = 0.17677669529663687f * LOG2E;
        if (nb < 640) {
            const bool isq = nb < 512;
            const int head = isq ? (nb >> 6) : ((nb - 512) >> 6);
            const float* g = isq ? gq : gk;
            f32x4 gv[4];
#pragma unroll
            for (int ni = 0; ni < 4; ++ni) gv[ni] = *(const f32x4*)(g + ni * 16 + q * 4);
#pragma unroll
            for (int mi = 0; mi < 8; ++mi) {
                const int m = mb + mi * 16 + ml, b = m >> 12, s = m & 4095;
                const float rs = row_rstd(ssx, m);
                f32x4 v[4];
                float ss = 0.f;
#pragma unroll
                for (int ni = 0; ni < 4; ++ni) { v[ni] = acc[mi][ni] * rs; ss += dot4(v[ni]); }
                ss += shflx(ss, 16, lane); ss += shflx(ss, 32, lane);
                const float r2 = rsqrtf(ss * (1.0f / 64.0f) + EPS);
#pragma unroll
                for (int ni = 0; ni < 4; ++ni) v[ni] = v[ni] * r2 * gv[ni];
                const float* tr = tab + (s >> 6) * 16 + q * 4;
                const float* tq = tab + (s & 63) * 16 + q * 4;
                const f32x4 c0 = *(const f32x4*)tr, s0 = *(const f32x4*)(tr + 1024), c1 = *(const f32x4*)tq, s1 = *(const f32x4*)(tq + 1024);
                f32x4 o0 = v[0] * c0 - v[1] * s0, o1 = v[1] * c0 + v[0] * s0, o2 = v[2] * c1 - v[3] * s1, o3 = v[3] * c1 + v[2] * s1;
                bf16_t* dst;
                if (isq) { o0 *= qsA; o1 *= qsA; o2 *= qsA; o3 *= qsA; dst = QA + ((size_t)(b * 8 + head) * SEQ + s) * 64 + q * 4; }
                else dst = KA + ((size_t)(b * 2 + head) * SEQ + s) * 64 + q * 4;
                st4bf(dst, o0); st4bf(dst + 16, o1); st4bf(dst + 32, o2); st4bf(dst + 48, o3);
            }
        } else if (nb < 768) {
            const int head = (nb - 640) >> 6;
#pragma unroll
            for (int mi = 0; mi < 8; ++mi) {
                const int m = mb + mi * 16 + ml, b = m >> 12, s = m & 4095;
                const float rs = row_rstd(ssx, m);
                bf16_t* dst = VA + ((size_t)(b * 2 + head) * SEQ + s) * 64 + q * 4;
#pragma unroll
                for (int ni = 0; ni < 4; ++ni) st4bf(dst + ni * 16, acc[mi][ni] * rs);
            }
        } else {
            const bool sq = nb < 1088;
#pragma unroll
            for (int mi = 0; mi < 8; ++mi) {
                const int m = mb + mi * 16 + ml, b = m >> 12, s = m & 4095;
                const float rs = row_rstd(ssx, m);
                float ss = 0.f;
#pragma unroll
                for (int ni = 0; ni < 4; ++ni) {
                    const int n16 = nb + ni * 16;
                    f32x4 v = acc[mi][ni] * rs;
                    if (n16 < 960) { st4bf(CQ + (size_t)m * 192 + (n16 - 768) + q * 4, v); ss += dot4(v); }
                    else if (n16 < 1088) { st4bf(CKV + (size_t)m * 128 + (n16 - 960) + q * 4, v); ss += dot4(v); }
                    else if (n16 < 1120) {
                        f32x4 pr;
#pragma unroll
                        for (int i = 0; i < 4; ++i) pr[i] = shflx(v[i], 32, lane);
                        const int pos = (n16 >= 1104) ? (s & 63) : (s >> 6);
                        const float* tc = tab + 2048 + pos * 8 + (q & 1) * 4;
                        const f32x4 c = *(const f32x4*)tc, sn = *(const f32x4*)(tc + 512);
                        const f32x4 o = (q < 2) ? (v * c - pr * sn) : (v * c + pr * sn);
#pragma unroll
                        for (int hh = 0; hh < 4; ++hh) st4bf(KB + ((size_t)(b * 4 + hh) * SEQ + s) * 96 + 64 + (n16 - 1088) + q * 4, o);
                    } else if (n16 < 1376) { const int c = n16 - 1120 + q * 4; st4bf(QC + ((size_t)(b * 4 + (c >> 6)) * SEQ + s) * 64 + (c & 63), v * qsC); }
                    else if (n16 < 1632) { const int c = n16 - 1376 + q * 4; st4bf(KC + ((size_t)(b * 4 + (c >> 6)) * SEQ + s) * 64 + (c & 63), v); }
                    else if (n16 < 1888) { const int c = n16 - 1632 + q * 4; st4bf(VC + ((size_t)(b * 4 + (c >> 6)) * SEQ + s) * 64 + (c & 63), v); }
                }
                if (sq) {
                    ss += shflx(ss, 16, lane); ss += shflx(ss, 32, lane);
                    if (q == 0) { if (nb < 960) sscq[(size_t)m * 4 + ((nb - 768) >> 6)] = ss; else ssckv[(size_t)m * 2 + ((nb - 960) >> 6)] = ss; }
                }
            }
        }
    }
};
struct EpiMlaQ {
    bf16_t* QB; const float* tab; const float* sscq; float qscale;
    DI void operator()(const f32x4 (&acc)[8][4], int mb, int nb, int lane) const {
#pragma unroll
        for (int mi = 0; mi < 8; ++mi) {
            const int m = mb + mi * 16 + (lane & 15), q = lane >> 4, b = m >> 12, s = m & 4095;
            const f32x4 sp = *(const f32x4*)(sscq + (size_t)m * 4);
            const float rs = rsqrtf((sp[0] + sp[1] + sp[2]) * (1.0f / 192.0f) + EPS) * qscale;
#pragma unroll
            for (int ni = 0; ni < 4; ++ni) {
                const int nt = nb + ni * 16;
                if (nt >= 384) continue;
                const int head = nt / 96, dt = nt - head * 96;
                f32x4 v = acc[mi][ni] * rs;
                f32x4 pr;
#pragma unroll
                for (int i = 0; i < 4; ++i) pr[i] = shflx(v[i], 32, lane);
                if (dt >= 64) {
                    const int pos = (dt >= 80) ? (s & 63) : (s >> 6);
                    const float* tc = tab + 2048 + pos * 8 + (q & 1) * 4;
                    const f32x4 c = *(const f32x4*)tc, sn = *(const f32x4*)(tc + 512);
                    v = (q < 2) ? (v * c - pr * sn) : (v * c + pr * sn);
                }
                st4bf(QB + ((size_t)(b * 4 + head) * SEQ + s) * 96 + dt + q * 4, v);
            }
        }
    }
};
struct EpiMlaKV {
    bf16_t* KB; bf16_t* VB; const float* ssckv;
    DI void operator()(const f32x4 (&acc)[8][4], int mb, int nb, int lane) const {
#pragma unroll
        for (int mi = 0; mi < 8; ++mi) {
            const int m = mb + mi * 16 + (lane & 15), b = m >> 12, s = m & 4095;
            const f32x2 sp = *(const f32x2*)(ssckv + (size_t)m * 2);
            const float rs = rsqrtf((sp[0] + sp[1]) * (1.0f / 128.0f) + EPS);
#pragma unroll
            for (int ni = 0; ni < 4; ++ni) {
                const int n = nb + ni * 16 + (lane >> 4) * 4;
                const int head = n >> 7, d = n & 127;
                const size_t rowi = (size_t)(b * 4 + head) * SEQ + s;
                if (d < 64) st4bf(KB + rowi * 96 + d, acc[mi][ni] * rs);
                else st4bf(VB + rowi * 64 + (d - 64), acc[mi][ni] * rs);
            }
        }
    }
};

DI void up_conv_tile(const bf16_t* __restrict__ XB, const bf16_t* __restrict__ Wt, const float* __restrict__ ssx, const float* __restrict__ cw, const float* __restrict__ cb,
                     bf16_t* __restrict__ ACT, int b, int jt, int nt, unsigned char* smem, int wv) {
    const int tid = tid_opaque(wv), lane = tid & 63, wid = tid >> 6, wr = wid >> 2, wc = wid & 3;
    const int lrow = tid >> 3, lc = tid & 7;
    const int tbase = jt * 254 - 1;
    unsigned aoff[4];
    bool av[4];
#pragma unroll
    for (int i = 0; i < 4; ++i) {
        const int tl = tbase + lrow + 64 * i;
        av[i] = (unsigned)tl < 4096u;
        const int tc = tl < 0 ? 0 : (tl > 4095 ? 4095 : tl);
        aoff[i] = (unsigned)(tc * XLD + lc * 8) * 2u;
    }
    const unsigned boff = (unsigned)(lrow * XLD + lc * 8) * 2u;
    f32x4 acc[8][4];
    gemm_mainloop(XB + (size_t)b * SEQ * XLD, aoff, av, Wt + (size_t)nt * 256 * XLD, boff, XLD, 16, smem, acc, tid);
    float* T = (float*)smem;
    const int q = lane >> 4, ml = lane & 15;
    float rs[8];
#pragma unroll
    for (int mi = 0; mi < 8; ++mi) {
        const int tl = tbase + wr * 128 + mi * 16 + ml;
        const int tc = tl < 0 ? 0 : (tl > 4095 ? 4095 : tl);
        rs[mi] = row_rstd(ssx, b * SEQ + tc);
    }
#pragma unroll
    for (int h = 0; h < 2; ++h) {
        if ((wc & 1) == h) {
#pragma unroll
            for (int mi = 0; mi < 8; ++mi)
#pragma unroll
                for (int ni = 0; ni < 4; ++ni) *(f32x4*)(T + (wr * 128 + mi * 16 + ml) * 132 + (wc >> 1) * 64 + ni * 16 + q * 4) = acc[mi][ni] * rs[mi];
        }
        __syncthreads();
        {
            const int cq = tid & 15, rg = tid >> 4, ch = nt * 128 + h * 64 + cq * 4;
            const f32x4 wg0 = *(const f32x4*)(cw + ch), wg1 = *(const f32x4*)(cw + DFF2 + ch), wg2 = *(const f32x4*)(cw + 2 * DFF2 + ch), bg = *(const f32x4*)(cb + ch);
            const f32x4 wv0 = *(const f32x4*)(cw + DFF + ch), wv1 = *(const f32x4*)(cw + DFF2 + DFF + ch), wv2 = *(const f32x4*)(cw + 2 * DFF2 + DFF + ch), bv = *(const f32x4*)(cb + DFF + ch);
            const int r0 = rg * 8, rm = r0 > 0 ? r0 - 1 : 0;
            f32x4 gm = *(const f32x4*)(T + rm * 132 + cq * 4), vm = *(const f32x4*)(T + rm * 132 + 64 + cq * 4);
            f32x4 g0 = *(const f32x4*)(T + r0 * 132 + cq * 4), v0 = *(const f32x4*)(T + r0 * 132 + 64 + cq * 4);
#pragma unroll
            for (int rr = 0; rr < 8; ++rr) {
                const int r = r0 + rr, rp = r < 255 ? r + 1 : 255;
                const f32x4 gp = *(const f32x4*)(T + rp * 132 + cq * 4), vp = *(const f32x4*)(T + rp * 132 + 64 + cq * 4);
                const f32x4 gg = wg0 * gm + wg1 * g0 + wg2 * gp + bg;
                const f32x4 vv = wv0 * vm + wv1 * v0 + wv2 * vp + bv;
                f32x4 o;
#pragma unroll
                for (int e = 0; e < 4; ++e) o[e] = gg[e] / (1.0f + __expf(-gg[e])) * vv[e];
                const int tl = tbase + r;
                if (r >= 1 && r <= 254 && tl <= 4095) st4bf(ACT + ((size_t)b * SEQ + tl) * ALD + ch, o);
                gm = g0; g0 = gp; vm = v0; v0 = vp;
            }
        }
        __syncthreads();
    }
}
DI void up_conv_phase(const bf16_t* XB, const bf16_t* Wt, const float* ssx, const float* cw, const float* cb, bf16_t* ACT, unsigned char* smem, int wv) {
    constexpr int NT = DFF / 128, MT = 17;
    const int bid = bid_opaque(), G = gridDim.x;
    const int xcd = bid & 7, lb = bid >> 3, nlb = G >> 3, nloc = MT * NT, full = (MT / 4) * 4 * NT, gs = MT - (MT / 4) * 4;
    for (int j = lb; j < nloc; j += nlb) {
        int jt, nt;
        if (j < full) { const int g = j / (4 * NT), rem = j - g * 4 * NT; jt = g * 4 + (rem & 3); nt = rem >> 2; }
        else { const int j2 = j - full; jt = (MT / 4) * 4 + j2 % gs; nt = j2 / gs; }
        up_conv_tile(XB, Wt, ssx, cw, cb, ACT, xcd, jt, nt, smem, wv);
    }
}

constexpr int ATT_STAGE = 64 * 208 + 8192;

template <int DQK, bool DIFF>
DI void attn_unit(const bf16_t* __restrict__ Qg, const bf16_t* __restrict__ Kg, const bf16_t* __restrict__ Vg, int q0, bf16_t* __restrict__ outp,
                  float slope2, float lam, float outmul, const float* __restrict__ subln, unsigned char* smem, int wv) {
    constexpr int NQT = DIFF ? 2 : 1, KS = DIFF ? 2 : DQK / 16, KSTR = DQK * 2 + 16, CPR = DQK / 8, KCH = (64 * CPR + NTHR - 1) / NTHR, KBYTES = 64 * 208;
    const int tid = tid_opaque(wv), lane = tid & 63, wid = tid >> 6, r = lane & 31, h = lane >> 5;
    const int qrow = q0 + wid * 32 + r;
    bf16x8 qf[NQT][KS];
#pragma unroll
    for (int qt = 0; qt < NQT; ++qt)
#pragma unroll
        for (int ks = 0; ks < KS; ++ks) qf[qt][ks] = *(const bf16x8*)(Qg + (size_t)qrow * DQK + qt * 32 + ks * 16 + h * 8);
    f32x16 O[NQT][2];
    float mrun[NQT], lsum[NQT];
#pragma unroll
    for (int qt = 0; qt < NQT; ++qt) {
        mrun[qt] = 0.f; lsum[qt] = 0.f;
#pragma unroll
        for (int d = 0; d < 2; ++d)
#pragma unroll
            for (int i = 0; i < 16; ++i) O[qt][d][i] = 0.f;
    }
    int koff[KCH], voff;
    bool kval[KCH];
#pragma unroll
    for (int i = 0; i < KCH; ++i) { const int id = tid + NTHR * i, key = id / CPR, c = id % CPR; koff[i] = key * KSTR + c * 16; kval[i] = id < 64 * CPR; }
    { const int key = tid >> 3, c = tid & 7; voff = KBYTES + key * 128 + ((c ^ (((key >> 1) & 1) << 2)) * 16); }
    u32x4 rk[KCH], rv;
#pragma unroll
    for (int i = 0; i < KCH; ++i) if (kval[i]) rk[i] = *(const u32x4*)(Kg + (size_t)(tid + NTHR * i) * 8);
    rv = *(const u32x4*)(Vg + (size_t)tid * 8);
#pragma unroll
    for (int i = 0; i < KCH; ++i) if (kval[i]) *(u32x4*)(smem + koff[i]) = rk[i];
    *(u32x4*)(smem + voff) = rv;
    __syncthreads();
    const int kfo = r * KSTR + h * 16;
    const int qq = (lane >> 2) & 3;
    const int colb0 = ((qq >> 1) & 1) * 64 + 32 * ((lane >> 4) & 1) + 8 * (lane & 3);
    const int vfo0 = KBYTES + (4 * h + qq) * 128 + colb0, vfo1 = KBYTES + (4 * h + qq) * 128 + (colb0 ^ 64);
    const float qpos = (float)qrow;

    for (int kt = 0; kt < SEQ / 64; ++kt) {
        const unsigned char* cur = smem + (kt & 1) * ATT_STAGE;
        const bool more = (kt + 1 < SEQ / 64);
        {
            const int kn = more ? kt + 1 : kt;
#pragma unroll
            for (int i = 0; i < KCH; ++i) if (kval[i]) rk[i] = *(const u32x4*)(Kg + (size_t)kn * 64 * DQK + (size_t)(tid + NTHR * i) * 8);
            rv = *(const u32x4*)(Vg + (size_t)kn * 64 * 64 + (size_t)tid * 8);
        }
#pragma unroll
        for (int qt = 0; qt < NQT; ++qt) {
            bf16x8 pf[2][2];
            f32x16 S[2];
#pragma unroll
            for (int kh = 0; kh < 2; ++kh) {
#pragma unroll
                for (int i = 0; i < 16; ++i) S[kh][i] = 0.f;
#pragma unroll
                for (int ks = 0; ks < KS; ++ks) {
                    const bf16x8 kf = *(const bf16x8*)(cur + kfo + kh * 32 * KSTR + (qt * 32 + ks * 16) * 2);
                    S[kh] = __builtin_amdgcn_mfma_f32_32x32x16_bf16(kf, qf[qt][ks], S[kh], 0, 0, 0);
                }
            }
            if (DIFF) {
                const float d0 = qpos - (float)(kt * 64 + 4 * h);
#pragma unroll
                for (int kh = 0; kh < 2; ++kh)
#pragma unroll
                    for (int i = 0; i < 16; ++i) S[kh][i] -= slope2 * fabsf(d0 - (float)(kh * 32 + (i & 3) + 8 * (i >> 2)));
            }
            float mx = __builtin_elementwise_maximum(S[0][0], S[1][0]);
#pragma unroll
            for (int i = 1; i < 16; ++i) mx = __builtin_elementwise_maximum(mx, __builtin_elementwise_maximum(S[0][i], S[1][i]));
            { const auto sw = __builtin_amdgcn_permlane32_swap(__float_as_uint(mx), __float_as_uint(mx), false, false); mx = __builtin_elementwise_maximum(__uint_as_float(sw[0]), __uint_as_float(sw[1])); }
            const float rel = mx - mrun[qt];
            const bool need = (rel > 8.0f) || (kt == 0 && rel < -8.0f);
            if (__builtin_amdgcn_ballot_w64(need) != 0ull) {
                const float delta = need ? rel : 0.f;
                const float alpha = (kt == 0) ? 1.0f : __builtin_amdgcn_exp2f(-delta);
                mrun[qt] += delta;
                lsum[qt] *= alpha;
#pragma unroll
                for (int d = 0; d < 2; ++d)
#pragma unroll
                    for (int i = 0; i < 16; ++i) O[qt][d][i] *= alpha;
            }
            float ps = 0.f;
            if (__builtin_amdgcn_ballot_w64(mrun[qt] != 0.f) != 0ull) {
#pragma unroll
                for (int kh = 0; kh < 2; ++kh)
#pragma unroll
                    for (int i = 0; i < 16; ++i) { const float pv = __builtin_amdgcn_exp2f(S[kh][i] - mrun[qt]); S[kh][i] = pv; ps += pv; }
            } else {
#pragma unroll
                for (int kh = 0; kh < 2; ++kh)
#pragma unroll
                    for (int i = 0; i < 16; ++i) { const float pv = __builtin_amdgcn_exp2f(S[kh][i]); S[kh][i] = pv; ps += pv; }
            }
            lsum[qt] += ps;
#pragma unroll
            for (int kh = 0; kh < 2; ++kh)
#pragma unroll
                for (int s2 = 0; s2 < 2; ++s2) {
                    u32x4 w;
                    w.x = pk2(S[kh][8 * s2 + 0], S[kh][8 * s2 + 1]); w.y = pk2(S[kh][8 * s2 + 2], S[kh][8 * s2 + 3]);
                    w.z = pk2(S[kh][8 * s2 + 4], S[kh][8 * s2 + 5]); w.w = pk2(S[kh][8 * s2 + 6], S[kh][8 * s2 + 7]);
                    pf[kh][s2] = __builtin_bit_cast(bf16x8, w);
                }
#pragma unroll
            for (int kh = 0; kh < 2; ++kh)
#pragma unroll
                for (int s2 = 0; s2 < 2; ++s2)
#pragma unroll
                    for (int d = 0; d < 2; ++d) {
                        const unsigned char* va = cur + (d ? vfo1 : vfo0) + (kh * 32 + 16 * s2) * 128;
                        const s16x4 lo = __builtin_amdgcn_ds_read_tr16_b64_v4i16((__attribute__((address_space(3))) s16x4*)(va));
                        const s16x4 hi = __builtin_amdgcn_ds_read_tr16_b64_v4i16((__attribute__((address_space(3))) s16x4*)(va + 8 * 128));
                        const bf16x8 vf = __builtin_shufflevector(lo, hi, 0, 1, 2, 3, 4, 5, 6, 7);
                        O[qt][d] = __builtin_amdgcn_mfma_f32_32x32x16_bf16(vf, pf[kh][s2], O[qt][d], 0, 0, 0);
                    }
            if (DIFF) __builtin_amdgcn_sched_barrier(0);
        }
        {
            unsigned char* nx = smem + ((kt + 1) & 1) * ATT_STAGE;
#pragma unroll
            for (int i = 0; i < KCH; ++i) if (kval[i]) *(u32x4*)(nx + koff[i]) = rk[i];
            *(u32x4*)(nx + voff) = rv;
        }
        __syncthreads();
    }
    const int tid2 = tid_opaque(wv), lane2 = tid2 & 63;
    const int h2 = lane2 >> 5;
    float inv[NQT];
#pragma unroll
    for (int qt = 0; qt < NQT; ++qt) { const float lt = lsum[qt] + shflx(lsum[qt], 32, lane2); inv[qt] = 1.0f / lt; }
    float o[2][16];
    if (DIFF) {
        float ss = 0.f;
#pragma unroll
        for (int d = 0; d < 2; ++d)
#pragma unroll
            for (int i = 0; i < 16; ++i) { const float x = O[0][d][i] * inv[0] - lam * (O[NQT - 1][d][i] * inv[NQT - 1]); o[d][i] = x; ss += x * x; }
        ss += shflx(ss, 32, lane2);
        const float rstd = rsqrtf(ss * (1.0f / 64.0f) + EPS) * outmul;
#pragma unroll
        for (int d = 0; d < 2; ++d)
#pragma unroll
            for (int i = 0; i < 16; ++i) o[d][i] *= rstd * subln[d * 32 + (i & 3) + 8 * (i >> 2) + 4 * h2];
    } else {
#pragma unroll
        for (int d = 0; d < 2; ++d)
#pragma unroll
            for (int i = 0; i < 16; ++i) o[d][i] = O[0][d][i] * inv[0];
    }
    const int qrow2 = q0 + (lane2 & 31) + ((tid2 >> 6) << 5);
    bf16_t* orow = outp + (size_t)qrow2 * XLD;
#pragma unroll
    for (int d = 0; d < 2; ++d)
#pragma unroll
        for (int g = 0; g < 4; ++g) {
            u32x2 w; w.x = pk2(o[d][4 * g], o[d][4 * g + 1]); w.y = pk2(o[d][4 * g + 2], o[d][4 * g + 3]);
            *(u32x2*)(orow + d * 32 + 8 * g + 4 * h2) = w;
        }
}

DI void attn_phase(const Params& p, int layer, float lam_init, float outmul, unsigned char* smem, int wv) {
    unsigned char* ws = p.ws;
    const bf16_t *QA = (const bf16_t*)(ws + OFF_QA), *KA = (const bf16_t*)(ws + OFF_KA), *VA = (const bf16_t*)(ws + OFF_VA), *QB = (const bf16_t*)(ws + OFF_QB),
                 *KB = (const bf16_t*)(ws + OFF_KB), *VB = (const bf16_t*)(ws + OFF_VB), *QC = (const bf16_t*)(ws + OFF_QC), *KC = (const bf16_t*)(ws + OFF_KC),
                 *VC = (const bf16_t*)(ws + OFF_VC);
    bf16_t* MIX = (bf16_t*)(ws + OFF_MIX);
    float s1 = 0.f, s2 = 0.f;
    for (int j = 0; j < 32; ++j) { s1 += p.lq1[layer * 32 + j] * p.lk1[layer * 32 + j]; s2 += p.lq2[layer * 32 + j] * p.lk2[layer * 32 + j]; }
    const float lam = __int_as_float(__builtin_amdgcn_readfirstlane(__float_as_int(expf(s1) - expf(s2) + lam_init)));
    for (int v = bid_opaque(); v < 2048; v += gridDim.x) {
        const int base = v & ~255, i = v & 255, j = i >> 3;
        const int u = base + ((i & 7) * 2 + (j >> 4)) * 16 + (j & 15);
        if (u < 512) {
            const int qb = u & 15, hh = (u >> 4) & 3, b = u >> 6;
            const size_t ro = (size_t)(b * 4 + hh) * SEQ * 64;
            const float slope2 = __int_as_float(__builtin_amdgcn_readfirstlane(__float_as_int(exp2f(-2.0f * (float)(hh + 1)) * LOG2E)));
            attn_unit<64, true>(QC + ro, KC + ro, VC + ro, qb * 256, MIX + (size_t)b * SEQ * XLD + 768 + hh * 64, slope2, lam, outmul,
                                p.subln + layer * 64, smem, wv);
        } else if (u < 1024) {
            const int w = u - 512, qb = w & 15, hh = (w >> 4) & 3, b = w >> 6;
            const size_t rq = (size_t)(b * 4 + hh) * SEQ;
            attn_unit<96, false>(QB + rq * 96, KB + rq * 96, VB + rq * 64, qb * 256, MIX + (size_t)b * SEQ * XLD + 512 + hh * 64, 0.f, 0.f, 0.f, nullptr, smem, wv);
        } else {
            const int w = u - 1024, qb = w & 15, hh = (w >> 4) & 7, b = w >> 7;
            const size_t rq = (size_t)(b * 8 + hh) * SEQ, rk = (size_t)(b * 2 + (hh >> 2)) * SEQ;
            attn_unit<64, false>(QA + rq * 64, KA + rk * 64, VA + rk * 64, qb * 256, MIX + (size_t)b * SEQ * XLD + hh * 64, 0.f, 0.f, 0.f, nullptr, smem, wv);
        }
    }
}

__global__ void __launch_bounds__(NTHR, 2) mega(Params p) {
    extern __shared__ __attribute__((aligned(16))) unsigned char smem[];
    cg::grid_group grid = cg::this_grid();
    unsigned char* ws = p.ws;
    const int gtid = blockIdx.x * NTHR + threadIdx.x, gthreads = gridDim.x * NTHR;
    const int wv = __builtin_amdgcn_readfirstlane((int)(threadIdx.x >> 6));
    bf16_t* XB = (bf16_t*)(ws + OFF_XB);
    float* SSX = (float*)(ws + OFF_SSX);
    float* tab = (float*)(ws + OFF_TAB);

    for (int l = 0; l < 2; ++l) {
        prep_weight<false>(p.w_in + (size_t)l * 1024 * INW, p.norm_attn + l * 1024, (bf16_t*)(ws + OFF_WIN) + (size_t)l * INWP * XLD, XLD, 1024, INW, INWP, gtid, gthreads);
        prep_weight<false>(p.w_uq + (size_t)l * 192 * 384, p.qan_b + l * 192, (bf16_t*)(ws + OFF_WUQ) + (size_t)l * 512 * 192, 192, 192, 384, 512, gtid, gthreads);
        prep_weight<false>(p.w_ukv + (size_t)l * 128 * 512, p.kvn_b + l * 128, (bf16_t*)(ws + OFF_WUKV) + (size_t)l * 512 * 128, 128, 128, 512, 512, gtid, gthreads);
        prep_weight<false>(p.w_out + (size_t)l * 1024 * 1024, nullptr, (bf16_t*)(ws + OFF_WOUT) + (size_t)l * 1024 * XLD, XLD, 1024, 1024, 1024, gtid, gthreads);
        prep_weight<true>(p.w_up + (size_t)l * 1024 * DFF2, p.norm_ffn + l * 1024, (bf16_t*)(ws + OFF_WUP) + (size_t)l * DFF2 * XLD, XLD, 1024, DFF2, DFF2, gtid, gthreads);
        prep_weight<false>(p.w_down + (size_t)l * DFF * 1024, nullptr, (bf16_t*)(ws + OFF_WDN) + (size_t)l * 1024 * ALD, ALD, DFF, 1024, 1024, gtid, gthreads);
    }
    for (int idx = gtid; idx < 1024 + 512; idx += gthreads) {
        if (idx < 1024) { const int pos = idx >> 4, f = idx & 15; const float ang = (float)pos * powf(10000.0f, -(float)f / 16.0f); tab[idx] = cosf(ang); tab[1024 + idx] = sinf(ang); }
        else { const int k = idx - 1024, pos = k >> 3, f = k & 7; const float ang = (float)pos * powf(10000.0f, -(float)f / 8.0f); tab[2048 + k] = cosf(ang); tab[2560 + k] = sinf(ang); }
    }
    convert_x(p.x, XB, SSX, wv);
    grid.sync();

    for (int l = 0; l < 2; ++l) {
        const float lam_init = __int_as_float(__builtin_amdgcn_readfirstlane(__float_as_int((l == 0) ? 0.2f : 0.35550906759096984f)));
        const float* xin = (l == 0) ? p.x : p.out;
        gemm_phase(XB, XLD, (const bf16_t*)(ws + OFF_WIN) + (size_t)l * INWP * XLD, XLD, 1024, M_TOK, INWP, smem,
                   EpiInProj{SSX, tab, p.qn_a + l * 64, p.kn_a + l * 64, (bf16_t*)(ws + OFF_QA), (bf16_t*)(ws + OFF_KA), (bf16_t*)(ws + OFF_VA), (bf16_t*)(ws + OFF_CQ),
                             (bf16_t*)(ws + OFF_CKV), (bf16_t*)(ws + OFF_KB), (bf16_t*)(ws + OFF_QC), (bf16_t*)(ws + OFF_KC), (bf16_t*)(ws + OFF_VC),
                             (float*)(ws + OFF_SSCQ), (float*)(ws + OFF_SSCKV)}, wv);
        grid.sync();
        gemm_phase((const bf16_t*)(ws + OFF_CQ), 192, (const bf16_t*)(ws + OFF_WUQ) + (size_t)l * 512 * 192, 192, 192, M_TOK, 512, smem,
                   EpiMlaQ{(bf16_t*)(ws + OFF_QB), tab, (const float*)(ws + OFF_SSCQ), 0.10206207261596575f * LOG2E}, wv);
        gemm_phase((const bf16_t*)(ws + OFF_CKV), 128, (const bf16_t*)(ws + OFF_WUKV) + (size_t)l * 512 * 128, 128, 128, M_TOK, 512, smem,
                   EpiMlaKV{(bf16_t*)(ws + OFF_KB), (bf16_t*)(ws + OFF_VB), (const float*)(ws + OFF_SSCKV)}, wv);
        grid.sync();
        attn_phase(p, l, lam_init, __int_as_float(__builtin_amdgcn_readfirstlane(__float_as_int((l == 0) ? 0.8f : 0.64449093240903016f))), smem, wv);
        grid.sync();
        gemm_phase((const bf16_t*)(ws + OFF_MIX), XLD, (const bf16_t*)(ws + OFF_WOUT) + (size_t)l * 1024 * XLD, XLD, 1024, M_TOK, 1024, smem, EpiResid2{xin, p.out, XB, SSX}, wv);
        grid.sync();
        up_conv_phase(XB, (const bf16_t*)(ws + OFF_WUP) + (size_t)l * DFF2 * XLD, SSX, p.conv_w + (size_t)l * 3 * DFF2, p.conv_b + (size_t)l * DFF2, (bf16_t*)(ws + OFF_ACT), smem, wv);
        grid.sync();
        gemm_phase((const bf16_t*)(ws + OFF_ACT), ALD, (const bf16_t*)(ws + OFF_WDN) + (size_t)l * 1024 * ALD, ALD, DFF, M_TOK, 1024, smem, EpiResid2{p.out, p.out, XB, SSX}, wv);
        grid.sync();
    }
    final_norm(p.out, p.final_norm, SSX, wv);
}

extern "C" void kernel_launch(void* const* d_in, const int* in_sizes, int n_in, void* d_out, int out_size, void* d_ws, size_t ws_size, hipStream_t stream) {
    static int grid_blocks = 0;
    if (!grid_blocks) {
        int dev = 0, cus = 0, per_cu = 0;
        hipGetDevice(&dev);
        hipDeviceGetAttribute(&cus, hipDeviceAttributeMultiprocessorCount, dev);
        hipFuncSetAttribute((const void*)mega, hipFuncAttributeMaxDynamicSharedMemorySize, SMEM_TOTAL);
        hipOccupancyMaxActiveBlocksPerMultiprocessor(&per_cu, mega, NTHR, SMEM_TOTAL);
        if (per_cu > 1) per_cu = 1;
        if (per_cu < 1) per_cu = 1;
        grid_blocks = (cus * per_cu) & ~7;
    }
    Params p{};
    const float** pp = (const float**)&p;
    for (int i = 0; i < 21; ++i) pp[i] = (const float*)d_in[i];
    p.out = (float*)d_out;
    p.ws = (unsigned char*)d_ws;
    void* args[] = {&p};
    hipError_t e = hipLaunchCooperativeKernel((void*)mega, dim3(grid_blocks), dim3(NTHR), args, SMEM_TOTAL, stream);
    if (e != hipSuccess) fprintf(stderr, "cooperative launch failed: %s (grid %d)\n", hipGetErrorString(e), grid_blocks);
}
```

```cpp
#include <hip/hip_runtime.h>
#include <hip/hip_cooperative_groups.h>
#include <stdint.h>
#include <math.h>
#include <stdio.h>
namespace cg = cooperative_groups;

typedef unsigned short bf16_t;
typedef short bf16x8 __attribute__((ext_vector_type(8)));
typedef short s16x4 __attribute__((ext_vector_type(4)));
typedef float f32x4 __attribute__((ext_vector_type(4)));
typedef float f32x16 __attribute__((ext_vector_type(16)));
typedef unsigned u32x4 __attribute__((ext_vector_type(4)));
typedef unsigned u32x2 __attribute__((ext_vector_type(2)));
typedef __bf16 bf2_t __attribute__((ext_vector_type(2)));
typedef float f32x2 __attribute__((ext_vector_type(2)));
#define DI __device__ __forceinline__

constexpr int M_TOK = 32768, SEQ = 4096, DM = 1024, INW = 1888, INWP = 2048, DFF = 2816, DFF2 = 5632;
constexpr float EPS = 1e-6f;
constexpr float LOG2E = 1.4426950408889634f;
constexpr int NTHR = 512, NWAVE = NTHR / 64;
constexpr int XLD = 1024 + 64, ALD = DFF + 64;

constexpr size_t SZ_WIN = (size_t)2 * INWP * XLD * 2, SZ_WUQ = (size_t)2 * 512 * 192 * 2, SZ_WUKV = (size_t)2 * 512 * 128 * 2,
                 SZ_WOUT = (size_t)2 * 1024 * XLD * 2, SZ_WUP = (size_t)2 * DFF2 * XLD * 2, SZ_WDN = (size_t)2 * 1024 * ALD * 2;
constexpr size_t OFF_WIN = 0, OFF_WUQ = OFF_WIN + SZ_WIN, OFF_WUKV = OFF_WUQ + SZ_WUQ, OFF_WOUT = OFF_WUKV + SZ_WUKV,
                 OFF_WUP = OFF_WOUT + SZ_WOUT, OFF_WDN = OFF_WUP + SZ_WUP, OFF_TAB = OFF_WDN + SZ_WDN, OFF_XB = OFF_TAB + 16384;
constexpr size_t OFF_SSX = OFF_XB + (size_t)M_TOK * XLD * 2, OFF_SSCQ = OFF_SSX + (size_t)M_TOK * 16 * 4, OFF_SSCKV = OFF_SSCQ + (size_t)M_TOK * 4 * 4,
                 OFF_BIG = OFF_SSCKV + (size_t)M_TOK * 2 * 4;
constexpr size_t OFF_QA = OFF_BIG, OFF_KA = OFF_QA + (size_t)M_TOK * 512 * 2,
                 OFF_VA = OFF_KA + (size_t)M_TOK * 128 * 2, OFF_CQ = OFF_VA + (size_t)M_TOK * 128 * 2, OFF_CKV = OFF_CQ + (size_t)M_TOK * 192 * 2,
                 OFF_QB = OFF_CKV + (size_t)M_TOK * 128 * 2, OFF_KB = OFF_QB + (size_t)M_TOK * 384 * 2, OFF_VB = OFF_KB + (size_t)M_TOK * 384 * 2,
                 OFF_QC = OFF_VB + (size_t)M_TOK * 256 * 2, OFF_KC = OFF_QC + (size_t)M_TOK * 256 * 2, OFF_VC = OFF_KC + (size_t)M_TOK * 256 * 2,
                 OFF_MIX = OFF_VC + (size_t)M_TOK * 256 * 2, OFF_END1 = OFF_MIX + (size_t)M_TOK * XLD * 2;
constexpr size_t OFF_ACT = OFF_BIG, OFF_END2 = OFF_ACT + (size_t)M_TOK * ALD * 2;
static_assert(OFF_END1 <= (size_t)512 * 1024 * 1024 && OFF_END2 <= (size_t)512 * 1024 * 1024, "workspace");

struct Params {
    const float *x, *norm_attn, *w_in, *qn_a, *kn_a, *qan_b, *w_uq, *kvn_b, *w_ukv, *lq1, *lk1, *lq2, *lk2, *subln, *w_out, *norm_ffn, *w_up,
        *conv_w, *conv_b, *w_down, *final_norm;
    float* out;
    unsigned char* ws;
};

DI unsigned pk2(float a, float b) { f32x2 v = {a, b}; bf2_t r = __builtin_convertvector(v, bf2_t); return __builtin_bit_cast(unsigned, r); }
DI void unpack8(u32x4 r, float* v) {
    v[0] = __uint_as_float(r.x << 16); v[1] = __uint_as_float(r.x & 0xffff0000u);
    v[2] = __uint_as_float(r.y << 16); v[3] = __uint_as_float(r.y & 0xffff0000u);
    v[4] = __uint_as_float(r.z << 16); v[5] = __uint_as_float(r.z & 0xffff0000u);
    v[6] = __uint_as_float(r.w << 16); v[7] = __uint_as_float(r.w & 0xffff0000u);
}
DI u32x4 pack8(const float* v) { u32x4 r; r.x = pk2(v[0], v[1]); r.y = pk2(v[2], v[3]); r.z = pk2(v[4], v[5]); r.w = pk2(v[6], v[7]); return r; }
DI int tid_opaque(int wv) { int t; asm volatile("v_mbcnt_lo_u32_b32 %0, -1, 0\n\tv_mbcnt_hi_u32_b32 %0, -1, %0" : "=v"(t)); return t | (wv << 6); }
DI int bid_opaque() { int b = blockIdx.x; asm volatile("" : "+s"(b)); return b; }
DI float shflx(float v, int mask, int lane) { return __int_as_float(__builtin_amdgcn_ds_bpermute((lane ^ mask) << 2, __float_as_int(v))); }
DI float wave_sum(float v, int lane) {
#pragma unroll
    for (int o = 32; o >= 1; o >>= 1) v += shflx(v, o, lane);
    return v;
}

template <bool UPPERM>
DI void prep_weight(const float* __restrict__ W, const float* __restrict__ gain, bf16_t* __restrict__ Wt, int ldw, int K, int N, int Npad, int gtid, int gthreads) {
    const int total = Npad * (K / 8);
    for (int idx = gtid; idx < total; idx += gthreads) {
        const int n = idx % Npad, kc = idx / Npad;
        int ns = n;
        if (UPPERM) { const int j = n >> 8, r = n & 255; ns = (r < 128) ? (128 * j + r) : (DFF + 128 * j + r - 128); }
        float v[8];
#pragma unroll
        for (int j = 0; j < 8; ++j) { const int k = kc * 8 + j; v[j] = (n < N) ? W[(size_t)k * N + ns] * (gain ? gain[k] : 1.0f) : 0.f; }
        *(u32x4*)(Wt + (size_t)n * ldw + kc * 8) = pack8(v);
    }
}

DI void convert_x(const float* X, bf16_t* XB, float* SSX, int wv) {
    const int tid_ = tid_opaque(wv);
    const int lane = tid_ & 63, gw = bid_opaque() * NWAVE + (tid_ >> 6), nw = gridDim.x * NWAVE;
    for (int row = gw; row < M_TOK; row += nw) {
        const f32x4* xr = (const f32x4*)(X + (size_t)row * 1024);
        float ss = 0.f;
#pragma unroll
        for (int i = 0; i < 4; ++i) {
            const f32x4 v = xr[lane + 64 * i];
            ss += v[0] * v[0] + v[1] * v[1] + v[2] * v[2] + v[3] * v[3];
            u32x2 w; w.x = pk2(v[0], v[1]); w.y = pk2(v[2], v[3]);
            *(u32x2*)(XB + (size_t)row * XLD + (lane + 64 * i) * 4) = w;
        }
        ss = wave_sum(ss, lane);
        if (lane < 16) SSX[(size_t)row * 16 + lane] = (lane == 0) ? ss : 0.f;
    }
}
DI void final_norm(float* X, const float* __restrict__ g, const float* SSX, int wv) {
    const int tid_ = tid_opaque(wv);
    const int lane = tid_ & 63, gw = bid_opaque() * NWAVE + (tid_ >> 6), nw = gridDim.x * NWAVE;
    for (int row = gw; row < M_TOK; row += nw) {
        float ss = (lane < 16) ? SSX[(size_t)row * 16 + lane] : 0.f;
        ss = wave_sum(ss, lane);
        const float rstd = rsqrtf(ss * (1.0f / 1024.0f) + EPS);
        f32x4* xr = (f32x4*)(X + (size_t)row * 1024);
#pragma unroll
        for (int i = 0; i < 4; ++i) { const f32x4 gv = ((const f32x4*)g)[lane + 64 * i]; xr[lane + 64 * i] = xr[lane + 64 * i] * rstd * gv; }
    }
}
DI float row_rstd(const float* ssx, int m) {
    const f32x4* pp = (const f32x4*)(ssx + (size_t)m * 16);
    const f32x4 a = (pp[0] + pp[1]) + (pp[2] + pp[3]);
    return rsqrtf(((a[0] + a[1]) + (a[2] + a[3])) * (1.0f / 1024.0f) + EPS);
}

constexpr int GSTR = 128, GOP = 256 * GSTR;
constexpr int SMEM_BYTES = 4 * GOP;
constexpr int SMEM_CONV = 256 * 132 * 4;
constexpr int SMEM_TOTAL = SMEM_CONV > SMEM_BYTES ? SMEM_CONV : SMEM_BYTES;

DI void gemm_mainloop(const bf16_t* __restrict__ Ab, const unsigned (&aoff)[4], const bool (&av)[4], const bf16_t* __restrict__ Bb, unsigned boff, int ldb, int nk, unsigned char* smem, f32x4 (&acc)[8][4], int tid) {
    const int lane = tid & 63, wid = tid >> 6, wr = wid >> 2, wc = wid & 3;
    const int lrow = tid >> 3, lc = tid & 7;
    u32x4 ra[4], rb[4];
#pragma unroll
    for (int i = 0; i < 8; ++i)
#pragma unroll
        for (int j = 0; j < 4; ++j) acc[i][j] = (f32x4){0.f, 0.f, 0.f, 0.f};
    const u32x4 zero4 = {0u, 0u, 0u, 0u};
#define G_LOAD(KT) { _Pragma("unroll") for (int i = 0; i < 4; ++i) { const u32x4 t_ = *(const u32x4*)((const unsigned char*)Ab + (size_t)(aoff[i] + (unsigned)((KT) * 128))); ra[i] = av[i] ? t_ : zero4; rb[i] = *(const u32x4*)((const unsigned char*)Bb + (size_t)(boff + (unsigned)(i * 128 * ldb) + (unsigned)((KT) * 128))); } }
#define G_WRITE(BUF) { int so_ = (BUF) * 2 * GOP + wboff; asm volatile("" : "+v"(so_)); unsigned char* wb_ = smem + so_; _Pragma("unroll") for (int i = 0; i < 4; ++i) { *(u32x4*)(wb_ + i * 64 * GSTR) = ra[i]; *(u32x4*)(wb_ + GOP + i * 64 * GSTR) = rb[i]; } }
    const int wboff = lrow * GSTR + ((lc ^ (lrow & 7)) << 4);
    const int foff = (lane & 15) * GSTR;
    const int fsw[2] = {(((lane >> 4)) ^ (lane & 7)) << 4, (((lane >> 4) + 4) ^ (lane & 7)) << 4};
    G_LOAD(0);
    G_WRITE(0);
    __syncthreads();
    for (int kt = 0; kt < nk; ++kt) {
        { const int kl = (kt + 1 < nk) ? kt + 1 : nk - 1; G_LOAD(kl); }
        const unsigned char* sa = smem + (kt & 1) * 2 * GOP + wr * 128 * GSTR + foff;
        const unsigned char* sb = smem + (kt & 1) * 2 * GOP + GOP + wc * 64 * GSTR + foff;
        int so_ = ((kt + 1) & 1) * 2 * GOP + wboff; asm volatile("" : "+v"(so_));
        unsigned char* wb_ = smem + so_;
#pragma unroll
        for (int kk = 0; kk < 2; ++kk) {
            bf16x8 af[8], bfr[4];
#pragma unroll
            for (int i = 0; i < 4; ++i) bfr[i] = *(const bf16x8*)(sb + i * 16 * GSTR + fsw[kk]);
#pragma unroll
            for (int i = 0; i < 8; ++i) af[i] = *(const bf16x8*)(sa + i * 16 * GSTR + fsw[kk]);
#pragma unroll
            for (int mi = 0; mi < 8; ++mi) {
#pragma unroll
                for (int ni = 0; ni < 4; ++ni) acc[mi][ni] = __builtin_amdgcn_mfma_f32_16x16x32_bf16(bfr[ni], af[mi], acc[mi][ni], 0, 0, 0);
                if (kk == 1) { if (mi < 4) *(u32x4*)(wb_ + mi * 64 * GSTR) = ra[mi]; else *(u32x4*)(wb_ + GOP + (mi - 4) * 64 * GSTR) = rb[mi - 4]; }
            }
        }
        __builtin_amdgcn_sched_group_barrier(0x008, 32, 0);
#pragma unroll
        for (int g = 0; g < 8; ++g) { __builtin_amdgcn_sched_group_barrier(0x008, 4, 0); __builtin_amdgcn_sched_group_barrier(0x200, 1, 0); }
        __syncthreads();
    }
#undef G_LOAD
#undef G_WRITE
}

template <class Epi>
DI void gemm_tile(const bf16_t* __restrict__ A, int lda, const bf16_t* __restrict__ Bt, int ldb, int K, int m0, int n0, unsigned char* smem, const Epi& epi, int wv) {
    const int tid = tid_opaque(wv), lane = tid & 63, wid = tid >> 6, wr = wid >> 2, wc = wid & 3;
    const int lrow = tid >> 3, lc = tid & 7;
    unsigned aoff[4];
    const bool av[4] = {true, true, true, true};
#pragma unroll
    for (int i = 0; i < 4; ++i) aoff[i] = (unsigned)((lrow + 64 * i) * lda + lc * 8) * 2u;
    const unsigned boff = (unsigned)(lrow * ldb + lc * 8) * 2u;
    f32x4 acc[8][4];
    gemm_mainloop(A + (size_t)m0 * lda, aoff, av, Bt + (size_t)n0 * ldb, boff, ldb, K / 64, smem, acc, tid);
    epi(acc, m0 + wr * 128, n0 + wc * 64, lane);
}

template <class Epi>
DI void gemm_phase(const bf16_t* A, int lda, const bf16_t* Bt, int ldb, int K, int Mrows, int Ncols, unsigned char* smem, const Epi& epi, int wv) {
    const int nN = Ncols / 256, nM = Mrows / 256;
    const int bid = bid_opaque(), G = gridDim.x;
    const int xcd = bid & 7, lb = bid >> 3, nlb = G >> 3, mper = nM >> 3, nloc = mper * nN;
    for (int j = lb; j < nloc; j += nlb) {
        const int g = j / (4 * nN), rem = j - g * 4 * nN;
        const int mt = xcd * mper + g * 4 + (rem & 3), nt = rem >> 2;
        gemm_tile(A, lda, Bt, ldb, K, mt * 256, nt * 256, smem, epi, wv);
    }
}

DI float dot4(f32x4 a) { return (a[0] * a[0] + a[1] * a[1]) + (a[2] * a[2] + a[3] * a[3]); }
DI void st4bf(bf16_t* dst, f32x4 v) { u32x2 w; w.x = pk2(v[0], v[1]); w.y = pk2(v[2], v[3]); *(u32x2*)dst = w; }

struct EpiResid2 {
    const float* Xin; float* Xout; bf16_t* XB; float* SSX;
    DI void operator()(const f32x4 (&acc)[8][4], int mb, int nb, int lane) const {
        const int q = lane >> 4;
#pragma unroll
        for (int mi = 0; mi < 8; ++mi) {
            const int m = mb + mi * 16 + (lane & 15);
            float ss = 0.f;
#pragma unroll
            for (int ni = 0; ni < 4; ++ni) {
                const size_t o = (size_t)m * 1024 + nb + ni * 16 + q * 4;
                f32x4 r = *(const f32x4*)(Xin + o);
                r += acc[mi][ni];
                *(f32x4*)(Xout + o) = r;
                st4bf(XB + (size_t)m * XLD + nb + ni * 16 + q * 4, r);
                ss += dot4(r);
            }
            ss += shflx(ss, 16, lane); ss += shflx(ss, 32, lane);
            if (q == 0) SSX[(size_t)m * 16 + (nb >> 6)] = ss;
        }
    }
};

struct EpiInProj {
    const float *ssx, *tab, *gq, *gk;
    bf16_t *QA, *KA, *VA, *CQ, *CKV, *KB, *QC, *KC, *VC;
    float *sscq, *ssckv;
    DI void operator()(const f32x4 (&acc)[8][4], int mb, int nb, int lane) const {
        const int q = lane >> 4, ml = lane & 15;
        const float qsA = 0.125f * LOG2E, qsC = 0.17677669529663687f * LOG2E;
        if (nb < 640) {
            const bool isq = nb < 512;
            const int head = isq ? (nb >> 6) : ((nb - 512) >> 6);
            const float* g = isq ? gq : gk;
            f32x4 gv[4];
#pragma unroll
            for (int ni = 0; ni < 4; ++ni) gv[ni] = *(const f32x4*)(g + ni * 16 + q * 4);
#pragma unroll
            for (int mi = 0; mi < 8; ++mi) {
                const int m = mb + mi * 16 + ml, b = m >> 12, s = m & 4095;
                const float rs = row_rstd(ssx, m);
                f32x4 v[4];
                float ss = 0.f;
#pragma unroll
                for (int ni = 0; ni < 4; ++ni) { v[ni] = acc[mi][ni] * rs; ss += dot4(v[ni]); }
                ss += shflx(ss, 16, lane); ss += shflx(ss, 32, lane);
                const float r2 = rsqrtf(ss * (1.0f / 64.0f) + EPS);
#pragma unroll
                for (int ni = 0; ni < 4; ++ni) v[ni] = v[ni] * r2 * gv[ni];
                const float* tr = tab + (s >> 6) * 16 + q * 4;
                const float* tq = tab + (s & 63) * 16 + q * 4;
                const f32x4 c0 = *(const f32x4*)tr, s0 = *(const f32x4*)(tr + 1024), c1 = *(const f32x4*)tq, s1 = *(const f32x4*)(tq + 1024);
                f32x4 o0 = v[0] * c0 - v[1] * s0, o1 = v[1] * c0 + v[0] * s0, o2 = v[2] * c1 - v[3] * s1, o3 = v[3] * c1 + v[2] * s1;
                bf16_t* dst;
                if (isq) { o0 *= qsA; o1 *= qsA; o2 *= qsA; o3 *= qsA; dst = QA + ((size_t)(b * 8 + head) * SEQ + s) * 64 + q * 4; }
                else dst = KA + ((size_t)(b * 2 + head) * SEQ + s) * 64 + q * 4;
                st4bf(dst, o0); st4bf(dst + 16, o1); st4bf(dst + 32, o2); st4bf(dst + 48, o3);
            }
        } else if (nb < 768) {
            const int head = (nb - 640) >> 6;
#pragma unroll
            for (int mi = 0; mi < 8; ++mi) {
                const int m = mb + mi * 16 + ml, b = m >> 12, s = m & 4095;
                const float rs = row_rstd(ssx, m);
                bf16_t* dst = VA + ((size_t)(b * 2 + head) * SEQ + s) * 64 + q * 4;
#pragma unroll
                for (int ni = 0; ni < 4; ++ni) st4bf(dst + ni * 16, acc[mi][ni] * rs);
            }
        } else {
            const bool sq = nb < 1088;
#pragma unroll
            for (int mi = 0; mi < 8; ++mi) {
                const int m = mb + mi * 16 + ml, b = m >> 12, s = m & 4095;
                const float rs = row_rstd(ssx, m);
                float ss = 0.f;
#pragma unroll
                for (int ni = 0; ni < 4; ++ni) {
                    const int n16 = nb + ni * 16;
                    f32x4 v = acc[mi][ni] * rs;
                    if (n16 < 960) { st4bf(CQ + (size_t)m * 192 + (n16 - 768) + q * 4, v); ss += dot4(v); }
                    else if (n16 < 1088) { st4bf(CKV + (size_t)m * 128 + (n16 - 960) + q * 4, v); ss += dot4(v); }
                    else if (n16 < 1120) {
                        f32x4 pr;
#pragma unroll
                        for (int i = 0; i < 4; ++i) pr[i] = shflx(v[i], 32, lane);
                        const int pos = (n16 >= 1104) ? (s & 63) : (s >> 6);
                        const float* tc = tab + 2048 + pos * 8 + (q & 1) * 4;
                        const f32x4 c = *(const f32x4*)tc, sn = *(const f32x4*)(tc + 512);
                        const f32x4 o = (q < 2) ? (v * c - pr * sn) : (v * c + pr * sn);
#pragma unroll
                        for (int hh = 0; hh < 4; ++hh) st4bf(KB + ((size_t)(b * 4 + hh) * SEQ + s) * 96 + 64 + (n16 - 1088) + q * 4, o);
                    } else if (n16 < 1376) { const int c = n16 - 1120 + q * 4; st4bf(QC + ((size_t)(b * 4 + (c >> 6)) * SEQ + s) * 64 + (c & 63), v * qsC); }
                    else if (n16 < 1632) { const int c = n16 - 1376 + q * 4; st4bf(KC + ((size_t)(b * 4 + (c >> 6)) * SEQ + s) * 64 + (c & 63), v); }
                    else if (n16 < 1888) { const int c = n16 - 1632 + q * 4; st4bf(VC + ((size_t)(b * 4 + (c >> 6)) * SEQ + s) * 64 + (c & 63), v); }
                }
                if (sq) {
                    ss += shflx(ss, 16, lane); ss += shflx(ss, 32, lane);
                    if (q == 0) { if (nb < 960) sscq[(size_t)m * 4 + ((nb - 768) >> 6)] = ss; else ssckv[(size_t)m * 2 + ((nb - 960) >> 6)] = ss; }
                }
            }
        }
    }
};
struct EpiMlaQ {
    bf16_t* QB; const float* tab; const float* sscq; float qscale;
    DI void operator()(const f32x4 (&acc)[8][4], int mb, int nb, int lane) const {
#pragma unroll
        for (int mi = 0; mi < 8; ++mi) {
            const int m = mb + mi * 16 + (lane & 15), q = lane >> 4, b = m >> 12, s = m & 4095;
            const f32x4 sp = *(const f32x4*)(sscq + (size_t)m * 4);
            const float rs = rsqrtf((sp[0] + sp[1] + sp[2]) * (1.0f / 192.0f) + EPS) * qscale;
#pragma unroll
            for (int ni = 0; ni < 4; ++ni) {
                const int nt = nb + ni * 16;
                if (nt >= 384) continue;
                const int head = nt / 96, dt = nt - head * 96;
                f32x4 v = acc[mi][ni] * rs;
                f32x4 pr;
#pragma unroll
                for (int i = 0; i < 4; ++i) pr[i] = shflx(v[i], 32, lane);
                if (dt >= 64) {
                    const int pos = (dt >= 80) ? (s & 63) : (s >> 6);
                    const float* tc = tab + 2048 + pos * 8 + (q & 1) * 4;
                    const f32x4 c = *(const f32x4*)tc, sn = *(const f32x4*)(tc + 512);
                    v = (q < 2) ? (v * c - pr * sn) : (v * c + pr * sn);
                }
                st4bf(QB + ((size_t)(b * 4 + head) * SEQ + s) * 96 + dt + q * 4, v);
            }
        }
    }
};
struct EpiMlaKV {
    bf16_t* KB; bf16_t* VB; const float* ssckv;
    DI void operator()(const f32x4 (&acc)[8][4], int mb, int nb, int lane) const {
#pragma unroll
        for (int mi = 0; mi < 8; ++mi) {
            const int m = mb + mi * 16 + (lane & 15), b = m >> 12, s = m & 4095;
            const f32x2 sp = *(const f32x2*)(ssckv + (size_t)m * 2);
            const float rs = rsqrtf((sp[0] + sp[1]) * (1.0f / 128.0f) + EPS);
#pragma unroll
            for (int ni = 0; ni < 4; ++ni) {
                const int n = nb + ni * 16 + (lane >> 4) * 4;
                const int head = n >> 7, d = n & 127;
                const size_t rowi = (size_t)(b * 4 + head) * SEQ + s;
                if (d < 64) st4bf(KB + rowi * 96 + d, acc[mi][ni] * rs);
                else st4bf(VB + rowi * 64 + (d - 64), acc[mi][ni] * rs);
            }
        }
    }
};

DI void up_conv_tile(const bf16_t* __restrict__ XB, const bf16_t* __restrict__ Wt, const float* __restrict__ ssx, const float* __restrict__ cw, const float* __restrict__ cb,
                     bf16_t* __restrict__ ACT, int b, int jt, int nt, unsigned char* smem, int wv) {
    const int tid = tid_opaque(wv), lane = tid & 63, wid = tid >> 6, wr = wid >> 2, wc = wid & 3;
    const int lrow = tid >> 3, lc = tid & 7;
    const int tbase = jt * 254 - 1;
    unsigned aoff[4];
    bool av[4];
#pragma unroll
    for (int i = 0; i < 4; ++i) {
        const int tl = tbase + lrow + 64 * i;
        av[i] = (unsigned)tl < 4096u;
        const int tc = tl < 0 ? 0 : (tl > 4095 ? 4095 : tl);
        aoff[i] = (unsigned)(tc * XLD + lc * 8) * 2u;
    }
    const unsigned boff = (unsigned)(lrow * XLD + lc * 8) * 2u;
    f32x4 acc[8][4];
    gemm_mainloop(XB + (size_t)b * SEQ * XLD, aoff, av, Wt + (size_t)nt * 256 * XLD, boff, XLD, 16, smem, acc, tid);
    float* T = (float*)smem;
    const int q = lane >> 4, ml = lane & 15;
    float rs[8];
#pragma unroll
    for (int mi = 0; mi < 8; ++mi) {
        const int tl = tbase + wr * 128 + mi * 16 + ml;
        const int tc = tl < 0 ? 0 : (tl > 4095 ? 4095 : tl);
        rs[mi] = row_rstd(ssx, b * SEQ + tc);
    }
#pragma unroll
    for (int h = 0; h < 2; ++h) {
        if ((wc & 1) == h) {
#pragma unroll
            for (int mi = 0; mi < 8; ++mi)
#pragma unroll
                for (int ni = 0; ni < 4; ++ni) *(f32x4*)(T + (wr * 128 + mi * 16 + ml) * 132 + (wc >> 1) * 64 + ni * 16 + q * 4) = acc[mi][ni] * rs[mi];
        }
        __syncthreads();
        {
            const int cq = tid & 15, rg = tid >> 4, ch = nt * 128 + h * 64 + cq * 4;
            const f32x4 wg0 = *(const f32x4*)(cw + ch), wg1 = *(const f32x4*)(cw + DFF2 + ch), wg2 = *(const f32x4*)(cw + 2 * DFF2 + ch), bg = *(const f32x4*)(cb + ch);
            const f32x4 wv0 = *(const f32x4*)(cw + DFF + ch), wv1 = *(const f32x4*)(cw + DFF2 + DFF + ch), wv2 = *(const f32x4*)(cw + 2 * DFF2 + DFF + ch), bv = *(const f32x4*)(cb + DFF + ch);
            const int r0 = rg * 8, rm = r0 > 0 ? r0 - 1 : 0;
            f32x4 gm = *(const f32x4*)(T + rm * 132 + cq * 4), vm = *(const f32x4*)(T + rm * 132 + 64 + cq * 4);
            f32x4 g0 = *(const f32x4*)(T + r0 * 132 + cq * 4), v0 = *(const f32x4*)(T + r0 * 132 + 64 + cq * 4);
#pragma unroll
            for (int rr = 0; rr < 8; ++rr) {
                const int r = r0 + rr, rp = r < 255 ? r + 1 : 255;
                const f32x4 gp = *(const f32x4*)(T + rp * 132 + cq * 4), vp = *(const f32x4*)(T + rp * 132 + 64 + cq * 4);
                const f32x4 gg = wg0 * gm + wg1 * g0 + wg2 * gp + bg;
                const f32x4 vv = wv0 * vm + wv1 * v0 + wv2 * vp + bv;
                f32x4 o;
#pragma unroll
                for (int e = 0; e < 4; ++e) o[e] = gg[e] * __builtin_amdgcn_rcpf(1.0f + __builtin_amdgcn_exp2f(-LOG2E * gg[e])) * vv[e];
                const int tl = tbase + r;
                if (r >= 1 && r <= 254 && tl <= 4095) st4bf(ACT + ((size_t)b * SEQ + tl) * ALD + ch, o);
                gm = g0; g0 = gp; vm = v0; v0 = vp;
            }
        }
        __syncthreads();
    }
}
DI void up_conv_phase(const bf16_t* XB, const bf16_t* Wt, const float* ssx, const float* cw, const float* cb, bf16_t* ACT, unsigned char* smem, int wv) {
    constexpr int NT = DFF / 128, MT = 17;
    const int bid = bid_opaque(), G = gridDim.x;
    const int xcd = bid & 7, lb = bid >> 3, nlb = G >> 3, nloc = MT * NT, full = (MT / 4) * 4 * NT, gs = MT - (MT / 4) * 4;
    for (int j = lb; j < nloc; j += nlb) {
        int jt, nt;
        if (j < full) { const int g = j / (4 * NT), rem = j - g * 4 * NT; jt = g * 4 + (rem & 3); nt = rem >> 2; }
        else { const int j2 = j - full; jt = (MT / 4) * 4 + j2 % gs; nt = j2 / gs; }
        up_conv_tile(XB, Wt, ssx, cw, cb, ACT, xcd, jt, nt, smem, wv);
    }
}

constexpr int ATT_STAGE = 64 * 208 + 8192;

template <int DQK, bool DIFF>
DI void attn_tile(const unsigned char* cur, int kt, f32x16 (&O)[DIFF ? 2 : 1][2], float (&mrun)[DIFF ? 2 : 1], float (&lsum)[DIFF ? 2 : 1], const bf16x8 (&qf)[DIFF ? 2 : 1][DIFF ? 2 : DQK / 16],
               int kfo, int vfo0, int vfo1, float qpos, float slope2, int h) {
    constexpr int NQT = DIFF ? 2 : 1, KS = DIFF ? 2 : DQK / 16, KSTR = DQK * 2 + 16;
        bf16x8 kfr[2][KS], vfr[2][2][2];
#pragma unroll
        for (int kh = 0; kh < 2; ++kh)
#pragma unroll
            for (int ks = 0; ks < KS; ++ks) kfr[kh][ks] = *(const bf16x8*)(cur + kfo + kh * 32 * KSTR + (ks * 16) * 2);
        if (!DIFF) {
#pragma unroll
            for (int kh = 0; kh < 2; ++kh)
#pragma unroll
                for (int s2 = 0; s2 < 2; ++s2)
#pragma unroll
                    for (int d = 0; d < 2; ++d) {
                        const unsigned char* va = cur + (d ? vfo1 : vfo0) + (kh * 32 + 16 * s2) * 128;
                        const s16x4 lo = __builtin_amdgcn_ds_read_tr16_b64_v4i16((__attribute__((address_space(3))) s16x4*)(va));
                        const s16x4 hi = __builtin_amdgcn_ds_read_tr16_b64_v4i16((__attribute__((address_space(3))) s16x4*)(va + 8 * 128));
                        vfr[kh][s2][d] = __builtin_shufflevector(lo, hi, 0, 1, 2, 3, 4, 5, 6, 7);
                    }
        }
        __builtin_amdgcn_sched_barrier(0);
#pragma unroll
        for (int qt = 0; qt < NQT; ++qt) {
            bf16x8 pf[2][2];
            f32x16 S[2];
#pragma unroll
            for (int kh = 0; kh < 2; ++kh) {
#pragma unroll
                for (int i = 0; i < 16; ++i) S[kh][i] = 0.f;
#pragma unroll
                for (int ks = 0; ks < KS; ++ks) S[kh] = __builtin_amdgcn_mfma_f32_32x32x16_bf16(kfr[kh][ks], qf[qt][ks], S[kh], 0, 0, 0);
            }
            if (DIFF && qt == 0) {
#pragma unroll
                for (int kh = 0; kh < 2; ++kh)
#pragma unroll
                    for (int ks = 0; ks < KS; ++ks) kfr[kh][ks] = *(const bf16x8*)(cur + kfo + kh * 32 * KSTR + (32 + ks * 16) * 2);
            }
            if (DIFF) {
                const float d0 = qpos - (float)(kt * 64 + 4 * h);
#pragma unroll
                for (int kh = 0; kh < 2; ++kh)
#pragma unroll
                    for (int i = 0; i < 16; ++i) S[kh][i] -= slope2 * fabsf(d0 - (float)(kh * 32 + (i & 3) + 8 * (i >> 2)));
            }
            float mx = __builtin_elementwise_maximum(S[0][0], S[1][0]);
#pragma unroll
            for (int i = 1; i < 16; ++i) mx = __builtin_elementwise_maximum(mx, __builtin_elementwise_maximum(S[0][i], S[1][i]));
            { const auto sw = __builtin_amdgcn_permlane32_swap(__float_as_uint(mx), __float_as_uint(mx), false, false); mx = __builtin_elementwise_maximum(__uint_as_float(sw[0]), __uint_as_float(sw[1])); }
            const float rel = mx - mrun[qt];
            const bool need = (rel > 8.0f) || (kt == 0 && rel < -8.0f);
            if (__builtin_amdgcn_ballot_w64(need) != 0ull) {
                const float delta = need ? rel : 0.f;
                const float alpha = (kt == 0) ? 1.0f : __builtin_amdgcn_exp2f(-delta);
                mrun[qt] += delta;
                lsum[qt] *= alpha;
#pragma unroll
                for (int d = 0; d < 2; ++d)
#pragma unroll
                    for (int i = 0; i < 16; ++i) O[qt][d][i] *= alpha;
            }
            float ps = 0.f;
            if (__builtin_amdgcn_ballot_w64(mrun[qt] != 0.f) != 0ull) {
#pragma unroll
                for (int kh = 0; kh < 2; ++kh)
#pragma unroll
                    for (int i = 0; i < 16; ++i) { const float pv = __builtin_amdgcn_exp2f(S[kh][i] - mrun[qt]); S[kh][i] = pv; ps += pv; }
            } else {
#pragma unroll
                for (int kh = 0; kh < 2; ++kh)
#pragma unroll
                    for (int i = 0; i < 16; ++i) { const float pv = __builtin_amdgcn_exp2f(S[kh][i]); S[kh][i] = pv; ps += pv; }
            }
            lsum[qt] += ps;
#pragma unroll
            for (int kh = 0; kh < 2; ++kh)
#pragma unroll
                for (int s2 = 0; s2 < 2; ++s2) {
                    u32x4 w;
                    w.x = pk2(S[kh][8 * s2 + 0], S[kh][8 * s2 + 1]); w.y = pk2(S[kh][8 * s2 + 2], S[kh][8 * s2 + 3]);
                    w.z = pk2(S[kh][8 * s2 + 4], S[kh][8 * s2 + 5]); w.w = pk2(S[kh][8 * s2 + 6], S[kh][8 * s2 + 7]);
                    pf[kh][s2] = __builtin_bit_cast(bf16x8, w);
                }
#pragma unroll
            for (int kh = 0; kh < 2; ++kh)
#pragma unroll
                for (int s2 = 0; s2 < 2; ++s2)
#pragma unroll
                    for (int d = 0; d < 2; ++d) {
                        if (DIFF) {
                            const unsigned char* va = cur + (d ? vfo1 : vfo0) + (kh * 32 + 16 * s2) * 128;
                            const s16x4 lo = __builtin_amdgcn_ds_read_tr16_b64_v4i16((__attribute__((address_space(3))) s16x4*)(va));
                            const s16x4 hi = __builtin_amdgcn_ds_read_tr16_b64_v4i16((__attribute__((address_space(3))) s16x4*)(va + 8 * 128));
                            vfr[kh][s2][d] = __builtin_shufflevector(lo, hi, 0, 1, 2, 3, 4, 5, 6, 7);
                        }
                        O[qt][d] = __builtin_amdgcn_mfma_f32_32x32x16_bf16(vfr[kh][s2][d], pf[kh][s2], O[qt][d], 0, 0, 0);
                    }
            if (DIFF) __builtin_amdgcn_sched_barrier(0);
        }
}

template <int DQK, bool DIFF>
DI void attn_unit(const bf16_t* __restrict__ Qg, const bf16_t* __restrict__ Kg, const bf16_t* __restrict__ Vg, int q0, bf16_t* __restrict__ outp,
                  float slope2, float lam, float outmul, const float* __restrict__ subln, unsigned char* smem, int wv) {
    constexpr int NQT = DIFF ? 2 : 1, KS = DIFF ? 2 : DQK / 16, KSTR = DQK * 2 + 16, CPR = DQK / 8, KCH = (64 * CPR + NTHR - 1) / NTHR, KBYTES = 64 * 208;
    const int tid = tid_opaque(wv), lane = tid & 63, wid = tid >> 6, r = lane & 31, h = lane >> 5;
    const int qrow = q0 + wid * 32 + r;
    bf16x8 qf[NQT][KS];
#pragma unroll
    for (int qt = 0; qt < NQT; ++qt)
#pragma unroll
        for (int ks = 0; ks < KS; ++ks) qf[qt][ks] = *(const bf16x8*)(Qg + (size_t)qrow * DQK + qt * 32 + ks * 16 + h * 8);
    f32x16 O[NQT][2];
    float mrun[NQT], lsum[NQT];
#pragma unroll
    for (int qt = 0; qt < NQT; ++qt) {
        mrun[qt] = 0.f; lsum[qt] = 0.f;
#pragma unroll
        for (int d = 0; d < 2; ++d)
#pragma unroll
            for (int i = 0; i < 16; ++i) O[qt][d][i] = 0.f;
    }
    int koff[KCH], voff;
    bool kval[KCH];
#pragma unroll
    for (int i = 0; i < KCH; ++i) { const int id = tid + NTHR * i, key = id / CPR, c = id % CPR; koff[i] = key * KSTR + c * 16; kval[i] = id < 64 * CPR; }
    { const int key = tid >> 3, c = tid & 7; voff = KBYTES + key * 128 + ((c ^ (((key >> 1) & 1) << 2)) * 16); }
    u32x4 rk[KCH], rv;
#pragma unroll
    for (int i = 0; i < KCH; ++i) if (kval[i]) rk[i] = *(const u32x4*)(Kg + (size_t)(tid + NTHR * i) * 8);
    rv = *(const u32x4*)(Vg + (size_t)tid * 8);
#pragma unroll
    for (int i = 0; i < KCH; ++i) if (kval[i]) *(u32x4*)(smem + koff[i]) = rk[i];
    *(u32x4*)(smem + voff) = rv;
    __syncthreads();
    const int kfo = r * KSTR + h * 16;
    const int qq = (lane >> 2) & 3;
    const int colb0 = ((qq >> 1) & 1) * 64 + 32 * ((lane >> 4) & 1) + 8 * (lane & 3);
    const int vfo0 = KBYTES + (4 * h + qq) * 128 + colb0, vfo1 = KBYTES + (4 * h + qq) * 128 + (colb0 ^ 64);
    const float qpos = (float)qrow;

    u32x4 rk2[KCH], rv2;
#define AT_LOAD(RK, RV, T) { const int tn_ = (T) < SEQ / 64 ? (T) : SEQ / 64 - 1; _Pragma("unroll") for (int i = 0; i < KCH; ++i) RK[i] = *(const u32x4*)(Kg + (size_t)tn_ * 64 * DQK + (size_t)(kval[i] ? tid + NTHR * i : tid) * 8);     RV = *(const u32x4*)(Vg + (size_t)tn_ * 64 * 64 + (size_t)tid * 8); }
#define AT_WRITE(RK, RV, SO) { _Pragma("unroll") for (int i = 0; i < KCH; ++i) if (kval[i]) *(u32x4*)(smem + (SO) + koff[i]) = RK[i]; *(u32x4*)(smem + (SO) + voff) = RV; }
    AT_LOAD(rk2, rv2, 1);
    for (int kt = 0; kt < SEQ / 64; kt += 2) {
        AT_LOAD(rk, rv, kt + 2);
        attn_tile<DQK, DIFF>(smem, kt, O, mrun, lsum, qf, kfo, vfo0, vfo1, qpos, slope2, h);
        AT_WRITE(rk2, rv2, ATT_STAGE);
        __syncthreads();
        AT_LOAD(rk2, rv2, kt + 3);
        attn_tile<DQK, DIFF>(smem + ATT_STAGE, kt + 1, O, mrun, lsum, qf, kfo, vfo0, vfo1, qpos, slope2, h);
        AT_WRITE(rk, rv, 0);
        __syncthreads();
    }
#undef AT_LOAD
#undef AT_WRITE
    const int tid2 = tid_opaque(wv), lane2 = tid2 & 63;
    const int h2 = lane2 >> 5;
    float inv[NQT];
#pragma unroll
    for (int qt = 0; qt < NQT; ++qt) { const float lt = lsum[qt] + shflx(lsum[qt], 32, lane2); inv[qt] = 1.0f / lt; }
    float o[2][16];
    if (DIFF) {
        float ss = 0.f;
#pragma unroll
        for (int d = 0; d < 2; ++d)
#pragma unroll
            for (int i = 0; i < 16; ++i) { const float x = O[0][d][i] * inv[0] - lam * (O[NQT - 1][d][i] * inv[NQT - 1]); o[d][i] = x; ss += x * x; }
        ss += shflx(ss, 32, lane2);
        const float rstd = rsqrtf(ss * (1.0f / 64.0f) + EPS) * outmul;
#pragma unroll
        for (int d = 0; d < 2; ++d)
#pragma unroll
            for (int i = 0; i < 16; ++i) o[d][i] *= rstd * subln[d * 32 + (i & 3) + 8 * (i >> 2) + 4 * h2];
    } else {
#pragma unroll
        for (int d = 0; d < 2; ++d)
#pragma unroll
            for (int i = 0; i < 16; ++i) o[d][i] = O[0][d][i] * inv[0];
    }
    const int qrow2 = q0 + (lane2 & 31) + ((tid2 >> 6) << 5);
    bf16_t* orow = outp + (size_t)qrow2 * XLD;
#pragma unroll
    for (int d = 0; d < 2; ++d)
#pragma unroll
        for (int g = 0; g < 4; ++g) {
            u32x2 w; w.x = pk2(o[d][4 * g], o[d][4 * g + 1]); w.y = pk2(o[d][4 * g + 2], o[d][4 * g + 3]);
            *(u32x2*)(orow + d * 32 + 8 * g + 4 * h2) = w;
        }
}

DI void attn_phase(const Params& p, int layer, float lam_init, float outmul, unsigned char* smem, int wv) {
    unsigned char* ws = p.ws;
    const bf16_t *QA = (const bf16_t*)(ws + OFF_QA), *KA = (const bf16_t*)(ws + OFF_KA), *VA = (const bf16_t*)(ws + OFF_VA), *QB = (const bf16_t*)(ws + OFF_QB),
                 *KB = (const bf16_t*)(ws + OFF_KB), *VB = (const bf16_t*)(ws + OFF_VB), *QC = (const bf16_t*)(ws + OFF_QC), *KC = (const bf16_t*)(ws + OFF_KC),
                 *VC = (const bf16_t*)(ws + OFF_VC);
    bf16_t* MIX = (bf16_t*)(ws + OFF_MIX);
    float s1 = 0.f, s2 = 0.f;
    for (int j = 0; j < 32; ++j) { s1 += p.lq1[layer * 32 + j] * p.lk1[layer * 32 + j]; s2 += p.lq2[layer * 32 + j] * p.lk2[layer * 32 + j]; }
    const float lam = __int_as_float(__builtin_amdgcn_readfirstlane(__float_as_int(expf(s1) - expf(s2) + lam_init)));
    for (int v = bid_opaque(); v < 2048; v += gridDim.x) {
        const int base = v & ~255, i = v & 255, j = i >> 3;
        const int u = base + ((i & 7) * 2 + (j >> 4)) * 16 + (j & 15);
        if (u < 512) {
            const int qb = u & 15, hh = (u >> 4) & 3, b = u >> 6;
            const size_t ro = (size_t)(b * 4 + hh) * SEQ * 64;
            const float slope2 = __int_as_float(__builtin_amdgcn_readfirstlane(__float_as_int(exp2f(-2.0f * (float)(hh + 1)) * LOG2E)));
            attn_unit<64, true>(QC + ro, KC + ro, VC + ro, qb * 256, MIX + (size_t)b * SEQ * XLD + 768 + hh * 64, slope2, lam, outmul,
                                p.subln + layer * 64, smem, wv);
        } else if (u < 1024) {
            const int w = u - 512, qb = w & 15, hh = (w >> 4) & 3, b = w >> 6;
            const size_t rq = (size_t)(b * 4 + hh) * SEQ;
            attn_unit<96, false>(QB + rq * 96, KB + rq * 96, VB + rq * 64, qb * 256, MIX + (size_t)b * SEQ * XLD + 512 + hh * 64, 0.f, 0.f, 0.f, nullptr, smem, wv);
        } else {
            const int w = u - 1024, qb = w & 15, hh = (w >> 4) & 7, b = w >> 7;
            const size_t rq = (size_t)(b * 8 + hh) * SEQ, rk = (size_t)(b * 2 + (hh >> 2)) * SEQ;
            attn_unit<64, false>(QA + rq * 64, KA + rk * 64, VA + rk * 64, qb * 256, MIX + (size_t)b * SEQ * XLD + hh * 64, 0.f, 0.f, 0.f, nullptr, smem, wv);
        }
    }
}

__global__ void __launch_bounds__(NTHR, 2) mega(Params p) {
    extern __shared__ __attribute__((aligned(16))) unsigned char smem[];
    cg::grid_group grid = cg::this_grid();
    unsigned char* ws = p.ws;
    const int gtid = blockIdx.x * NTHR + threadIdx.x, gthreads = gridDim.x * NTHR;
    const int wv = __builtin_amdgcn_readfirstlane((int)(threadIdx.x >> 6));
    bf16_t* XB = (bf16_t*)(ws + OFF_XB);
    float* SSX = (float*)(ws + OFF_SSX);
    float* tab = (float*)(ws + OFF_TAB);

    for (int l = 0; l < 2; ++l) {
        prep_weight<false>(p.w_in + (size_t)l * 1024 * INW, p.norm_attn + l * 1024, (bf16_t*)(ws + OFF_WIN) + (size_t)l * INWP * XLD, XLD, 1024, INW, INWP, gtid, gthreads);
        prep_weight<false>(p.w_uq + (size_t)l * 192 * 384, p.qan_b + l * 192, (bf16_t*)(ws + OFF_WUQ) + (size_t)l * 512 * 192, 192, 192, 384, 512, gtid, gthreads);
        prep_weight<false>(p.w_ukv + (size_t)l * 128 * 512, p.kvn_b + l * 128, (bf16_t*)(ws + OFF_WUKV) + (size_t)l * 512 * 128, 128, 128, 512, 512, gtid, gthreads);
        prep_weight<false>(p.w_out + (size_t)l * 1024 * 1024, nullptr, (bf16_t*)(ws + OFF_WOUT) + (size_t)l * 1024 * XLD, XLD, 1024, 1024, 1024, gtid, gthreads);
        prep_weight<true>(p.w_up + (size_t)l * 1024 * DFF2, p.norm_ffn + l * 1024, (bf16_t*)(ws + OFF_WUP) + (size_t)l * DFF2 * XLD, XLD, 1024, DFF2, DFF2, gtid, gthreads);
        prep_weight<false>(p.w_down + (size_t)l * DFF * 1024, nullptr, (bf16_t*)(ws + OFF_WDN) + (size_t)l * 1024 * ALD, ALD, DFF, 1024, 1024, gtid, gthreads);
    }
    for (int idx = gtid; idx < 1024 + 512; idx += gthreads) {
        if (idx < 1024) { const int pos = idx >> 4, f = idx & 15; const float ang = (float)pos * powf(10000.0f, -(float)f / 16.0f); tab[idx] = cosf(ang); tab[1024 + idx] = sinf(ang); }
        else { const int k = idx - 1024, pos = k >> 3, f = k & 7; const float ang = (float)pos * powf(10000.0f, -(float)f / 8.0f); tab[2048 + k] = cosf(ang); tab[2560 + k] = sinf(ang); }
    }
    convert_x(p.x, XB, SSX, wv);
    grid.sync();

    for (int l = 0; l < 2; ++l) {
        const float lam_init = __int_as_float(__builtin_amdgcn_readfirstlane(__float_as_int((l == 0) ? 0.2f : 0.35550906759096984f)));
        const float* xin = (l == 0) ? p.x : p.out;
        gemm_phase(XB, XLD, (const bf16_t*)(ws + OFF_WIN) + (size_t)l * INWP * XLD, XLD, 1024, M_TOK, INWP, smem,
                   EpiInProj{SSX, tab, p.qn_a + l * 64, p.kn_a + l * 64, (bf16_t*)(ws + OFF_QA), (bf16_t*)(ws + OFF_KA), (bf16_t*)(ws + OFF_VA), (bf16_t*)(ws + OFF_CQ),
                             (bf16_t*)(ws + OFF_CKV), (bf16_t*)(ws + OFF_KB), (bf16_t*)(ws + OFF_QC), (bf16_t*)(ws + OFF_KC), (bf16_t*)(ws + OFF_VC),
                             (float*)(ws + OFF_SSCQ), (float*)(ws + OFF_SSCKV)}, wv);
        grid.sync();
        gemm_phase((const bf16_t*)(ws + OFF_CQ), 192, (const bf16_t*)(ws + OFF_WUQ) + (size_t)l * 512 * 192, 192, 192, M_TOK, 512, smem,
                   EpiMlaQ{(bf16_t*)(ws + OFF_QB), tab, (const float*)(ws + OFF_SSCQ), 0.10206207261596575f * LOG2E}, wv);
        gemm_phase((const bf16_t*)(ws + OFF_CKV), 128, (const bf16_t*)(ws + OFF_WUKV) + (size_t)l * 512 * 128, 128, 128, M_TOK, 512, smem,
                   EpiMlaKV{(bf16_t*)(ws + OFF_KB), (bf16_t*)(ws + OFF_VB), (const float*)(ws + OFF_SSCKV)}, wv);
        grid.sync();
        attn_phase(p, l, lam_init, __int_as_float(__builtin_amdgcn_readfirstlane(__float_as_int((l == 0) ? 0.8f : 0.64449093240903016f))), smem, wv);
        grid.sync();
        gemm_phase((const bf16_t*)(ws + OFF_MIX), XLD, (const bf16_t*)(ws + OFF_WOUT) + (size_t)l * 1024 * XLD, XLD, 1024, M_TOK, 1024, smem, EpiResid2{xin, p.out, XB, SSX}, wv);
        grid.sync();
        up_conv_phase(XB, (const bf16_t*)(ws + OFF_WUP) + (size_t)l * DFF2 * XLD, SSX, p.conv_w + (size_t)l * 3 * DFF2, p.conv_b + (size_t)l * DFF2, (bf16_t*)(ws + OFF_ACT), smem, wv);
        grid.sync();
        gemm_phase((const bf16_t*)(ws + OFF_ACT), ALD, (const bf16_t*)(ws + OFF_WDN) + (size_t)l * 1024 * ALD, ALD, DFF, M_TOK, 1024, smem, EpiResid2{p.out, p.out, XB, SSX}, wv);
        grid.sync();
    }
    final_norm(p.out, p.final_norm, SSX, wv);
}

extern "C" void kernel_launch(void* const* d_in, const int* in_sizes, int n_in, void* d_out, int out_size, void* d_ws, size_t ws_size, hipStream_t stream) {
    static int grid_blocks = 0;
    if (!grid_blocks) {
        int dev = 0, cus = 0, per_cu = 0;
        hipGetDevice(&dev);
        hipDeviceGetAttribute(&cus, hipDeviceAttributeMultiprocessorCount, dev);
        hipFuncSetAttribute((const void*)mega, hipFuncAttributeMaxDynamicSharedMemorySize, SMEM_TOTAL);
        hipOccupancyMaxActiveBlocksPerMultiprocessor(&per_cu, mega, NTHR, SMEM_TOTAL);
        if (per_cu > 1) per_cu = 1;
        if (per_cu < 1) per_cu = 1;
        grid_blocks = (cus * per_cu) & ~7;
    }
    Params p{};
    const float** pp = (const float**)&p;
    for (int i = 0; i < 21; ++i) pp[i] = (const float*)d_in[i];
    p.out = (float*)d_out;
    p.ws = (unsigned char*)d_ws;
    void* args[] = {&p};
    hipError_t e = hipLaunchCooperativeKernel((void*)mega, dim3(grid_blocks), dim3(NTHR), args, SMEM_TOTAL, stream);
    if (e != hipSuccess) fprintf(stderr, "cooperative launch failed: %s (grid %d)\n", hipGetErrorString(e), grid_blocks);
}
```

```cpp
#include <hip/hip_runtime.h>
#include <hip/hip_cooperative_groups.h>
#include <stdint.h>
#include <math.h>
#include <stdio.h>
namespace cg = cooperative_groups;

typedef unsigned short bf16_t;
typedef short bf16x8 __attribute__((ext_vector_type(8)));
typedef short s16x4 __attribute__((ext_vector_type(4)));
typedef float f32x4 __attribute__((ext_vector_type(4)));
typedef float f32x16 __attribute__((ext_vector_type(16)));
typedef unsigned u32x4 __attribute__((ext_vector_type(4)));
typedef unsigned u32x2 __attribute__((ext_vector_type(2)));
typedef __bf16 bf2_t __attribute__((ext_vector_type(2)));
typedef float f32x2 __attribute__((ext_vector_type(2)));
#define DI __device__ __forceinline__

constexpr int M_TOK = 32768, SEQ = 4096, DM = 1024, INW = 1888, INWP = 2048, DFF = 2816, DFF2 = 5632;
constexpr float EPS = 1e-6f;
constexpr float LOG2E = 1.4426950408889634f;
constexpr int NTHR = 512, NWAVE = NTHR / 64;
constexpr int XLD = 1024 + 64, ALD = DFF + 64;

constexpr size_t SZ_WIN = (size_t)2 * INWP * XLD * 2, SZ_WUQ = (size_t)2 * 512 * 192 * 2, SZ_WUKV = (size_t)2 * 512 * 128 * 2,
                 SZ_WOUT = (size_t)2 * 1024 * XLD * 2, SZ_WUP = (size_t)2 * DFF2 * XLD * 2, SZ_WDN = (size_t)2 * 1024 * ALD * 2;
constexpr size_t OFF_WIN = 0, OFF_WUQ = OFF_WIN + SZ_WIN, OFF_WUKV = OFF_WUQ + SZ_WUQ, OFF_WOUT = OFF_WUKV + SZ_WUKV,
                 OFF_WUP = OFF_WOUT + SZ_WOUT, OFF_WDN = OFF_WUP + SZ_WUP, OFF_TAB = OFF_WDN + SZ_WDN, OFF_XB = OFF_TAB + 16384;
constexpr size_t OFF_SSX = OFF_XB + (size_t)M_TOK * XLD * 2, OFF_SSCQ = OFF_SSX + (size_t)M_TOK * 16 * 4, OFF_SSCKV = OFF_SSCQ + (size_t)M_TOK * 4 * 4,
                 OFF_BIG = OFF_SSCKV + (size_t)M_TOK * 2 * 4;
constexpr size_t OFF_QA = OFF_BIG, OFF_KA = OFF_QA + (size_t)M_TOK * 512 * 2,
                 OFF_VA = OFF_KA + (size_t)M_TOK * 128 * 2, OFF_CQ = OFF_VA + (size_t)M_TOK * 128 * 2, OFF_CKV = OFF_CQ + (size_t)M_TOK * 192 * 2,
                 OFF_QB = OFF_CKV + (size_t)M_TOK * 128 * 2, OFF_KB = OFF_QB + (size_t)M_TOK * 384 * 2, OFF_VB = OFF_KB + (size_t)M_TOK * 384 * 2,
                 OFF_QC = OFF_VB + (size_t)M_TOK * 256 * 2, OFF_KC = OFF_QC + (size_t)M_TOK * 256 * 2, OFF_VC = OFF_KC + (size_t)M_TOK * 256 * 2,
                 OFF_MIX = OFF_VC + (size_t)M_TOK * 256 * 2, OFF_END1 = OFF_MIX + (size_t)M_TOK * XLD * 2;
constexpr size_t OFF_ACT = OFF_BIG, OFF_END2 = OFF_ACT + (size_t)M_TOK * ALD * 2;
static_assert(OFF_END1 <= (size_t)512 * 1024 * 1024 && OFF_END2 <= (size_t)512 * 1024 * 1024, "workspace");

struct Params {
    const float *x, *norm_attn, *w_in, *qn_a, *kn_a, *qan_b, *w_uq, *kvn_b, *w_ukv, *lq1, *lk1, *lq2, *lk2, *subln, *w_out, *norm_ffn, *w_up,
        *conv_w, *conv_b, *w_down, *final_norm;
    float* out;
    unsigned char* ws;
};

DI unsigned pk2(float a, float b) { f32x2 v = {a, b}; bf2_t r = __builtin_convertvector(v, bf2_t); return __builtin_bit_cast(unsigned, r); }
DI void unpack8(u32x4 r, float* v) {
    v[0] = __uint_as_float(r.x << 16); v[1] = __uint_as_float(r.x & 0xffff0000u);
    v[2] = __uint_as_float(r.y << 16); v[3] = __uint_as_float(r.y & 0xffff0000u);
    v[4] = __uint_as_float(r.z << 16); v[5] = __uint_as_float(r.z & 0xffff0000u);
    v[6] = __uint_as_float(r.w << 16); v[7] = __uint_as_float(r.w & 0xffff0000u);
}
DI u32x4 pack8(const float* v) { u32x4 r; r.x = pk2(v[0], v[1]); r.y = pk2(v[2], v[3]); r.z = pk2(v[4], v[5]); r.w = pk2(v[6], v[7]); return r; }
DI int tid_opaque(int wv) { int t; asm volatile("v_mbcnt_lo_u32_b32 %0, -1, 0\n\tv_mbcnt_hi_u32_b32 %0, -1, %0" : "=v"(t)); return t | (wv << 6); }
DI int bid_opaque() { int b = blockIdx.x; asm volatile("" : "+s"(b)); return b; }
DI float shflx(float v, int mask, int lane) { return __int_as_float(__builtin_amdgcn_ds_bpermute((lane ^ mask) << 2, __float_as_int(v))); }
DI float wave_sum(float v, int lane) {
#pragma unroll
    for (int o = 32; o >= 1; o >>= 1) v += shflx(v, o, lane);
    return v;
}

template <bool UPPERM>
DI void prep_weight(const float* __restrict__ W, const float* __restrict__ gain, bf16_t* __restrict__ Wt, int ldw, int K, int N, int Npad, int gtid, int gthreads) {
    const int total = Npad * (K / 8);
    for (int idx = gtid; idx < total; idx += gthreads) {
        const int n = idx % Npad, kc = idx / Npad;
        int ns = n;
        if (UPPERM) { const int j = n >> 8, r = n & 255; ns = (r < 128) ? (128 * j + r) : (DFF + 128 * j + r - 128); }
        float v[8];
#pragma unroll
        for (int j = 0; j < 8; ++j) { const int k = kc * 8 + j; v[j] = (n < N) ? W[(size_t)k * N + ns] * (gain ? gain[k] : 1.0f) : 0.f; }
        *(u32x4*)(Wt + (size_t)n * ldw + kc * 8) = pack8(v);
    }
}

DI void convert_x(const float* X, bf16_t* XB, float* SSX, int wv) {
    const int tid_ = tid_opaque(wv);
    const int lane = tid_ & 63, gw = bid_opaque() * NWAVE + (tid_ >> 6), nw = gridDim.x * NWAVE;
    for (int row = gw; row < M_TOK; row += nw) {
        const f32x4* xr = (const f32x4*)(X + (size_t)row * 1024);
        float ss = 0.f;
#pragma unroll
        for (int i = 0; i < 4; ++i) {
            const f32x4 v = xr[lane + 64 * i];
            ss += v[0] * v[0] + v[1] * v[1] + v[2] * v[2] + v[3] * v[3];
            u32x2 w; w.x = pk2(v[0], v[1]); w.y = pk2(v[2], v[3]);
            *(u32x2*)(XB + (size_t)row * XLD + (lane + 64 * i) * 4) = w;
        }
        ss = wave_sum(ss, lane);
        if (lane < 16) SSX[(size_t)row * 16 + lane] = (lane == 0) ? ss : 0.f;
    }
}
DI void final_norm(const bf16_t* XB, float* Out, const float* __restrict__ g, const float* SSX, int wv) {
    const int tid_ = tid_opaque(wv);
    const int lane = tid_ & 63, gw = bid_opaque() * NWAVE + (tid_ >> 6), nw = gridDim.x * NWAVE;
    for (int row = gw; row < M_TOK; row += nw) {
        float ss = (lane < 16) ? SSX[(size_t)row * 16 + lane] : 0.f;
        ss = wave_sum(ss, lane);
        const float rstd = rsqrtf(ss * (1.0f / 1024.0f) + EPS);
        f32x4* orow = (f32x4*)(Out + (size_t)row * 1024);
#pragma unroll
        for (int i = 0; i < 4; ++i) {
            const u32x2 w = *(const u32x2*)(XB + (size_t)row * XLD + (lane + 64 * i) * 4);
            f32x4 r; r[0] = __uint_as_float(w.x << 16); r[1] = __uint_as_float(w.x & 0xffff0000u); r[2] = __uint_as_float(w.y << 16); r[3] = __uint_as_float(w.y & 0xffff0000u);
            const f32x4 gv = ((const f32x4*)g)[lane + 64 * i];
            orow[lane + 64 * i] = r * rstd * gv;
        }
    }
}
DI float row_rstd(const float* ssx, int m) {
    const f32x4* pp = (const f32x4*)(ssx + (size_t)m * 16);
    const f32x4 a = (pp[0] + pp[1]) + (pp[2] + pp[3]);
    return rsqrtf(((a[0] + a[1]) + (a[2] + a[3])) * (1.0f / 1024.0f) + EPS);
}

constexpr int GSTR = 128, GOP = 256 * GSTR;
constexpr int SMEM_BYTES = 4 * GOP;
constexpr int SMEM_CONV = 256 * 132 * 4;
constexpr int SMEM_TOTAL = SMEM_CONV > SMEM_BYTES ? SMEM_CONV : SMEM_BYTES;

DI void gemm_mainloop(const bf16_t* __restrict__ Ab, const unsigned (&aoff)[4], const bool (&av)[4], const bf16_t* __restrict__ Bb, unsigned boff, int ldb, int nk, unsigned char* smem, f32x4 (&acc)[8][4], int tid) {
    const int lane = tid & 63, wid = tid >> 6, wr = wid >> 2, wc = wid & 3;
    const int lrow = tid >> 3, lc = tid & 7;
    u32x4 ra[4], rb[4];
#pragma unroll
    for (int i = 0; i < 8; ++i)
#pragma unroll
        for (int j = 0; j < 4; ++j) acc[i][j] = (f32x4){0.f, 0.f, 0.f, 0.f};
    const u32x4 zero4 = {0u, 0u, 0u, 0u};
#define G_LOAD(KT) { _Pragma("unroll") for (int i = 0; i < 4; ++i) { const u32x4 t_ = *(const u32x4*)((const unsigned char*)Ab + (size_t)(aoff[i] + (unsigned)((KT) * 128))); ra[i] = av[i] ? t_ : zero4; rb[i] = *(const u32x4*)((const unsigned char*)Bb + (size_t)(boff + (unsigned)(i * 128 * ldb) + (unsigned)((KT) * 128))); } }
#define G_WRITE(BUF) { int so_ = (BUF) * 2 * GOP + wboff; asm volatile("" : "+v"(so_)); unsigned char* wb_ = smem + so_; _Pragma("unroll") for (int i = 0; i < 4; ++i) { *(u32x4*)(wb_ + i * 64 * GSTR) = ra[i]; *(u32x4*)(wb_ + GOP + i * 64 * GSTR) = rb[i]; } }
    const int wboff = lrow * GSTR + ((lc ^ (lrow & 7)) << 4);
    const int foff = (lane & 15) * GSTR;
    const int fsw[2] = {(((lane >> 4)) ^ (lane & 7)) << 4, (((lane >> 4) + 4) ^ (lane & 7)) << 4};
    G_LOAD(0);
    G_WRITE(0);
    __syncthreads();
    for (int kt = 0; kt < nk; ++kt) {
        { const int kl = (kt + 1 < nk) ? kt + 1 : nk - 1; G_LOAD(kl); }
        const unsigned char* sa = smem + (kt & 1) * 2 * GOP + wr * 128 * GSTR + foff;
        const unsigned char* sb = smem + (kt & 1) * 2 * GOP + GOP + wc * 64 * GSTR + foff;
        int so_ = ((kt + 1) & 1) * 2 * GOP + wboff; asm volatile("" : "+v"(so_));
        unsigned char* wb_ = smem + so_;
#pragma unroll
        for (int kk = 0; kk < 2; ++kk) {
            bf16x8 af[8], bfr[4];
#pragma unroll
            for (int i = 0; i < 4; ++i) bfr[i] = *(const bf16x8*)(sb + i * 16 * GSTR + fsw[kk]);
#pragma unroll
            for (int i = 0; i < 8; ++i) af[i] = *(const bf16x8*)(sa + i * 16 * GSTR + fsw[kk]);
#pragma unroll
            for (int mi = 0; mi < 8; ++mi) {
#pragma unroll
                for (int ni = 0; ni < 4; ++ni) acc[mi][ni] = __builtin_amdgcn_mfma_f32_16x16x32_bf16(bfr[ni], af[mi], acc[mi][ni], 0, 0, 0);
                if (kk == 1) { if (mi < 4) *(u32x4*)(wb_ + mi * 64 * GSTR) = ra[mi]; else *(u32x4*)(wb_ + GOP + (mi - 4) * 64 * GSTR) = rb[mi - 4]; }
            }
        }
        __builtin_amdgcn_sched_group_barrier(0x008, 32, 0);
#pragma unroll
        for (int g = 0; g < 8; ++g) { __builtin_amdgcn_sched_group_barrier(0x008, 4, 0); __builtin_amdgcn_sched_group_barrier(0x200, 1, 0); }
        __syncthreads();
    }
#undef G_LOAD
#undef G_WRITE
}

template <class Epi>
DI void gemm_tile(const bf16_t* __restrict__ A, int lda, const bf16_t* __restrict__ Bt, int ldb, int K, int m0, int n0, unsigned char* smem, const Epi& epi, int wv) {
    const int tid = tid_opaque(wv), lane = tid & 63, wid = tid >> 6, wr = wid >> 2, wc = wid & 3;
    const int lrow = tid >> 3, lc = tid & 7;
    unsigned aoff[4];
    const bool av[4] = {true, true, true, true};
#pragma unroll
    for (int i = 0; i < 4; ++i) aoff[i] = (unsigned)((lrow + 64 * i) * lda + lc * 8) * 2u;
    const unsigned boff = (unsigned)(lrow * ldb + lc * 8) * 2u;
    f32x4 acc[8][4];
    gemm_mainloop(A + (size_t)m0 * lda, aoff, av, Bt + (size_t)n0 * ldb, boff, ldb, K / 64, smem, acc, tid);
    epi(acc, m0 + wr * 128, n0 + wc * 64, lane);
}

template <class Epi>
DI void gemm_phase(const bf16_t* A, int lda, const bf16_t* Bt, int ldb, int K, int Mrows, int Ncols, unsigned char* smem, const Epi& epi, int wv) {
    const int nN = Ncols / 256, nM = Mrows / 256;
    const int bid = bid_opaque(), G = gridDim.x;
    const int xcd = bid & 7, lb = bid >> 3, nlb = G >> 3, mper = nM >> 3, nloc = mper * nN;
    for (int j = lb; j < nloc; j += nlb) {
        const int g = j / (4 * nN), rem = j - g * 4 * nN;
        const int mt = xcd * mper + g * 4 + (rem & 3), nt = rem >> 2;
        gemm_tile(A, lda, Bt, ldb, K, mt * 256, nt * 256, smem, epi, wv);
    }
}

DI float dot4(f32x4 a) { return (a[0] * a[0] + a[1] * a[1]) + (a[2] * a[2] + a[3] * a[3]); }
DI void st4bf(bf16_t* dst, f32x4 v) { u32x2 w; w.x = pk2(v[0], v[1]); w.y = pk2(v[2], v[3]); *(u32x2*)dst = w; }

template <bool XIN_F32>
struct EpiResid2 {
    const float* Xin; bf16_t* XB; float* SSX;
    DI void operator()(const f32x4 (&acc)[8][4], int mb, int nb, int lane) const {
        const int q = lane >> 4;
#pragma unroll
        for (int mi = 0; mi < 8; ++mi) {
            const int m = mb + mi * 16 + (lane & 15);
            float ss = 0.f;
#pragma unroll
            for (int ni = 0; ni < 4; ++ni) {
                const int col = nb + ni * 16 + q * 4;
                bf16_t* xb = XB + (size_t)m * XLD + col;
                f32x4 r;
                if (XIN_F32) r = *(const f32x4*)(Xin + (size_t)m * 1024 + col);
                else { const u32x2 w = *(const u32x2*)xb; r[0] = __uint_as_float(w.x << 16); r[1] = __uint_as_float(w.x & 0xffff0000u); r[2] = __uint_as_float(w.y << 16); r[3] = __uint_as_float(w.y & 0xffff0000u); }
                r += acc[mi][ni];
                st4bf(xb, r);
                ss += dot4(r);
            }
            ss += shflx(ss, 16, lane); ss += shflx(ss, 32, lane);
            if (q == 0) SSX[(size_t)m * 16 + (nb >> 6)] = ss;
        }
    }
};

struct EpiInProj {
    const float *ssx, *tab, *gq, *gk;
    bf16_t *QA, *KA, *VA, *CQ, *CKV, *KB, *QC, *KC, *VC;
    float *sscq, *ssckv;
    DI void operator()(const f32x4 (&acc)[8][4], int mb, int nb, int lane) const {
        const int q = lane >> 4, ml = lane & 15;
        const float qsA = 0.125f * LOG2E, qsC = 0.17677669529663687f * LOG2E;
        if (nb < 640) {
            const bool isq = nb < 512;
            const int head = isq ? (nb >> 6) : ((nb - 512) >> 6);
            const float* g = isq ? gq : gk;
            f32x4 gv[4];
#pragma unroll
            for (int ni = 0; ni < 4; ++ni) gv[ni] = *(const f32x4*)(g + ni * 16 + q * 4);
#pragma unroll
            for (int mi = 0; mi < 8; ++mi) {
                const int m = mb + mi * 16 + ml, b = m >> 12, s = m & 4095;
                const float rs = row_rstd(ssx, m);
                f32x4 v[4];
                float ss = 0.f;
#pragma unroll
                for (int ni = 0; ni < 4; ++ni) { v[ni] = acc[mi][ni] * rs; ss += dot4(v[ni]); }
                ss += shflx(ss, 16, lane); ss += shflx(ss, 32, lane);
                const float r2 = rsqrtf(ss * (1.0f / 64.0f) + EPS);
#pragma unroll
                for (int ni = 0; ni < 4; ++ni) v[ni] = v[ni] * r2 * gv[ni];
                const float* tr = tab + (s >> 6) * 16 + q * 4;
                const float* tq = tab + (s & 63) * 16 + q * 4;
                const f32x4 c0 = *(const f32x4*)tr, s0 = *(const f32x4*)(tr + 1024), c1 = *(const f32x4*)tq, s1 = *(const f32x4*)(tq + 1024);
                f32x4 o0 = v[0] * c0 - v[1] * s0, o1 = v[1] * c0 + v[0] * s0, o2 = v[2] * c1 - v[3] * s1, o3 = v[3] * c1 + v[2] * s1;
                bf16_t* dst;
                if (isq) { o0 *= qsA; o1 *= qsA; o2 *= qsA; o3 *= qsA; dst = QA + ((size_t)(b * 8 + head) * SEQ + s) * 64 + q * 4; }
                else dst = KA + ((size_t)(b * 2 + head) * SEQ + s) * 64 + q * 4;
                st4bf(dst, o0); st4bf(dst + 16, o1); st4bf(dst + 32, o2); st4bf(dst + 48, o3);
            }
        } else if (nb < 768) {
            const int head = (nb - 640) >> 6;
#pragma unroll
            for (int mi = 0; mi < 8; ++mi) {
                const int m = mb + mi * 16 + ml, b = m >> 12, s = m & 4095;
                const float rs = row_rstd(ssx, m);
                bf16_t* dst = VA + ((size_t)(b * 2 + head) * SEQ + s) * 64 + q * 4;
#pragma unroll
                for (int ni = 0; ni < 4; ++ni) st4bf(dst + ni * 16, acc[mi][ni] * rs);
            }
        } else {
            const bool sq = nb < 1088;
#pragma unroll
            for (int mi = 0; mi < 8; ++mi) {
                const int m = mb + mi * 16 + ml, b = m >> 12, s = m & 4095;
                const float rs = row_rstd(ssx, m);
                float ss = 0.f;
#pragma unroll
                for (int ni = 0; ni < 4; ++ni) {
                    const int n16 = nb + ni * 16;
                    f32x4 v = acc[mi][ni] * rs;
                    if (n16 < 960) { st4bf(CQ + (size_t)m * 192 + (n16 - 768) + q * 4, v); ss += dot4(v); }
                    else if (n16 < 1088) { st4bf(CKV + (size_t)m * 128 + (n16 - 960) + q * 4, v); ss += dot4(v); }
                    else if (n16 < 1120) {
                        f32x4 pr;
#pragma unroll
                        for (int i = 0; i < 4; ++i) pr[i] = shflx(v[i], 32, lane);
                        const int pos = (n16 >= 1104) ? (s & 63) : (s >> 6);
                        const float* tc = tab + 2048 + pos * 8 + (q & 1) * 4;
                        const f32x4 c = *(const f32x4*)tc, sn = *(const f32x4*)(tc + 512);
                        const f32x4 o = (q < 2) ? (v * c - pr * sn) : (v * c + pr * sn);
#pragma unroll
                        for (int hh = 0; hh < 4; ++hh) st4bf(KB + ((size_t)(b * 4 + hh) * SEQ + s) * 96 + 64 + (n16 - 1088) + q * 4, o);
                    } else if (n16 < 1376) { const int c = n16 - 1120 + q * 4; st4bf(QC + ((size_t)(b * 4 + (c >> 6)) * SEQ + s) * 64 + (c & 63), v * qsC); }
                    else if (n16 < 1632) { const int c = n16 - 1376 + q * 4; st4bf(KC + ((size_t)(b * 4 + (c >> 6)) * SEQ + s) * 64 + (c & 63), v); }
                    else if (n16 < 1888) { const int c = n16 - 1632 + q * 4; st4bf(VC + ((size_t)(b * 4 + (c >> 6)) * SEQ + s) * 64 + (c & 63), v); }
                }
                if (sq) {
                    ss += shflx(ss, 16, lane); ss += shflx(ss, 32, lane);
                    if (q == 0) { if (nb < 960) sscq[(size_t)m * 4 + ((nb - 768) >> 6)] = ss; else ssckv[(size_t)m * 2 + ((nb - 960) >> 6)] = ss; }
                }
            }
        }
    }
};
struct EpiMlaQ {
    bf16_t* QB; const float* tab; const float* sscq; float qscale;
    DI void operator()(const f32x4 (&acc)[8][4], int mb, int nb, int lane) const {
#pragma unroll
        for (int mi = 0; mi < 8; ++mi) {
            const int m = mb + mi * 16 + (lane & 15), q = lane >> 4, b = m >> 12, s = m & 4095;
            const f32x4 sp = *(const f32x4*)(sscq + (size_t)m * 4);
            const float rs = rsqrtf((sp[0] + sp[1] + sp[2]) * (1.0f / 192.0f) + EPS) * qscale;
#pragma unroll
            for (int ni = 0; ni < 4; ++ni) {
                const int nt = nb + ni * 16;
                if (nt >= 384) continue;
                const int head = nt / 96, dt = nt - head * 96;
                f32x4 v = acc[mi][ni] * rs;
                f32x4 pr;
#pragma unroll
                for (int i = 0; i < 4; ++i) pr[i] = shflx(v[i], 32, lane);
                if (dt >= 64) {
                    const int pos = (dt >= 80) ? (s & 63) : (s >> 6);
                    const float* tc = tab + 2048 + pos * 8 + (q & 1) * 4;
                    const f32x4 c = *(const f32x4*)tc, sn = *(const f32x4*)(tc + 512);
                    v = (q < 2) ? (v * c - pr * sn) : (v * c + pr * sn);
                }
                st4bf(QB + ((size_t)(b * 4 + head) * SEQ + s) * 96 + dt + q * 4, v);
            }
        }
    }
};
struct EpiMlaKV {
    bf16_t* KB; bf16_t* VB; const float* ssckv;
    DI void operator()(const f32x4 (&acc)[8][4], int mb, int nb, int lane) const {
#pragma unroll
        for (int mi = 0; mi < 8; ++mi) {
            const int m = mb + mi * 16 + (lane & 15), b = m >> 12, s = m & 4095;
            const f32x2 sp = *(const f32x2*)(ssckv + (size_t)m * 2);
            const float rs = rsqrtf((sp[0] + sp[1]) * (1.0f / 128.0f) + EPS);
#pragma unroll
            for (int ni = 0; ni < 4; ++ni) {
                const int n = nb + ni * 16 + (lane >> 4) * 4;
                const int head = n >> 7, d = n & 127;
                const size_t rowi = (size_t)(b * 4 + head) * SEQ + s;
                if (d < 64) st4bf(KB + rowi * 96 + d, acc[mi][ni] * rs);
                else st4bf(VB + rowi * 64 + (d - 64), acc[mi][ni] * rs);
            }
        }
    }
};

DI void up_conv_tile(const bf16_t* __restrict__ XB, const bf16_t* __restrict__ Wt, const float* __restrict__ ssx, const float* __restrict__ cw, const float* __restrict__ cb,
                     bf16_t* __restrict__ ACT, int b, int jt, int nt, unsigned char* smem, int wv) {
    const int tid = tid_opaque(wv), lane = tid & 63, wid = tid >> 6, wr = wid >> 2, wc = wid & 3;
    const int lrow = tid >> 3, lc = tid & 7;
    const int tbase = jt * 254 - 1;
    unsigned aoff[4];
    bool av[4];
#pragma unroll
    for (int i = 0; i < 4; ++i) {
        const int tl = tbase + lrow + 64 * i;
        av[i] = (unsigned)tl < 4096u;
        const int tc = tl < 0 ? 0 : (tl > 4095 ? 4095 : tl);
        aoff[i] = (unsigned)(tc * XLD + lc * 8) * 2u;
    }
    const unsigned boff = (unsigned)(lrow * XLD + lc * 8) * 2u;
    f32x4 acc[8][4];
    gemm_mainloop(XB + (size_t)b * SEQ * XLD, aoff, av, Wt + (size_t)nt * 256 * XLD, boff, XLD, 16, smem, acc, tid);
    float* T = (float*)smem;
    const int q = lane >> 4, ml = lane & 15;
    float rs[8];
#pragma unroll
    for (int mi = 0; mi < 8; ++mi) {
        const int tl = tbase + wr * 128 + mi * 16 + ml;
        const int tc = tl < 0 ? 0 : (tl > 4095 ? 4095 : tl);
        rs[mi] = row_rstd(ssx, b * SEQ + tc);
    }
#pragma unroll
    for (int h = 0; h < 2; ++h) {
        if ((wc & 1) == h) {
#pragma unroll
            for (int mi = 0; mi < 8; ++mi)
#pragma unroll
                for (int ni = 0; ni < 4; ++ni) *(f32x4*)(T + (wr * 128 + mi * 16 + ml) * 132 + (wc >> 1) * 64 + ni * 16 + q * 4) = acc[mi][ni] * rs[mi];
        }
        __syncthreads();
        {
            const int cq = tid & 15, rg = tid >> 4, ch = nt * 128 + h * 64 + cq * 4;
            const f32x4 wg0 = *(const f32x4*)(cw + ch), wg1 = *(const f32x4*)(cw + DFF2 + ch), wg2 = *(const f32x4*)(cw + 2 * DFF2 + ch), bg = *(const f32x4*)(cb + ch);
            const f32x4 wv0 = *(const f32x4*)(cw + DFF + ch), wv1 = *(const f32x4*)(cw + DFF2 + DFF + ch), wv2 = *(const f32x4*)(cw + 2 * DFF2 + DFF + ch), bv = *(const f32x4*)(cb + DFF + ch);
            const int r0 = rg * 8, rm = r0 > 0 ? r0 - 1 : 0;
            f32x4 gm = *(const f32x4*)(T + rm * 132 + cq * 4), vm = *(const f32x4*)(T + rm * 132 + 64 + cq * 4);
            f32x4 g0 = *(const f32x4*)(T + r0 * 132 + cq * 4), v0 = *(const f32x4*)(T + r0 * 132 + 64 + cq * 4);
#pragma unroll
            for (int rr = 0; rr < 8; ++rr) {
                const int r = r0 + rr, rp = r < 255 ? r + 1 : 255;
                const f32x4 gp = *(const f32x4*)(T + rp * 132 + cq * 4), vp = *(const f32x4*)(T + rp * 132 + 64 + cq * 4);
                const f32x4 gg = wg0 * gm + wg1 * g0 + wg2 * gp + bg;
                const f32x4 vv = wv0 * vm + wv1 * v0 + wv2 * vp + bv;
                f32x4 o;
#pragma unroll
                for (int e = 0; e < 4; ++e) o[e] = gg[e] * __builtin_amdgcn_rcpf(1.0f + __builtin_amdgcn_exp2f(-LOG2E * gg[e])) * vv[e];
                const int tl = tbase + r;
                if (r >= 1 && r <= 254 && tl <= 4095) st4bf(ACT + ((size_t)b * SEQ + tl) * ALD + ch, o);
                gm = g0; g0 = gp; vm = v0; v0 = vp;
            }
        }
        __syncthreads();
    }
}
DI void up_conv_phase(const bf16_t* XB, const bf16_t* Wt, const float* ssx, const float* cw, const float* cb, bf16_t* ACT, unsigned char* smem, int wv) {
    constexpr int NT = DFF / 128, MT = 17;
    const int bid = bid_opaque(), G = gridDim.x;
    const int xcd = bid & 7, lb = bid >> 3, nlb = G >> 3, nloc = MT * NT, full = (MT / 4) * 4 * NT, gs = MT - (MT / 4) * 4;
    for (int j = lb; j < nloc; j += nlb) {
        int jt, nt;
        if (j < full) { const int g = j / (4 * NT), rem = j - g * 4 * NT; jt = g * 4 + (rem & 3); nt = rem >> 2; }
        else { const int j2 = j - full; jt = (MT / 4) * 4 + j2 % gs; nt = j2 / gs; }
        up_conv_tile(XB, Wt, ssx, cw, cb, ACT, xcd, jt, nt, smem, wv);
    }
}

constexpr int ATT_STAGE = 64 * 208 + 8192;

template <int DQK, bool DIFF>
DI void attn_tile(const unsigned char* cur, int kt, f32x16 (&O)[DIFF ? 2 : 1][2], float (&mrun)[DIFF ? 2 : 1], float (&lsum)[DIFF ? 2 : 1], const bf16x8 (&qf)[DIFF ? 2 : 1][DIFF ? 2 : DQK / 16],
               int kfo, int vfo0, int vfo1, float qpos, float slope2, int h) {
    constexpr int NQT = DIFF ? 2 : 1, KS = DIFF ? 2 : DQK / 16, KSTR = DQK * 2 + 16;
        bf16x8 kfr[2][KS], vfr[2][2][2];
#pragma unroll
        for (int kh = 0; kh < 2; ++kh)
#pragma unroll
            for (int ks = 0; ks < KS; ++ks) kfr[kh][ks] = *(const bf16x8*)(cur + kfo + kh * 32 * KSTR + (ks * 16) * 2);
        if (!DIFF) {
#pragma unroll
            for (int kh = 0; kh < 2; ++kh)
#pragma unroll
                for (int s2 = 0; s2 < 2; ++s2)
#pragma unroll
                    for (int d = 0; d < 2; ++d) {
                        const unsigned char* va = cur + (d ? vfo1 : vfo0) + (kh * 32 + 16 * s2) * 128;
                        const s16x4 lo = __builtin_amdgcn_ds_read_tr16_b64_v4i16((__attribute__((address_space(3))) s16x4*)(va));
                        const s16x4 hi = __builtin_amdgcn_ds_read_tr16_b64_v4i16((__attribute__((address_space(3))) s16x4*)(va + 8 * 128));
                        vfr[kh][s2][d] = __builtin_shufflevector(lo, hi, 0, 1, 2, 3, 4, 5, 6, 7);
                    }
        }
        __builtin_amdgcn_sched_barrier(0);
#pragma unroll
        for (int qt = 0; qt < NQT; ++qt) {
            bf16x8 pf[2][2];
            f32x16 S[2];
#pragma unroll
            for (int kh = 0; kh < 2; ++kh) {
#pragma unroll
                for (int i = 0; i < 16; ++i) S[kh][i] = 0.f;
#pragma unroll
                for (int ks = 0; ks < KS; ++ks) S[kh] = __builtin_amdgcn_mfma_f32_32x32x16_bf16(kfr[kh][ks], qf[qt][ks], S[kh], 0, 0, 0);
            }
            if (DIFF && qt == 0) {
#pragma unroll
                for (int kh = 0; kh < 2; ++kh)
#pragma unroll
                    for (int ks = 0; ks < KS; ++ks) kfr[kh][ks] = *(const bf16x8*)(cur + kfo + kh * 32 * KSTR + (32 + ks * 16) * 2);
            }
            if (DIFF) {
                const float d0 = qpos - (float)(kt * 64 + 4 * h);
#pragma unroll
                for (int kh = 0; kh < 2; ++kh)
#pragma unroll
                    for (int i = 0; i < 16; ++i) S[kh][i] -= slope2 * fabsf(d0 - (float)(kh * 32 + (i & 3) + 8 * (i >> 2)));
            }
            float mx = __builtin_elementwise_maximum(S[0][0], S[1][0]);
#pragma unroll
            for (int i = 1; i < 16; ++i) mx = __builtin_elementwise_maximum(mx, __builtin_elementwise_maximum(S[0][i], S[1][i]));
            { const auto sw = __builtin_amdgcn_permlane32_swap(__float_as_uint(mx), __float_as_uint(mx), false, false); mx = __builtin_elementwise_maximum(__uint_as_float(sw[0]), __uint_as_float(sw[1])); }
            const float rel = mx - mrun[qt];
            const bool need = (rel > 8.0f) || (kt == 0 && rel < -8.0f);
            if (__builtin_amdgcn_ballot_w64(need) != 0ull) {
                const float delta = need ? rel : 0.f;
                const float alpha = (kt == 0) ? 1.0f : __builtin_amdgcn_exp2f(-delta);
                mrun[qt] += delta;
                lsum[qt] *= alpha;
#pragma unroll
                for (int d = 0; d < 2; ++d)
#pragma unroll
                    for (int i = 0; i < 16; ++i) O[qt][d][i] *= alpha;
            }
            float ps = 0.f;
            if (__builtin_amdgcn_ballot_w64(mrun[qt] != 0.f) != 0ull) {
#pragma unroll
                for (int kh = 0; kh < 2; ++kh)
#pragma unroll
                    for (int i = 0; i < 16; ++i) { const float pv = __builtin_amdgcn_exp2f(S[kh][i] - mrun[qt]); S[kh][i] = pv; ps += pv; }
            } else {
#pragma unroll
                for (int kh = 0; kh < 2; ++kh)
#pragma unroll
                    for (int i = 0; i < 16; ++i) { const float pv = __builtin_amdgcn_exp2f(S[kh][i]); S[kh][i] = pv; ps += pv; }
            }
            lsum[qt] += ps;
#pragma unroll
            for (int kh = 0; kh < 2; ++kh)
#pragma unroll
                for (int s2 = 0; s2 < 2; ++s2) {
                    u32x4 w;
                    w.x = pk2(S[kh][8 * s2 + 0], S[kh][8 * s2 + 1]); w.y = pk2(S[kh][8 * s2 + 2], S[kh][8 * s2 + 3]);
                    w.z = pk2(S[kh][8 * s2 + 4], S[kh][8 * s2 + 5]); w.w = pk2(S[kh][8 * s2 + 6], S[kh][8 * s2 + 7]);
                    pf[kh][s2] = __builtin_bit_cast(bf16x8, w);
                }
#pragma unroll
            for (int kh = 0; kh < 2; ++kh)
#pragma unroll
                for (int s2 = 0; s2 < 2; ++s2)
#pragma unroll
                    for (int d = 0; d < 2; ++d) {
                        if (DIFF) {
                            const unsigned char* va = cur + (d ? vfo1 : vfo0) + (kh * 32 + 16 * s2) * 128;
                            const s16x4 lo = __builtin_amdgcn_ds_read_tr16_b64_v4i16((__attribute__((address_space(3))) s16x4*)(va));
                            const s16x4 hi = __builtin_amdgcn_ds_read_tr16_b64_v4i16((__attribute__((address_space(3))) s16x4*)(va + 8 * 128));
                            vfr[kh][s2][d] = __builtin_shufflevector(lo, hi, 0, 1, 2, 3, 4, 5, 6, 7);
                        }
                        O[qt][d] = __builtin_amdgcn_mfma_f32_32x32x16_bf16(vfr[kh][s2][d], pf[kh][s2], O[qt][d], 0, 0, 0);
                    }
            if (DIFF) __builtin_amdgcn_sched_barrier(0);
        }
}

template <int DQK, bool DIFF>
DI void attn_unit(const bf16_t* __restrict__ Qg, const bf16_t* __restrict__ Kg, const bf16_t* __restrict__ Vg, int q0, bf16_t* __restrict__ outp,
                  float slope2, float lam, float outmul, const float* __restrict__ subln, unsigned char* smem, int wv) {
    constexpr int NQT = DIFF ? 2 : 1, KS = DIFF ? 2 : DQK / 16, KSTR = DQK * 2 + 16, CPR = DQK / 8, KCH = (64 * CPR + NTHR - 1) / NTHR, KBYTES = 64 * 208;
    const int tid = tid_opaque(wv), lane = tid & 63, wid = tid >> 6, r = lane & 31, h = lane >> 5;
    const int qrow = q0 + wid * 32 + r;
    bf16x8 qf[NQT][KS];
#pragma unroll
    for (int qt = 0; qt < NQT; ++qt)
#pragma unroll
        for (int ks = 0; ks < KS; ++ks) qf[qt][ks] = *(const bf16x8*)(Qg + (size_t)qrow * DQK + qt * 32 + ks * 16 + h * 8);
    f32x16 O[NQT][2];
    float mrun[NQT], lsum[NQT];
#pragma unroll
    for (int qt = 0; qt < NQT; ++qt) {
        mrun[qt] = 0.f; lsum[qt] = 0.f;
#pragma unroll
        for (int d = 0; d < 2; ++d)
#pragma unroll
            for (int i = 0; i < 16; ++i) O[qt][d][i] = 0.f;
    }
    int koff[KCH], voff;
    bool kval[KCH];
#pragma unroll
    for (int i = 0; i < KCH; ++i) { const int id = tid + NTHR * i, key = id / CPR, c = id % CPR; koff[i] = key * KSTR + c * 16; kval[i] = id < 64 * CPR; }
    { const int key = tid >> 3, c = tid & 7; voff = KBYTES + key * 128 + ((c ^ (((key >> 1) & 1) << 2)) * 16); }
    u32x4 rk[KCH], rv;
#pragma unroll
    for (int i = 0; i < KCH; ++i) if (kval[i]) rk[i] = *(const u32x4*)(Kg + (size_t)(tid + NTHR * i) * 8);
    rv = *(const u32x4*)(Vg + (size_t)tid * 8);
#pragma unroll
    for (int i = 0; i < KCH; ++i) if (kval[i]) *(u32x4*)(smem + koff[i]) = rk[i];
    *(u32x4*)(smem + voff) = rv;
    __syncthreads();
    const int kfo = r * KSTR + h * 16;
    const int qq = (lane >> 2) & 3;
    const int colb0 = ((qq >> 1) & 1) * 64 + 32 * ((lane >> 4) & 1) + 8 * (lane & 3);
    const int vfo0 = KBYTES + (4 * h + qq) * 128 + colb0, vfo1 = KBYTES + (4 * h + qq) * 128 + (colb0 ^ 64);
    const float qpos = (float)qrow;

    u32x4 rk2[KCH], rv2;
#define AT_LOAD(RK, RV, T) { const int tn_ = (T) < SEQ / 64 ? (T) : SEQ / 64 - 1; _Pragma("unroll") for (int i = 0; i < KCH; ++i) RK[i] = *(const u32x4*)(Kg + (size_t)tn_ * 64 * DQK + (size_t)(kval[i] ? tid + NTHR * i : tid) * 8);     RV = *(const u32x4*)(Vg + (size_t)tn_ * 64 * 64 + (size_t)tid * 8); }
#define AT_WRITE(RK, RV, SO) { _Pragma("unroll") for (int i = 0; i < KCH; ++i) if (kval[i]) *(u32x4*)(smem + (SO) + koff[i]) = RK[i]; *(u32x4*)(smem + (SO) + voff) = RV; }
    AT_LOAD(rk2, rv2, 1);
    for (int kt = 0; kt < SEQ / 64; kt += 2) {
        AT_LOAD(rk, rv, kt + 2);
        attn_tile<DQK, DIFF>(smem, kt, O, mrun, lsum, qf, kfo, vfo0, vfo1, qpos, slope2, h);
        AT_WRITE(rk2, rv2, ATT_STAGE);
        __syncthreads();
        AT_LOAD(rk2, rv2, kt + 3);
        attn_tile<DQK, DIFF>(smem + ATT_STAGE, kt + 1, O, mrun, lsum, qf, kfo, vfo0, vfo1, qpos, slope2, h);
        AT_WRITE(rk, rv, 0);
        __syncthreads();
    }
#undef AT_LOAD
#undef AT_WRITE
    const int tid2 = tid_opaque(wv), lane2 = tid2 & 63;
    const int h2 = lane2 >> 5;
    float inv[NQT];
#pragma unroll
    for (int qt = 0; qt < NQT; ++qt) { const float lt = lsum[qt] + shflx(lsum[qt], 32, lane2); inv[qt] = 1.0f / lt; }
    float o[2][16];
    if (DIFF) {
        float ss = 0.f;
#pragma unroll
        for (int d = 0; d < 2; ++d)
#pragma unroll
            for (int i = 0; i < 16; ++i) { const float x = O[0][d][i] * inv[0] - lam * (O[NQT - 1][d][i] * inv[NQT - 1]); o[d][i] = x; ss += x * x; }
        ss += shflx(ss, 32, lane2);
        const float rstd = rsqrtf(ss * (1.0f / 64.0f) + EPS) * outmul;
#pragma unroll
        for (int d = 0; d < 2; ++d)
#pragma unroll
            for (int i = 0; i < 16; ++i) o[d][i] *= rstd * subln[d * 32 + (i & 3) + 8 * (i >> 2) + 4 * h2];
    } else {
#pragma unroll
        for (int d = 0; d < 2; ++d)
#pragma unroll
            for (int i = 0; i < 16; ++i) o[d][i] = O[0][d][i] * inv[0];
    }
    const int qrow2 = q0 + (lane2 & 31) + ((tid2 >> 6) << 5);
    bf16_t* orow = outp + (size_t)qrow2 * XLD;
#pragma unroll
    for (int d = 0; d < 2; ++d)
#pragma unroll
        for (int g = 0; g < 4; ++g) {
            u32x2 w; w.x = pk2(o[d][4 * g], o[d][4 * g + 1]); w.y = pk2(o[d][4 * g + 2], o[d][4 * g + 3]);
            *(u32x2*)(orow + d * 32 + 8 * g + 4 * h2) = w;
        }
}

DI void attn_phase(const Params& p, int layer, float lam_init, float outmul, unsigned char* smem, int wv) {
    unsigned char* ws = p.ws;
    const bf16_t *QA = (const bf16_t*)(ws + OFF_QA), *KA = (const bf16_t*)(ws + OFF_KA), *VA = (const bf16_t*)(ws + OFF_VA), *QB = (const bf16_t*)(ws + OFF_QB),
                 *KB = (const bf16_t*)(ws + OFF_KB), *VB = (const bf16_t*)(ws + OFF_VB), *QC = (const bf16_t*)(ws + OFF_QC), *KC = (const bf16_t*)(ws + OFF_KC),
                 *VC = (const bf16_t*)(ws + OFF_VC);
    bf16_t* MIX = (bf16_t*)(ws + OFF_MIX);
    float s1 = 0.f, s2 = 0.f;
    for (int j = 0; j < 32; ++j) { s1 += p.lq1[layer * 32 + j] * p.lk1[layer * 32 + j]; s2 += p.lq2[layer * 32 + j] * p.lk2[layer * 32 + j]; }
    const float lam = __int_as_float(__builtin_amdgcn_readfirstlane(__float_as_int(expf(s1) - expf(s2) + lam_init)));
    for (int v = bid_opaque(); v < 2048; v += gridDim.x) {
        const int base = v & ~255, i = v & 255, j = i >> 3;
        const int u = base + ((i & 7) * 2 + (j >> 4)) * 16 + (j & 15);
        if (u < 512) {
            const int qb = u & 15, hh = (u >> 4) & 3, b = u >> 6;
            const size_t ro = (size_t)(b * 4 + hh) * SEQ * 64;
            const float slope2 = __int_as_float(__builtin_amdgcn_readfirstlane(__float_as_int(exp2f(-2.0f * (float)(hh + 1)) * LOG2E)));
            attn_unit<64, true>(QC + ro, KC + ro, VC + ro, qb * 256, MIX + (size_t)b * SEQ * XLD + 768 + hh * 64, slope2, lam, outmul,
                                p.subln + layer * 64, smem, wv);
        } else if (u < 1024) {
            const int w = u - 512, qb = w & 15, hh = (w >> 4) & 3, b = w >> 6;
            const size_t rq = (size_t)(b * 4 + hh) * SEQ;
            attn_unit<96, false>(QB + rq * 96, KB + rq * 96, VB + rq * 64, qb * 256, MIX + (size_t)b * SEQ * XLD + 512 + hh * 64, 0.f, 0.f, 0.f, nullptr, smem, wv);
        } else {
            const int w = u - 1024, qb = w & 15, hh = (w >> 4) & 7, b = w >> 7;
            const size_t rq = (size_t)(b * 8 + hh) * SEQ, rk = (size_t)(b * 2 + (hh >> 2)) * SEQ;
            attn_unit<64, false>(QA + rq * 64, KA + rk * 64, VA + rk * 64, qb * 256, MIX + (size_t)b * SEQ * XLD + hh * 64, 0.f, 0.f, 0.f, nullptr, smem, wv);
        }
    }
}

__global__ void __launch_bounds__(NTHR, 2) mega(Params p) {
    extern __shared__ __attribute__((aligned(16))) unsigned char smem[];
    cg::grid_group grid = cg::this_grid();
    unsigned char* ws = p.ws;
    const int gtid = blockIdx.x * NTHR + threadIdx.x, gthreads = gridDim.x * NTHR;
    const int wv = __builtin_amdgcn_readfirstlane((int)(threadIdx.x >> 6));
    bf16_t* XB = (bf16_t*)(ws + OFF_XB);
    float* SSX = (float*)(ws + OFF_SSX);
    float* tab = (float*)(ws + OFF_TAB);

    for (int l = 0; l < 2; ++l) {
        prep_weight<false>(p.w_in + (size_t)l * 1024 * INW, p.norm_attn + l * 1024, (bf16_t*)(ws + OFF_WIN) + (size_t)l * INWP * XLD, XLD, 1024, INW, INWP, gtid, gthreads);
        prep_weight<false>(p.w_uq + (size_t)l * 192 * 384, p.qan_b + l * 192, (bf16_t*)(ws + OFF_WUQ) + (size_t)l * 512 * 192, 192, 192, 384, 512, gtid, gthreads);
        prep_weight<false>(p.w_ukv + (size_t)l * 128 * 512, p.kvn_b + l * 128, (bf16_t*)(ws + OFF_WUKV) + (size_t)l * 512 * 128, 128, 128, 512, 512, gtid, gthreads);
        prep_weight<false>(p.w_out + (size_t)l * 1024 * 1024, nullptr, (bf16_t*)(ws + OFF_WOUT) + (size_t)l * 1024 * XLD, XLD, 1024, 1024, 1024, gtid, gthreads);
        prep_weight<true>(p.w_up + (size_t)l * 1024 * DFF2, p.norm_ffn + l * 1024, (bf16_t*)(ws + OFF_WUP) + (size_t)l * DFF2 * XLD, XLD, 1024, DFF2, DFF2, gtid, gthreads);
        prep_weight<false>(p.w_down + (size_t)l * DFF * 1024, nullptr, (bf16_t*)(ws + OFF_WDN) + (size_t)l * 1024 * ALD, ALD, DFF, 1024, 1024, gtid, gthreads);
    }
    for (int idx = gtid; idx < 1024 + 512; idx += gthreads) {
        if (idx < 1024) { const int pos = idx >> 4, f = idx & 15; const float ang = (float)pos * powf(10000.0f, -(float)f / 16.0f); tab[idx] = cosf(ang); tab[1024 + idx] = sinf(ang); }
        else { const int k = idx - 1024, pos = k >> 3, f = k & 7; const float ang = (float)pos * powf(10000.0f, -(float)f / 8.0f); tab[2048 + k] = cosf(ang); tab[2560 + k] = sinf(ang); }
    }
    convert_x(p.x, XB, SSX, wv);
    grid.sync();

    for (int l = 0; l < 2; ++l) {
        const float lam_init = __int_as_float(__builtin_amdgcn_readfirstlane(__float_as_int((l == 0) ? 0.2f : 0.35550906759096984f)));
        gemm_phase(XB, XLD, (const bf16_t*)(ws + OFF_WIN) + (size_t)l * INWP * XLD, XLD, 1024, M_TOK, INWP, smem,
                   EpiInProj{SSX, tab, p.qn_a + l * 64, p.kn_a + l * 64, (bf16_t*)(ws + OFF_QA), (bf16_t*)(ws + OFF_KA), (bf16_t*)(ws + OFF_VA), (bf16_t*)(ws + OFF_CQ),
                             (bf16_t*)(ws + OFF_CKV), (bf16_t*)(ws + OFF_KB), (bf16_t*)(ws + OFF_QC), (bf16_t*)(ws + OFF_KC), (bf16_t*)(ws + OFF_VC),
                             (float*)(ws + OFF_SSCQ), (float*)(ws + OFF_SSCKV)}, wv);
        grid.sync();
        gemm_phase((const bf16_t*)(ws + OFF_CQ), 192, (const bf16_t*)(ws + OFF_WUQ) + (size_t)l * 512 * 192, 192, 192, M_TOK, 512, smem,
                   EpiMlaQ{(bf16_t*)(ws + OFF_QB), tab, (const float*)(ws + OFF_SSCQ), 0.10206207261596575f * LOG2E}, wv);
        gemm_phase((const bf16_t*)(ws + OFF_CKV), 128, (const bf16_t*)(ws + OFF_WUKV) + (size_t)l * 512 * 128, 128, 128, M_TOK, 512, smem,
                   EpiMlaKV{(bf16_t*)(ws + OFF_KB), (bf16_t*)(ws + OFF_VB), (const float*)(ws + OFF_SSCKV)}, wv);
        grid.sync();
        attn_phase(p, l, lam_init, __int_as_float(__builtin_amdgcn_readfirstlane(__float_as_int((l == 0) ? 0.8f : 0.64449093240903016f))), smem, wv);
        grid.sync();
        if (l == 0) gemm_phase((const bf16_t*)(ws + OFF_MIX), XLD, (const bf16_t*)(ws + OFF_WOUT) + (size_t)l * 1024 * XLD, XLD, 1024, M_TOK, 1024, smem, EpiResid2<true>{p.x, XB, SSX}, wv);
        else gemm_phase((const bf16_t*)(ws + OFF_MIX), XLD, (const bf16_t*)(ws + OFF_WOUT) + (size_t)l * 1024 * XLD, XLD, 1024, M_TOK, 1024, smem, EpiResid2<false>{nullptr, XB, SSX}, wv);
        grid.sync();
        up_conv_phase(XB, (const bf16_t*)(ws + OFF_WUP) + (size_t)l * DFF2 * XLD, SSX, p.conv_w + (size_t)l * 3 * DFF2, p.conv_b + (size_t)l * DFF2, (bf16_t*)(ws + OFF_ACT), smem, wv);
        grid.sync();
        gemm_phase((const bf16_t*)(ws + OFF_ACT), ALD, (const bf16_t*)(ws + OFF_WDN) + (size_t)l * 1024 * ALD, ALD, DFF, M_TOK, 1024, smem, EpiResid2<false>{nullptr, XB, SSX}, wv);
        grid.sync();
    }
    final_norm(XB, p.out, p.final_norm, SSX, wv);
}

extern "C" void kernel_launch(void* const* d_in, const int* in_sizes, int n_in, void* d_out, int out_size, void* d_ws, size_t ws_size, hipStream_t stream) {
    static int grid_blocks = 0;
    if (!grid_blocks) {
        int dev = 0, cus = 0, per_cu = 0;
        hipGetDevice(&dev);
        hipDeviceGetAttribute(&cus, hipDeviceAttributeMultiprocessorCount, dev);
        hipFuncSetAttribute((const void*)mega, hipFuncAttributeMaxDynamicSharedMemorySize, SMEM_TOTAL);
        hipOccupancyMaxActiveBlocksPerMultiprocessor(&per_cu, mega, NTHR, SMEM_TOTAL);
        if (per_cu > 1) per_cu = 1;
        if (per_cu < 1) per_cu = 1;
        grid_blocks = (cus * per_cu) & ~7;
    }
    Params p{};
    const float** pp = (const float**)&p;
    for (int i = 0; i < 21; ++i) pp[i] = (const float*)d_in[i];
    p.out = (float*)d_out;
    p.ws = (unsigned char*)d_ws;
    void* args[] = {&p};
    hipError_t e = hipLaunchCooperativeKernel((void*)mega, dim3(grid_blocks), dim3(NTHR), args, SMEM_TOTAL, stream);
    if (e != hipSuccess) fprintf(stderr, "cooperative launch failed: %s (grid %d)\n", hipGetErrorString(e), grid_blocks);
}
```

```cpp
#include <hip/hip_runtime.h>
#include <hip/hip_cooperative_groups.h>
#include <stdint.h>
#include <math.h>
#include <stdio.h>
namespace cg = cooperative_groups;

typedef unsigned short bf16_t;
typedef short bf16x8 __attribute__((ext_vector_type(8)));
typedef short s16x4 __attribute__((ext_vector_type(4)));
typedef float f32x4 __attribute__((ext_vector_type(4)));
typedef float f32x16 __attribute__((ext_vector_type(16)));
typedef unsigned u32x4 __attribute__((ext_vector_type(4)));
typedef unsigned u32x2 __attribute__((ext_vector_type(2)));
typedef __bf16 bf2_t __attribute__((ext_vector_type(2)));
typedef float f32x2 __attribute__((ext_vector_type(2)));
#define DI __device__ __forceinline__

constexpr int M_TOK = 32768, SEQ = 4096, DM = 1024, INW = 1888, INWP = 2048, DFF = 2816, DFF2 = 5632;
constexpr float EPS = 1e-6f;
constexpr float LOG2E = 1.4426950408889634f;
constexpr int NTHR = 512, NWAVE = NTHR / 64;
constexpr int XLD = 1024 + 64, ALD = DFF + 64;

constexpr size_t SZ_WIN = (size_t)2 * INWP * XLD * 2, SZ_WUQ = (size_t)2 * 512 * 192 * 2, SZ_WUKV = (size_t)2 * 512 * 128 * 2,
                 SZ_WOUT = (size_t)2 * 1024 * XLD * 2, SZ_WUP = (size_t)2 * DFF2 * XLD * 2, SZ_WDN = (size_t)2 * 1024 * ALD * 2;
constexpr size_t OFF_WIN = 0, OFF_WUQ = OFF_WIN + SZ_WIN, OFF_WUKV = OFF_WUQ + SZ_WUQ, OFF_WOUT = OFF_WUKV + SZ_WUKV,
                 OFF_WUP = OFF_WOUT + SZ_WOUT, OFF_WDN = OFF_WUP + SZ_WUP, OFF_TAB = OFF_WDN + SZ_WDN, OFF_XB = OFF_TAB + 16384;
constexpr size_t OFF_SSX = OFF_XB + (size_t)M_TOK * XLD * 2, OFF_SSCQ = OFF_SSX + (size_t)M_TOK * 16 * 4, OFF_SSCKV = OFF_SSCQ + (size_t)M_TOK * 4 * 4,
                 OFF_BIG = OFF_SSCKV + (size_t)M_TOK * 2 * 4;
constexpr size_t OFF_QA = OFF_BIG, OFF_KA = OFF_QA + (size_t)M_TOK * 512 * 2,
                 OFF_VA = OFF_KA + (size_t)M_TOK * 128 * 2, OFF_CQ = OFF_VA + (size_t)M_TOK * 128 * 2, OFF_CKV = OFF_CQ + (size_t)M_TOK * 192 * 2,
                 OFF_QB = OFF_CKV + (size_t)M_TOK * 128 * 2, OFF_KB = OFF_QB + (size_t)M_TOK * 384 * 2, OFF_VB = OFF_KB + (size_t)M_TOK * 384 * 2,
                 OFF_QC = OFF_VB + (size_t)M_TOK * 256 * 2, OFF_KC = OFF_QC + (size_t)M_TOK * 256 * 2, OFF_VC = OFF_KC + (size_t)M_TOK * 256 * 2,
                 OFF_MIX = OFF_VC + (size_t)M_TOK * 256 * 2, OFF_END1 = OFF_MIX + (size_t)M_TOK * XLD * 2;
constexpr size_t OFF_ACT = OFF_BIG, OFF_END2 = OFF_ACT + (size_t)M_TOK * ALD * 2;
constexpr size_t OFF_BAR = ((OFF_END1 > OFF_END2 ? OFF_END1 : OFF_END2) + 255) & ~(size_t)255;
static_assert(OFF_BAR + 16384 <= (size_t)512 * 1024 * 1024, "workspace");

struct Params {
    const float *x, *norm_attn, *w_in, *qn_a, *kn_a, *qan_b, *w_uq, *kvn_b, *w_ukv, *lq1, *lk1, *lq2, *lk2, *subln, *w_out, *norm_ffn, *w_up,
        *conv_w, *conv_b, *w_down, *final_norm;
    float* out;
    unsigned char* ws;
};

DI unsigned pk2(float a, float b) { f32x2 v = {a, b}; bf2_t r = __builtin_convertvector(v, bf2_t); return __builtin_bit_cast(unsigned, r); }
DI void unpack8(u32x4 r, float* v) {
    v[0] = __uint_as_float(r.x << 16); v[1] = __uint_as_float(r.x & 0xffff0000u);
    v[2] = __uint_as_float(r.y << 16); v[3] = __uint_as_float(r.y & 0xffff0000u);
    v[4] = __uint_as_float(r.z << 16); v[5] = __uint_as_float(r.z & 0xffff0000u);
    v[6] = __uint_as_float(r.w << 16); v[7] = __uint_as_float(r.w & 0xffff0000u);
}
DI u32x4 pack8(const float* v) { u32x4 r; r.x = pk2(v[0], v[1]); r.y = pk2(v[2], v[3]); r.z = pk2(v[4], v[5]); r.w = pk2(v[6], v[7]); return r; }
DI int tid_opaque(int wv) { int t; asm volatile("v_mbcnt_lo_u32_b32 %0, -1, 0\n\tv_mbcnt_hi_u32_b32 %0, -1, %0" : "=v"(t)); return t | (wv << 6); }
DI int bid_opaque() { int b = blockIdx.x; asm volatile("" : "+s"(b)); return b; }
DI float shflx(float v, int mask, int lane) { return __int_as_float(__builtin_amdgcn_ds_bpermute((lane ^ mask) << 2, __float_as_int(v))); }
DI float wave_sum(float v, int lane) {
#pragma unroll
    for (int o = 32; o >= 1; o >>= 1) v += shflx(v, o, lane);
    return v;
}

template <bool UPPERM>
DI void prep_weight(const float* __restrict__ W, const float* __restrict__ gain, bf16_t* __restrict__ Wt, int ldw, int K, int N, int Npad, int gtid, int gthreads) {
    const int total = Npad * (K / 8);
    for (int idx = gtid; idx < total; idx += gthreads) {
        const int n = idx % Npad, kc = idx / Npad;
        int ns = n;
        if (UPPERM) { const int j = n >> 8, r = n & 255; ns = (r < 128) ? (128 * j + r) : (DFF + 128 * j + r - 128); }
        float v[8];
#pragma unroll
        for (int j = 0; j < 8; ++j) { const int k = kc * 8 + j; v[j] = (n < N) ? W[(size_t)k * N + ns] * (gain ? gain[k] : 1.0f) : 0.f; }
        *(u32x4*)(Wt + (size_t)n * ldw + kc * 8) = pack8(v);
    }
}

DI void convert_x(const float* X, bf16_t* XB, float* SSX, int wv) {
    const int tid_ = tid_opaque(wv);
    const int lane = tid_ & 63, gw = bid_opaque() * NWAVE + (tid_ >> 6), nw = gridDim.x * NWAVE;
    for (int row = gw; row < M_TOK; row += nw) {
        const f32x4* xr = (const f32x4*)(X + (size_t)row * 1024);
        float ss = 0.f;
#pragma unroll
        for (int i = 0; i < 4; ++i) {
            const f32x4 v = xr[lane + 64 * i];
            ss += v[0] * v[0] + v[1] * v[1] + v[2] * v[2] + v[3] * v[3];
            u32x2 w; w.x = pk2(v[0], v[1]); w.y = pk2(v[2], v[3]);
            *(u32x2*)(XB + (size_t)row * XLD + (lane + 64 * i) * 4) = w;
        }
        ss = wave_sum(ss, lane);
        if (lane < 16) SSX[(size_t)row * 16 + lane] = (lane == 0) ? ss : 0.f;
    }
}
DI void final_norm(const bf16_t* XB, float* Out, const float* __restrict__ g, const float* SSX, int wv) {
    const int tid_ = tid_opaque(wv);
    const int lane = tid_ & 63, gw = bid_opaque() * NWAVE + (tid_ >> 6), nw = gridDim.x * NWAVE;
    for (int row = gw; row < M_TOK; row += nw) {
        float ss = (lane < 16) ? SSX[(size_t)row * 16 + lane] : 0.f;
        ss = wave_sum(ss, lane);
        const float rstd = rsqrtf(ss * (1.0f / 1024.0f) + EPS);
        f32x4* orow = (f32x4*)(Out + (size_t)row * 1024);
#pragma unroll
        for (int i = 0; i < 4; ++i) {
            const u32x2 w = *(const u32x2*)(XB + (size_t)row * XLD + (lane + 64 * i) * 4);
            f32x4 r; r[0] = __uint_as_float(w.x << 16); r[1] = __uint_as_float(w.x & 0xffff0000u); r[2] = __uint_as_float(w.y << 16); r[3] = __uint_as_float(w.y & 0xffff0000u);
            const f32x4 gv = ((const f32x4*)g)[lane + 64 * i];
            orow[lane + 64 * i] = r * rstd * gv;
        }
    }
}
DI float row_rstd(const float* ssx, int m) {
    const f32x4* pp = (const f32x4*)(ssx + (size_t)m * 16);
    const f32x4 a = (pp[0] + pp[1]) + (pp[2] + pp[3]);
    return rsqrtf(((a[0] + a[1]) + (a[2] + a[3])) * (1.0f / 1024.0f) + EPS);
}

constexpr int GSTR = 128, GOP = 256 * GSTR;
constexpr int SMEM_BYTES = 4 * GOP;
constexpr int SMEM_CONV = 256 * 132 * 4;
constexpr int SMEM_TOTAL = SMEM_CONV > SMEM_BYTES ? SMEM_CONV : SMEM_BYTES;

DI void gemm_mainloop(const bf16_t* __restrict__ Ab, const unsigned (&aoff)[4], const bool (&av)[4], const bf16_t* __restrict__ Bb, unsigned boff, int ldb, int nk, unsigned char* smem, f32x4 (&acc)[8][4], int tid) {
    const int lane = tid & 63, wid = tid >> 6, wr = wid >> 2, wc = wid & 3;
    const int lrow = tid >> 3, lc = tid & 7;
    u32x4 ra[4], rb[4];
#pragma unroll
    for (int i = 0; i < 8; ++i)
#pragma unroll
        for (int j = 0; j < 4; ++j) acc[i][j] = (f32x4){0.f, 0.f, 0.f, 0.f};
    const u32x4 zero4 = {0u, 0u, 0u, 0u};
#define G_LOAD(KT) { _Pragma("unroll") for (int i = 0; i < 4; ++i) { const u32x4 t_ = *(const u32x4*)((const unsigned char*)Ab + (size_t)(aoff[i] + (unsigned)((KT) * 128))); ra[i] = av[i] ? t_ : zero4; rb[i] = *(const u32x4*)((const unsigned char*)Bb + (size_t)(boff + (unsigned)(i * 128 * ldb) + (unsigned)((KT) * 128))); } }
#define G_WRITE(BUF) { int so_ = (BUF) * 2 * GOP + wboff; asm volatile("" : "+v"(so_)); unsigned char* wb_ = smem + so_; _Pragma("unroll") for (int i = 0; i < 4; ++i) { *(u32x4*)(wb_ + i * 64 * GSTR) = ra[i]; *(u32x4*)(wb_ + GOP + i * 64 * GSTR) = rb[i]; } }
    const int wboff = lrow * GSTR + ((lc ^ (lrow & 7)) << 4);
    const int foff = (lane & 15) * GSTR;
    const int fsw[2] = {(((lane >> 4)) ^ (lane & 7)) << 4, (((lane >> 4) + 4) ^ (lane & 7)) << 4};
    G_LOAD(0);
    G_WRITE(0);
    __syncthreads();
    for (int kt = 0; kt < nk; ++kt) {
        { const int kl = (kt + 1 < nk) ? kt + 1 : nk - 1; G_LOAD(kl); }
        const unsigned char* sa = smem + (kt & 1) * 2 * GOP + wr * 128 * GSTR + foff;
        const unsigned char* sb = smem + (kt & 1) * 2 * GOP + GOP + wc * 64 * GSTR + foff;
        int so_ = ((kt + 1) & 1) * 2 * GOP + wboff; asm volatile("" : "+v"(so_));
        unsigned char* wb_ = smem + so_;
#pragma unroll
        for (int kk = 0; kk < 2; ++kk) {
            bf16x8 af[8], bfr[4];
#pragma unroll
            for (int i = 0; i < 4; ++i) bfr[i] = *(const bf16x8*)(sb + i * 16 * GSTR + fsw[kk]);
#pragma unroll
            for (int i = 0; i < 8; ++i) af[i] = *(const bf16x8*)(sa + i * 16 * GSTR + fsw[kk]);
#pragma unroll
            for (int mi = 0; mi < 8; ++mi) {
#pragma unroll
                for (int ni = 0; ni < 4; ++ni) acc[mi][ni] = __builtin_amdgcn_mfma_f32_16x16x32_bf16(bfr[ni], af[mi], acc[mi][ni], 0, 0, 0);
                if (kk == 1) { if (mi < 4) *(u32x4*)(wb_ + mi * 64 * GSTR) = ra[mi]; else *(u32x4*)(wb_ + GOP + (mi - 4) * 64 * GSTR) = rb[mi - 4]; }
            }
        }
        __builtin_amdgcn_sched_group_barrier(0x008, 32, 0);
#pragma unroll
        for (int g = 0; g < 8; ++g) { __builtin_amdgcn_sched_group_barrier(0x008, 4, 0); __builtin_amdgcn_sched_group_barrier(0x200, 1, 0); }
        __syncthreads();
    }
#undef G_LOAD
#undef G_WRITE
}

template <class Epi>
DI void gemm_tile(const bf16_t* __restrict__ A, int lda, const bf16_t* __restrict__ Bt, int ldb, int K, int m0, int n0, unsigned char* smem, const Epi& epi, int wv) {
    const int tid = tid_opaque(wv), lane = tid & 63, wid = tid >> 6, wr = wid >> 2, wc = wid & 3;
    const int lrow = tid >> 3, lc = tid & 7;
    unsigned aoff[4];
    const bool av[4] = {true, true, true, true};
#pragma unroll
    for (int i = 0; i < 4; ++i) aoff[i] = (unsigned)((lrow + 64 * i) * lda + lc * 8) * 2u;
    const unsigned boff = (unsigned)(lrow * ldb + lc * 8) * 2u;
    f32x4 acc[8][4];
    gemm_mainloop(A + (size_t)m0 * lda, aoff, av, Bt + (size_t)n0 * ldb, boff, ldb, K / 64, smem, acc, tid);
    epi(acc, m0 + wr * 128, n0 + wc * 64, lane);
}

template <class Epi>
DI void gemm_phase(const bf16_t* A, int lda, const bf16_t* Bt, int ldb, int K, int Mrows, int Ncols, unsigned char* smem, const Epi& epi, int wv) {
    const int nN = Ncols / 256, nM = Mrows / 256;
    const int bid = bid_opaque(), G = gridDim.x;
    const int xcd = bid & 7, lb = bid >> 3, nlb = G >> 3, mper = nM >> 3, nloc = mper * nN;
    for (int j = lb; j < nloc; j += nlb) {
        const int g = j / (4 * nN), rem = j - g * 4 * nN;
        const int mt = xcd * mper + g * 4 + (rem & 3), nt = rem >> 2;
        gemm_tile(A, lda, Bt, ldb, K, mt * 256, nt * 256, smem, epi, wv);
    }
}

DI float dot4(f32x4 a) { return (a[0] * a[0] + a[1] * a[1]) + (a[2] * a[2] + a[3] * a[3]); }
DI void st4bf(bf16_t* dst, f32x4 v) { u32x2 w; w.x = pk2(v[0], v[1]); w.y = pk2(v[2], v[3]); *(u32x2*)dst = w; }

template <bool XIN_F32>
struct EpiResid2 {
    const float* Xin; bf16_t* XB; float* SSX;
    DI void operator()(const f32x4 (&acc)[8][4], int mb, int nb, int lane) const {
        const int q = lane >> 4;
#pragma unroll
        for (int mi = 0; mi < 8; ++mi) {
            const int m = mb + mi * 16 + (lane & 15);
            float ss = 0.f;
#pragma unroll
            for (int ni = 0; ni < 4; ++ni) {
                const int col = nb + ni * 16 + q * 4;
                bf16_t* xb = XB + (size_t)m * XLD + col;
                f32x4 r;
                if (XIN_F32) r = *(const f32x4*)(Xin + (size_t)m * 1024 + col);
                else { const u32x2 w = *(const u32x2*)xb; r[0] = __uint_as_float(w.x << 16); r[1] = __uint_as_float(w.x & 0xffff0000u); r[2] = __uint_as_float(w.y << 16); r[3] = __uint_as_float(w.y & 0xffff0000u); }
                r += acc[mi][ni];
                st4bf(xb, r);
                ss += dot4(r);
            }
            ss += shflx(ss, 16, lane); ss += shflx(ss, 32, lane);
            if (q == 0) SSX[(size_t)m * 16 + (nb >> 6)] = ss;
        }
    }
};

struct EpiInProj {
    const float *ssx, *tab, *gq, *gk;
    bf16_t *QA, *KA, *VA, *CQ, *CKV, *KB, *QC, *KC, *VC;
    float *sscq, *ssckv;
    DI void operator()(const f32x4 (&acc)[8][4], int mb, int nb, int lane) const {
        const int q = lane >> 4, ml = lane & 15;
        const float qsA = 0.125f * LOG2E, qsC = 0.17677669529663687f * LOG2E;
        if (nb < 640) {
            const bool isq = nb < 512;
            const int head = isq ? (nb >> 6) : ((nb - 512) >> 6);
            const float* g = isq ? gq : gk;
            f32x4 gv[4];
#pragma unroll
            for (int ni = 0; ni < 4; ++ni) gv[ni] = *(const f32x4*)(g + ni * 16 + q * 4);
#pragma unroll
            for (int mi = 0; mi < 8; ++mi) {
                const int m = mb + mi * 16 + ml, b = m >> 12, s = m & 4095;
                const float rs = row_rstd(ssx, m);
                f32x4 v[4];
                float ss = 0.f;
#pragma unroll
                for (int ni = 0; ni < 4; ++ni) { v[ni] = acc[mi][ni] * rs; ss += dot4(v[ni]); }
                ss += shflx(ss, 16, lane); ss += shflx(ss, 32, lane);
                const float r2 = rsqrtf(ss * (1.0f / 64.0f) + EPS);
#pragma unroll
                for (int ni = 0; ni < 4; ++ni) v[ni] = v[ni] * r2 * gv[ni];
                const float* tr = tab + (s >> 6) * 16 + q * 4;
                const float* tq = tab + (s & 63) * 16 + q * 4;
                const f32x4 c0 = *(const f32x4*)tr, s0 = *(const f32x4*)(tr + 1024), c1 = *(const f32x4*)tq, s1 = *(const f32x4*)(tq + 1024);
                f32x4 o0 = v[0] * c0 - v[1] * s0, o1 = v[1] * c0 + v[0] * s0, o2 = v[2] * c1 - v[3] * s1, o3 = v[3] * c1 + v[2] * s1;
                bf16_t* dst;
                if (isq) { o0 *= qsA; o1 *= qsA; o2 *= qsA; o3 *= qsA; dst = QA + ((size_t)(b * 8 + head) * SEQ + s) * 64 + q * 4; }
                else dst = KA + ((size_t)(b * 2 + head) * SEQ + s) * 64 + q * 4;
                st4bf(dst, o0); st4bf(dst + 16, o1); st4bf(dst + 32, o2); st4bf(dst + 48, o3);
            }
        } else if (nb < 768) {
            const int head = (nb - 640) >> 6;
#pragma unroll
            for (int mi = 0; mi < 8; ++mi) {
                const int m = mb + mi * 16 + ml, b = m >> 12, s = m & 4095;
                const float rs = row_rstd(ssx, m);
                bf16_t* dst = VA + ((size_t)(b * 2 + head) * SEQ + s) * 64 + q * 4;
#pragma unroll
                for (int ni = 0; ni < 4; ++ni) st4bf(dst + ni * 16, acc[mi][ni] * rs);
            }
        } else {
            const bool sq = nb < 1088;
#pragma unroll
            for (int mi = 0; mi < 8; ++mi) {
                const int m = mb + mi * 16 + ml, b = m >> 12, s = m & 4095;
                const float rs = row_rstd(ssx, m);
                float ss = 0.f;
#pragma unroll
                for (int ni = 0; ni < 4; ++ni) {
                    const int n16 = nb + ni * 16;
                    f32x4 v = acc[mi][ni] * rs;
                    if (n16 < 960) { st4bf(CQ + (size_t)m * 192 + (n16 - 768) + q * 4, v); ss += dot4(v); }
                    else if (n16 < 1088) { st4bf(CKV + (size_t)m * 128 + (n16 - 960) + q * 4, v); ss += dot4(v); }
                    else if (n16 < 1120) {
                        f32x4 pr;
#pragma unroll
                        for (int i = 0; i < 4; ++i) pr[i] = shflx(v[i], 32, lane);
                        const int pos = (n16 >= 1104) ? (s & 63) : (s >> 6);
                        const float* tc = tab + 2048 + pos * 8 + (q & 1) * 4;
                        const f32x4 c = *(const f32x4*)tc, sn = *(const f32x4*)(tc + 512);
                        const f32x4 o = (q < 2) ? (v * c - pr * sn) : (v * c + pr * sn);
#pragma unroll
                        for (int hh = 0; hh < 4; ++hh) st4bf(KB + ((size_t)(b * 4 + hh) * SEQ + s) * 96 + 64 + (n16 - 1088) + q * 4, o);
                    } else if (n16 < 1376) { const int c = n16 - 1120 + q * 4; st4bf(QC + ((size_t)(b * 4 + (c >> 6)) * SEQ + s) * 64 + (c & 63), v * qsC); }
                    else if (n16 < 1632) { const int c = n16 - 1376 + q * 4; st4bf(KC + ((size_t)(b * 4 + (c >> 6)) * SEQ + s) * 64 + (c & 63), v); }
                    else if (n16 < 1888) { const int c = n16 - 1632 + q * 4; st4bf(VC + ((size_t)(b * 4 + (c >> 6)) * SEQ + s) * 64 + (c & 63), v); }
                }
                if (sq) {
                    ss += shflx(ss, 16, lane); ss += shflx(ss, 32, lane);
                    if (q == 0) { if (nb < 960) sscq[(size_t)m * 4 + ((nb - 768) >> 6)] = ss; else ssckv[(size_t)m * 2 + ((nb - 960) >> 6)] = ss; }
                }
            }
        }
    }
};
struct EpiMlaQ {
    bf16_t* QB; const float* tab; const float* sscq; float qscale;
    DI void operator()(const f32x4 (&acc)[8][4], int mb, int nb, int lane) const {
#pragma unroll
        for (int mi = 0; mi < 8; ++mi) {
            const int m = mb + mi * 16 + (lane & 15), q = lane >> 4, b = m >> 12, s = m & 4095;
            const f32x4 sp = *(const f32x4*)(sscq + (size_t)m * 4);
            const float rs = rsqrtf((sp[0] + sp[1] + sp[2]) * (1.0f / 192.0f) + EPS) * qscale;
#pragma unroll
            for (int ni = 0; ni < 4; ++ni) {
                const int nt = nb + ni * 16;
                if (nt >= 384) continue;
                const int head = nt / 96, dt = nt - head * 96;
                f32x4 v = acc[mi][ni] * rs;
                f32x4 pr;
#pragma unroll
                for (int i = 0; i < 4; ++i) pr[i] = shflx(v[i], 32, lane);
                if (dt >= 64) {
                    const int pos = (dt >= 80) ? (s & 63) : (s >> 6);
                    const float* tc = tab + 2048 + pos * 8 + (q & 1) * 4;
                    const f32x4 c = *(const f32x4*)tc, sn = *(const f32x4*)(tc + 512);
                    v = (q < 2) ? (v * c - pr * sn) : (v * c + pr * sn);
                }
                st4bf(QB + ((size_t)(b * 4 + head) * SEQ + s) * 96 + dt + q * 4, v);
            }
        }
    }
};
struct EpiMlaKV {
    bf16_t* KB; bf16_t* VB; const float* ssckv;
    DI void operator()(const f32x4 (&acc)[8][4], int mb, int nb, int lane) const {
#pragma unroll
        for (int mi = 0; mi < 8; ++mi) {
            const int m = mb + mi * 16 + (lane & 15), b = m >> 12, s = m & 4095;
            const f32x2 sp = *(const f32x2*)(ssckv + (size_t)m * 2);
            const float rs = rsqrtf((sp[0] + sp[1]) * (1.0f / 128.0f) + EPS);
#pragma unroll
            for (int ni = 0; ni < 4; ++ni) {
                const int n = nb + ni * 16 + (lane >> 4) * 4;
                const int head = n >> 7, d = n & 127;
                const size_t rowi = (size_t)(b * 4 + head) * SEQ + s;
                if (d < 64) st4bf(KB + rowi * 96 + d, acc[mi][ni] * rs);
                else st4bf(VB + rowi * 64 + (d - 64), acc[mi][ni] * rs);
            }
        }
    }
};

DI void up_conv_tile(const bf16_t* __restrict__ XB, const bf16_t* __restrict__ Wt, const float* __restrict__ ssx, const float* __restrict__ cw, const float* __restrict__ cb,
                     bf16_t* __restrict__ ACT, int b, int jt, int nt, unsigned char* smem, int wv) {
    const int tid = tid_opaque(wv), lane = tid & 63, wid = tid >> 6, wr = wid >> 2, wc = wid & 3;
    const int lrow = tid >> 3, lc = tid & 7;
    const int tbase = jt * 254 - 1;
    unsigned aoff[4];
    bool av[4];
#pragma unroll
    for (int i = 0; i < 4; ++i) {
        const int tl = tbase + lrow + 64 * i;
        av[i] = (unsigned)tl < 4096u;
        const int tc = tl < 0 ? 0 : (tl > 4095 ? 4095 : tl);
        aoff[i] = (unsigned)(tc * XLD + lc * 8) * 2u;
    }
    const unsigned boff = (unsigned)(lrow * XLD + lc * 8) * 2u;
    f32x4 acc[8][4];
    gemm_mainloop(XB + (size_t)b * SEQ * XLD, aoff, av, Wt + (size_t)nt * 256 * XLD, boff, XLD, 16, smem, acc, tid);
    float* T = (float*)smem;
    const int q = lane >> 4, ml = lane & 15;
    float rs[8];
#pragma unroll
    for (int mi = 0; mi < 8; ++mi) {
        const int tl = tbase + wr * 128 + mi * 16 + ml;
        const int tc = tl < 0 ? 0 : (tl > 4095 ? 4095 : tl);
        rs[mi] = row_rstd(ssx, b * SEQ + tc);
    }
#pragma unroll
    for (int h = 0; h < 2; ++h) {
        if ((wc & 1) == h) {
#pragma unroll
            for (int mi = 0; mi < 8; ++mi)
#pragma unroll
                for (int ni = 0; ni < 4; ++ni) *(f32x4*)(T + (wr * 128 + mi * 16 + ml) * 132 + (wc >> 1) * 64 + ni * 16 + q * 4) = acc[mi][ni] * rs[mi];
        }
        __syncthreads();
        {
            const int cq = tid & 15, rg = tid >> 4, ch = nt * 128 + h * 64 + cq * 4;
            const f32x4 wg0 = *(const f32x4*)(cw + ch), wg1 = *(const f32x4*)(cw + DFF2 + ch), wg2 = *(const f32x4*)(cw + 2 * DFF2 + ch), bg = *(const f32x4*)(cb + ch);
            const f32x4 wv0 = *(const f32x4*)(cw + DFF + ch), wv1 = *(const f32x4*)(cw + DFF2 + DFF + ch), wv2 = *(const f32x4*)(cw + 2 * DFF2 + DFF + ch), bv = *(const f32x4*)(cb + DFF + ch);
            const int r0 = rg * 8, rm = r0 > 0 ? r0 - 1 : 0;
            f32x4 gm = *(const f32x4*)(T + rm * 132 + cq * 4), vm = *(const f32x4*)(T + rm * 132 + 64 + cq * 4);
            f32x4 g0 = *(const f32x4*)(T + r0 * 132 + cq * 4), v0 = *(const f32x4*)(T + r0 * 132 + 64 + cq * 4);
#pragma unroll
            for (int rr = 0; rr < 8; ++rr) {
                const int r = r0 + rr, rp = r < 255 ? r + 1 : 255;
                const f32x4 gp = *(const f32x4*)(T + rp * 132 + cq * 4), vp = *(const f32x4*)(T + rp * 132 + 64 + cq * 4);
                const f32x4 gg = wg0 * gm + wg1 * g0 + wg2 * gp + bg;
                const f32x4 vv = wv0 * vm + wv1 * v0 + wv2 * vp + bv;
                f32x4 o;
#pragma unroll
                for (int e = 0; e < 4; ++e) o[e] = gg[e] * __builtin_amdgcn_rcpf(1.0f + __builtin_amdgcn_exp2f(-LOG2E * gg[e])) * vv[e];
                const int tl = tbase + r;
                if (r >= 1 && r <= 254 && tl <= 4095) st4bf(ACT + ((size_t)b * SEQ + tl) * ALD + ch, o);
                gm = g0; g0 = gp; vm = v0; v0 = vp;
            }
        }
        __syncthreads();
    }
}
DI void up_conv_phase(const bf16_t* XB, const bf16_t* Wt, const float* ssx, const float* cw, const float* cb, bf16_t* ACT, unsigned char* smem, int wv) {
    constexpr int NT = DFF / 128, MT = 17;
    const int bid = bid_opaque(), G = gridDim.x;
    const int xcd = bid & 7, lb = bid >> 3, nlb = G >> 3, nloc = MT * NT, full = (MT / 4) * 4 * NT, gs = MT - (MT / 4) * 4;
    for (int j = lb; j < nloc; j += nlb) {
        int jt, nt;
        if (j < full) { const int g = j / (4 * NT), rem = j - g * 4 * NT; jt = g * 4 + (rem & 3); nt = rem >> 2; }
        else { const int j2 = j - full; jt = (MT / 4) * 4 + j2 % gs; nt = j2 / gs; }
        up_conv_tile(XB, Wt, ssx, cw, cb, ACT, xcd, jt, nt, smem, wv);
    }
}

constexpr int ATT_STAGE = 64 * 208 + 8192;

template <int DQK, bool DIFF>
DI void attn_tile(const unsigned char* cur, int kt, f32x16 (&O)[DIFF ? 2 : 1][2], float (&mrun)[DIFF ? 2 : 1], float (&lsum)[DIFF ? 2 : 1], const bf16x8 (&qf)[DIFF ? 2 : 1][DIFF ? 2 : DQK / 16],
               int kfo, int vfo0, int vfo1, float qpos, float slope2, int h) {
    constexpr int NQT = DIFF ? 2 : 1, KS = DIFF ? 2 : DQK / 16, KSTR = DQK * 2 + 16;
        bf16x8 kfr[2][KS], vfr[2][2][2];
#pragma unroll
        for (int kh = 0; kh < 2; ++kh)
#pragma unroll
            for (int ks = 0; ks < KS; ++ks) kfr[kh][ks] = *(const bf16x8*)(cur + kfo + kh * 32 * KSTR + (ks * 16) * 2);
        if (!DIFF) {
#pragma unroll
            for (int kh = 0; kh < 2; ++kh)
#pragma unroll
                for (int s2 = 0; s2 < 2; ++s2)
#pragma unroll
                    for (int d = 0; d < 2; ++d) {
                        const unsigned char* va = cur + (d ? vfo1 : vfo0) + (kh * 32 + 16 * s2) * 128;
                        const s16x4 lo = __builtin_amdgcn_ds_read_tr16_b64_v4i16((__attribute__((address_space(3))) s16x4*)(va));
                        const s16x4 hi = __builtin_amdgcn_ds_read_tr16_b64_v4i16((__attribute__((address_space(3))) s16x4*)(va + 8 * 128));
                        vfr[kh][s2][d] = __builtin_shufflevector(lo, hi, 0, 1, 2, 3, 4, 5, 6, 7);
                    }
        }
        __builtin_amdgcn_sched_barrier(0);
#pragma unroll
        for (int qt = 0; qt < NQT; ++qt) {
            bf16x8 pf[2][2];
            f32x16 S[2];
#pragma unroll
            for (int kh = 0; kh < 2; ++kh) {
#pragma unroll
                for (int i = 0; i < 16; ++i) S[kh][i] = 0.f;
#pragma unroll
                for (int ks = 0; ks < KS; ++ks) S[kh] = __builtin_amdgcn_mfma_f32_32x32x16_bf16(kfr[kh][ks], qf[qt][ks], S[kh], 0, 0, 0);
            }
            if (DIFF && qt == 0) {
#pragma unroll
                for (int kh = 0; kh < 2; ++kh)
#pragma unroll
                    for (int ks = 0; ks < KS; ++ks) kfr[kh][ks] = *(const bf16x8*)(cur + kfo + kh * 32 * KSTR + (32 + ks * 16) * 2);
            }
            if (DIFF) {
                const float d0 = qpos - (float)(kt * 64 + 4 * h);
#pragma unroll
                for (int kh = 0; kh < 2; ++kh)
#pragma unroll
                    for (int i = 0; i < 16; ++i) S[kh][i] -= slope2 * fabsf(d0 - (float)(kh * 32 + (i & 3) + 8 * (i >> 2)));
            }
            float mx = __builtin_elementwise_maximum(S[0][0], S[1][0]);
#pragma unroll
            for (int i = 1; i < 16; ++i) mx = __builtin_elementwise_maximum(mx, __builtin_elementwise_maximum(S[0][i], S[1][i]));
            { const auto sw = __builtin_amdgcn_permlane32_swap(__float_as_uint(mx), __float_as_uint(mx), false, false); mx = __builtin_elementwise_maximum(__uint_as_float(sw[0]), __uint_as_float(sw[1])); }
            const float rel = mx - mrun[qt];
            const bool need = (rel > 8.0f) || (kt == 0 && rel < -8.0f);
            if (__builtin_amdgcn_ballot_w64(need) != 0ull) {
                const float delta = need ? rel : 0.f;
                const float alpha = (kt == 0) ? 1.0f : __builtin_amdgcn_exp2f(-delta);
                mrun[qt] += delta;
                lsum[qt] *= alpha;
#pragma unroll
                for (int d = 0; d < 2; ++d)
#pragma unroll
                    for (int i = 0; i < 16; ++i) O[qt][d][i] *= alpha;
            }
            float ps = 0.f;
            if (__builtin_amdgcn_ballot_w64(mrun[qt] != 0.f) != 0ull) {
#pragma unroll
                for (int kh = 0; kh < 2; ++kh)
#pragma unroll
                    for (int i = 0; i < 16; ++i) { const float pv = __builtin_amdgcn_exp2f(S[kh][i] - mrun[qt]); S[kh][i] = pv; ps += pv; }
            } else {
#pragma unroll
                for (int kh = 0; kh < 2; ++kh)
#pragma unroll
                    for (int i = 0; i < 16; ++i) { const float pv = __builtin_amdgcn_exp2f(S[kh][i]); S[kh][i] = pv; ps += pv; }
            }
            lsum[qt] += ps;
#pragma unroll
            for (int kh = 0; kh < 2; ++kh)
#pragma unroll
                for (int s2 = 0; s2 < 2; ++s2) {
                    u32x4 w;
                    w.x = pk2(S[kh][8 * s2 + 0], S[kh][8 * s2 + 1]); w.y = pk2(S[kh][8 * s2 + 2], S[kh][8 * s2 + 3]);
                    w.z = pk2(S[kh][8 * s2 + 4], S[kh][8 * s2 + 5]); w.w = pk2(S[kh][8 * s2 + 6], S[kh][8 * s2 + 7]);
                    pf[kh][s2] = __builtin_bit_cast(bf16x8, w);
                }
#pragma unroll
            for (int kh = 0; kh < 2; ++kh)
#pragma unroll
                for (int s2 = 0; s2 < 2; ++s2)
#pragma unroll
                    for (int d = 0; d < 2; ++d) {
                        if (DIFF) {
                            const unsigned char* va = cur + (d ? vfo1 : vfo0) + (kh * 32 + 16 * s2) * 128;
                            const s16x4 lo = __builtin_amdgcn_ds_read_tr16_b64_v4i16((__attribute__((address_space(3))) s16x4*)(va));
                            const s16x4 hi = __builtin_amdgcn_ds_read_tr16_b64_v4i16((__attribute__((address_space(3))) s16x4*)(va + 8 * 128));
                            vfr[kh][s2][d] = __builtin_shufflevector(lo, hi, 0, 1, 2, 3, 4, 5, 6, 7);
                        }
                        O[qt][d] = __builtin_amdgcn_mfma_f32_32x32x16_bf16(vfr[kh][s2][d], pf[kh][s2], O[qt][d], 0, 0, 0);
                    }
            if (DIFF) __builtin_amdgcn_sched_barrier(0);
        }
}

template <int DQK, bool DIFF>
DI void attn_unit(const bf16_t* __restrict__ Qg, const bf16_t* __restrict__ Kg, const bf16_t* __restrict__ Vg, int q0, bf16_t* __restrict__ outp,
                  float slope2, float lam, float outmul, const float* __restrict__ subln, unsigned char* smem, int wv) {
    constexpr int NQT = DIFF ? 2 : 1, KS = DIFF ? 2 : DQK / 16, KSTR = DQK * 2 + 16, CPR = DQK / 8, KCH = (64 * CPR + NTHR - 1) / NTHR, KBYTES = 64 * 208;
    const int tid = tid_opaque(wv), lane = tid & 63, wid = tid >> 6, r = lane & 31, h = lane >> 5;
    const int qrow = q0 + wid * 32 + r;
    bf16x8 qf[NQT][KS];
#pragma unroll
    for (int qt = 0; qt < NQT; ++qt)
#pragma unroll
        for (int ks = 0; ks < KS; ++ks) qf[qt][ks] = *(const bf16x8*)(Qg + (size_t)qrow * DQK + qt * 32 + ks * 16 + h * 8);
    f32x16 O[NQT][2];
    float mrun[NQT], lsum[NQT];
#pragma unroll
    for (int qt = 0; qt < NQT; ++qt) {
        mrun[qt] = 0.f; lsum[qt] = 0.f;
#pragma unroll
        for (int d = 0; d < 2; ++d)
#pragma unroll
            for (int i = 0; i < 16; ++i) O[qt][d][i] = 0.f;
    }
    int koff[KCH], voff;
    bool kval[KCH];
#pragma unroll
    for (int i = 0; i < KCH; ++i) { const int id = tid + NTHR * i, key = id / CPR, c = id % CPR; koff[i] = key * KSTR + c * 16; kval[i] = id < 64 * CPR; }
    { const int key = tid >> 3, c = tid & 7; voff = KBYTES + key * 128 + ((c ^ (((key >> 1) & 1) << 2)) * 16); }
    u32x4 rk[KCH], rv;
#pragma unroll
    for (int i = 0; i < KCH; ++i) if (kval[i]) rk[i] = *(const u32x4*)(Kg + (size_t)(tid + NTHR * i) * 8);
    rv = *(const u32x4*)(Vg + (size_t)tid * 8);
#pragma unroll
    for (int i = 0; i < KCH; ++i) if (kval[i]) *(u32x4*)(smem + koff[i]) = rk[i];
    *(u32x4*)(smem + voff) = rv;
    __syncthreads();
    const int kfo = r * KSTR + h * 16;
    const int qq = (lane >> 2) & 3;
    const int colb0 = ((qq >> 1) & 1) * 64 + 32 * ((lane >> 4) & 1) + 8 * (lane & 3);
    const int vfo0 = KBYTES + (4 * h + qq) * 128 + colb0, vfo1 = KBYTES + (4 * h + qq) * 128 + (colb0 ^ 64);
    const float qpos = (float)qrow;

    u32x4 rk2[KCH], rv2;
#define AT_LOAD(RK, RV, T) { const int tn_ = (T) < SEQ / 64 ? (T) : SEQ / 64 - 1; _Pragma("unroll") for (int i = 0; i < KCH; ++i) RK[i] = *(const u32x4*)(Kg + (size_t)tn_ * 64 * DQK + (size_t)(kval[i] ? tid + NTHR * i : tid) * 8);     RV = *(const u32x4*)(Vg + (size_t)tn_ * 64 * 64 + (size_t)tid * 8); }
#define AT_WRITE(RK, RV, SO) { _Pragma("unroll") for (int i = 0; i < KCH; ++i) if (kval[i]) *(u32x4*)(smem + (SO) + koff[i]) = RK[i]; *(u32x4*)(smem + (SO) + voff) = RV; }
    AT_LOAD(rk2, rv2, 1);
    for (int kt = 0; kt < SEQ / 64; kt += 2) {
        AT_LOAD(rk, rv, kt + 2);
        attn_tile<DQK, DIFF>(smem, kt, O, mrun, lsum, qf, kfo, vfo0, vfo1, qpos, slope2, h);
        AT_WRITE(rk2, rv2, ATT_STAGE);
        __syncthreads();
        AT_LOAD(rk2, rv2, kt + 3);
        attn_tile<DQK, DIFF>(smem + ATT_STAGE, kt + 1, O, mrun, lsum, qf, kfo, vfo0, vfo1, qpos, slope2, h);
        AT_WRITE(rk, rv, 0);
        __syncthreads();
    }
#undef AT_LOAD
#undef AT_WRITE
    const int tid2 = tid_opaque(wv), lane2 = tid2 & 63;
    const int h2 = lane2 >> 5;
    float inv[NQT];
#pragma unroll
    for (int qt = 0; qt < NQT; ++qt) { const float lt = lsum[qt] + shflx(lsum[qt], 32, lane2); inv[qt] = 1.0f / lt; }
    float o[2][16];
    if (DIFF) {
        float ss = 0.f;
#pragma unroll
        for (int d = 0; d < 2; ++d)
#pragma unroll
            for (int i = 0; i < 16; ++i) { const float x = O[0][d][i] * inv[0] - lam * (O[NQT - 1][d][i] * inv[NQT - 1]); o[d][i] = x; ss += x * x; }
        ss += shflx(ss, 32, lane2);
        const float rstd = rsqrtf(ss * (1.0f / 64.0f) + EPS) * outmul;
#pragma unroll
        for (int d = 0; d < 2; ++d)
#pragma unroll
            for (int i = 0; i < 16; ++i) o[d][i] *= rstd * subln[d * 32 + (i & 3) + 8 * (i >> 2) + 4 * h2];
    } else {
#pragma unroll
        for (int d = 0; d < 2; ++d)
#pragma unroll
            for (int i = 0; i < 16; ++i) o[d][i] = O[0][d][i] * inv[0];
    }
    const int qrow2 = q0 + (lane2 & 31) + ((tid2 >> 6) << 5);
    bf16_t* orow = outp + (size_t)qrow2 * XLD;
#pragma unroll
    for (int d = 0; d < 2; ++d)
#pragma unroll
        for (int g = 0; g < 4; ++g) {
            u32x2 w; w.x = pk2(o[d][4 * g], o[d][4 * g + 1]); w.y = pk2(o[d][4 * g + 2], o[d][4 * g + 3]);
            *(u32x2*)(orow + d * 32 + 8 * g + 4 * h2) = w;
        }
}

DI void attn_phase(const Params& p, int layer, float lam_init, float outmul, unsigned char* smem, int wv) {
    unsigned char* ws = p.ws;
    const bf16_t *QA = (const bf16_t*)(ws + OFF_QA), *KA = (const bf16_t*)(ws + OFF_KA), *VA = (const bf16_t*)(ws + OFF_VA), *QB = (const bf16_t*)(ws + OFF_QB),
                 *KB = (const bf16_t*)(ws + OFF_KB), *VB = (const bf16_t*)(ws + OFF_VB), *QC = (const bf16_t*)(ws + OFF_QC), *KC = (const bf16_t*)(ws + OFF_KC),
                 *VC = (const bf16_t*)(ws + OFF_VC);
    bf16_t* MIX = (bf16_t*)(ws + OFF_MIX);
    float s1 = 0.f, s2 = 0.f;
    for (int j = 0; j < 32; ++j) { s1 += p.lq1[layer * 32 + j] * p.lk1[layer * 32 + j]; s2 += p.lq2[layer * 32 + j] * p.lk2[layer * 32 + j]; }
    const float lam = __int_as_float(__builtin_amdgcn_readfirstlane(__float_as_int(expf(s1) - expf(s2) + lam_init)));
    for (int v = bid_opaque(); v < 2048; v += gridDim.x) {
        const int base = v & ~255, i = v & 255, j = i >> 3;
        const int u = base + ((i & 7) * 2 + (j >> 4)) * 16 + (j & 15);
        if (u < 512) {
            const int qb = u & 15, hh = (u >> 4) & 3, b = u >> 6;
            const size_t ro = (size_t)(b * 4 + hh) * SEQ * 64;
            const float slope2 = __int_as_float(__builtin_amdgcn_readfirstlane(__float_as_int(exp2f(-2.0f * (float)(hh + 1)) * LOG2E)));
            attn_unit<64, true>(QC + ro, KC + ro, VC + ro, qb * 256, MIX + (size_t)b * SEQ * XLD + 768 + hh * 64, slope2, lam, outmul,
                                p.subln + layer * 64, smem, wv);
        } else if (u < 1024) {
            const int w = u - 512, qb = w & 15, hh = (w >> 4) & 3, b = w >> 6;
            const size_t rq = (size_t)(b * 4 + hh) * SEQ;
            attn_unit<96, false>(QB + rq * 96, KB + rq * 96, VB + rq * 64, qb * 256, MIX + (size_t)b * SEQ * XLD + 512 + hh * 64, 0.f, 0.f, 0.f, nullptr, smem, wv);
        } else {
            const int w = u - 1024, qb = w & 15, hh = (w >> 4) & 7, b = w >> 7;
            const size_t rq = (size_t)(b * 8 + hh) * SEQ, rk = (size_t)(b * 2 + (hh >> 2)) * SEQ;
            attn_unit<64, false>(QA + rq * 64, KA + rk * 64, VA + rk * 64, qb * 256, MIX + (size_t)b * SEQ * XLD + hh * 64, 0.f, 0.f, 0.f, nullptr, smem, wv);
        }
    }
}

#define GB_XCNT(j) (64 * (j))
#define GB_XSUB(j) (1024 + 64 * (j))
#define GB_XGEN(j) (2048 + 64 * (j))
#define GB_TOP 3072
#define GB_TOPGEN 3136
constexpr int GB_WORDS = 3200;
DI unsigned gb_ld(unsigned* p) { return __hip_atomic_load(p, __ATOMIC_RELAXED, __HIP_MEMORY_SCOPE_AGENT); }
DI unsigned gb_add(unsigned* p) { return __hip_atomic_fetch_add(p, 1u, __ATOMIC_RELAXED, __HIP_MEMORY_SCOPE_AGENT); }
DI unsigned gb_xcc() { return (unsigned)__builtin_amdgcn_s_getreg((3 << 11) | 20) & 0xFu; }
#define GB_SPIN(cond) { unsigned sp_ = 0; while (cond) { __builtin_amdgcn_s_sleep(1); if (++sp_ > (1u << 24)) break; } }
DI void grid_bar(unsigned* bar, unsigned x, unsigned nloc, unsigned nx, unsigned& ep, int wv) {
    asm volatile("s_waitcnt vmcnt(0)" ::: "memory");
    __syncthreads();
    asm volatile("" : "+s"(nloc), "+s"(nx), "+s"(x));
    unsigned epl = ep; asm volatile("" : "+s"(epl));
    if (tid_opaque(wv) == 0) {
        const unsigned old = gb_add(&bar[GB_XSUB(x)]);
        if (old + 1u == (epl + 1u) * nloc) {
            __builtin_amdgcn_fence(__ATOMIC_RELEASE, "agent");
            asm volatile("s_waitcnt vmcnt(0)" ::: "memory");
            const unsigned og = gb_add(&bar[GB_TOP]);
            if (og + 1u == (epl + 1u) * nx) gb_add(&bar[GB_TOPGEN]);
            else GB_SPIN(gb_ld(&bar[GB_TOPGEN]) == epl);
            __builtin_amdgcn_fence(__ATOMIC_ACQUIRE, "agent");
            gb_add(&bar[GB_XGEN(x)]);
            asm volatile("s_waitcnt vmcnt(0)" ::: "memory");
        } else {
            GB_SPIN(gb_ld(&bar[GB_XGEN(x)]) == epl);
            __builtin_amdgcn_fence(__ATOMIC_ACQUIRE, "agent");
            asm volatile("s_waitcnt vmcnt(0)" ::: "memory");
        }
    }
    ep += 1u;
    __syncthreads();
}

__global__ void __launch_bounds__(NTHR, 2) mega(Params p) {
    extern __shared__ __attribute__((aligned(16))) unsigned char smem[];
    cg::grid_group grid = cg::this_grid();
    unsigned char* ws = p.ws;
    const int gtid = blockIdx.x * NTHR + threadIdx.x, gthreads = gridDim.x * NTHR;
    const int wv = __builtin_amdgcn_readfirstlane((int)(threadIdx.x >> 6));
    bf16_t* XB = (bf16_t*)(ws + OFF_XB);
    float* SSX = (float*)(ws + OFF_SSX);
    float* tab = (float*)(ws + OFF_TAB);

    unsigned* bar = (unsigned*)(ws + OFF_BAR);
    const unsigned myx = gb_xcc();
    if (threadIdx.x == 0) gb_add(&bar[GB_XCNT(myx)]);
    for (int l = 0; l < 2; ++l) {
        prep_weight<false>(p.w_in + (size_t)l * 1024 * INW, p.norm_attn + l * 1024, (bf16_t*)(ws + OFF_WIN) + (size_t)l * INWP * XLD, XLD, 1024, INW, INWP, gtid, gthreads);
        prep_weight<false>(p.w_uq + (size_t)l * 192 * 384, p.qan_b + l * 192, (bf16_t*)(ws + OFF_WUQ) + (size_t)l * 512 * 192, 192, 192, 384, 512, gtid, gthreads);
        prep_weight<false>(p.w_ukv + (size_t)l * 128 * 512, p.kvn_b + l * 128, (bf16_t*)(ws + OFF_WUKV) + (size_t)l * 512 * 128, 128, 128, 512, 512, gtid, gthreads);
        prep_weight<false>(p.w_out + (size_t)l * 1024 * 1024, nullptr, (bf16_t*)(ws + OFF_WOUT) + (size_t)l * 1024 * XLD, XLD, 1024, 1024, 1024, gtid, gthreads);
        prep_weight<true>(p.w_up + (size_t)l * 1024 * DFF2, p.norm_ffn + l * 1024, (bf16_t*)(ws + OFF_WUP) + (size_t)l * DFF2 * XLD, XLD, 1024, DFF2, DFF2, gtid, gthreads);
        prep_weight<false>(p.w_down + (size_t)l * DFF * 1024, nullptr, (bf16_t*)(ws + OFF_WDN) + (size_t)l * 1024 * ALD, ALD, DFF, 1024, 1024, gtid, gthreads);
    }
    for (int idx = gtid; idx < 1024 + 512; idx += gthreads) {
        if (idx < 1024) { const int pos = idx >> 4, f = idx & 15; const float ang = (float)pos * powf(10000.0f, -(float)f / 16.0f); tab[idx] = cosf(ang); tab[1024 + idx] = sinf(ang); }
        else { const int k = idx - 1024, pos = k >> 3, f = k & 7; const float ang = (float)pos * powf(10000.0f, -(float)f / 8.0f); tab[2048 + k] = cosf(ang); tab[2560 + k] = sinf(ang); }
    }
    convert_x(p.x, XB, SSX, wv);
    grid.sync();

    unsigned nloc = 1u, nx = 0u, ep = 0u;
    for (unsigned j = 0; j < 16; ++j) { const unsigned c = gb_ld(&bar[GB_XCNT(j)]); nx += (c > 0u) ? 1u : 0u; nloc = (j == myx) ? c : nloc; }
    nloc = __builtin_amdgcn_readfirstlane(nloc > 0u ? nloc : 1u); nx = __builtin_amdgcn_readfirstlane(nx > 0u ? nx : 1u);
    for (int l = 0; l < 2; ++l) {
        const float lam_init = __int_as_float(__builtin_amdgcn_readfirstlane(__float_as_int((l == 0) ? 0.2f : 0.35550906759096984f)));
        gemm_phase(XB, XLD, (const bf16_t*)(ws + OFF_WIN) + (size_t)l * INWP * XLD, XLD, 1024, M_TOK, INWP, smem,
                   EpiInProj{SSX, tab, p.qn_a + l * 64, p.kn_a + l * 64, (bf16_t*)(ws + OFF_QA), (bf16_t*)(ws + OFF_KA), (bf16_t*)(ws + OFF_VA), (bf16_t*)(ws + OFF_CQ),
                             (bf16_t*)(ws + OFF_CKV), (bf16_t*)(ws + OFF_KB), (bf16_t*)(ws + OFF_QC), (bf16_t*)(ws + OFF_KC), (bf16_t*)(ws + OFF_VC),
                             (float*)(ws + OFF_SSCQ), (float*)(ws + OFF_SSCKV)}, wv);
        grid_bar(bar, myx, nloc, nx, ep, wv);
        gemm_phase((const bf16_t*)(ws + OFF_CQ), 192, (const bf16_t*)(ws + OFF_WUQ) + (size_t)l * 512 * 192, 192, 192, M_TOK, 512, smem,
                   EpiMlaQ{(bf16_t*)(ws + OFF_QB), tab, (const float*)(ws + OFF_SSCQ), 0.10206207261596575f * LOG2E}, wv);
        gemm_phase((const bf16_t*)(ws + OFF_CKV), 128, (const bf16_t*)(ws + OFF_WUKV) + (size_t)l * 512 * 128, 128, 128, M_TOK, 512, smem,
                   EpiMlaKV{(bf16_t*)(ws + OFF_KB), (bf16_t*)(ws + OFF_VB), (const float*)(ws + OFF_SSCKV)}, wv);
        grid_bar(bar, myx, nloc, nx, ep, wv);
        attn_phase(p, l, lam_init, __int_as_float(__builtin_amdgcn_readfirstlane(__float_as_int((l == 0) ? 0.8f : 0.64449093240903016f))), smem, wv);
        grid_bar(bar, myx, nloc, nx, ep, wv);
        if (l == 0) gemm_phase((const bf16_t*)(ws + OFF_MIX), XLD, (const bf16_t*)(ws + OFF_WOUT) + (size_t)l * 1024 * XLD, XLD, 1024, M_TOK, 1024, smem, EpiResid2<true>{p.x, XB, SSX}, wv);
        else gemm_phase((const bf16_t*)(ws + OFF_MIX), XLD, (const bf16_t*)(ws + OFF_WOUT) + (size_t)l * 1024 * XLD, XLD, 1024, M_TOK, 1024, smem, EpiResid2<false>{nullptr, XB, SSX}, wv);
        grid_bar(bar, myx, nloc, nx, ep, wv);
        up_conv_phase(XB, (const bf16_t*)(ws + OFF_WUP) + (size_t)l * DFF2 * XLD, SSX, p.conv_w + (size_t)l * 3 * DFF2, p.conv_b + (size_t)l * DFF2, (bf16_t*)(ws + OFF_ACT), smem, wv);
        grid_bar(bar, myx, nloc, nx, ep, wv);
        gemm_phase((const bf16_t*)(ws + OFF_ACT), ALD, (const bf16_t*)(ws + OFF_WDN) + (size_t)l * 1024 * ALD, ALD, DFF, M_TOK, 1024, smem, EpiResid2<false>{nullptr, XB, SSX}, wv);
        grid_bar(bar, myx, nloc, nx, ep, wv);
    }
    final_norm(XB, p.out, p.final_norm, SSX, wv);
}

extern "C" void kernel_launch(void* const* d_in, const int* in_sizes, int n_in, void* d_out, int out_size, void* d_ws, size_t ws_size, hipStream_t stream) {
    static int grid_blocks = 0;
    if (!grid_blocks) {
        int dev = 0, cus = 0, per_cu = 0;
        hipGetDevice(&dev);
        hipDeviceGetAttribute(&cus, hipDeviceAttributeMultiprocessorCount, dev);
        hipFuncSetAttribute((const void*)mega, hipFuncAttributeMaxDynamicSharedMemorySize, SMEM_TOTAL);
        hipOccupancyMaxActiveBlocksPerMultiprocessor(&per_cu, mega, NTHR, SMEM_TOTAL);
        if (per_cu > 1) per_cu = 1;
        if (per_cu < 1) per_cu = 1;
        grid_blocks = (cus * per_cu) & ~7;
    }
    Params p{};
    const float** pp = (const float**)&p;
    for (int i = 0; i < 21; ++i) pp[i] = (const float*)d_in[i];
    p.out = (float*)d_out;
    p.ws = (unsigned char*)d_ws;
    hipMemsetAsync((unsigned char*)d_ws + OFF_BAR, 0, GB_WORDS * 4, stream);
    void* args[] = {&p};
    hipError_t e = hipLaunchCooperativeKernel((void*)mega, dim3(grid_blocks), dim3(NTHR), args, SMEM_TOTAL, stream);
    if (e != hipSuccess) fprintf(stderr, "cooperative launch failed: %s (grid %d)\n", hipGetErrorString(e), grid_blocks);
}
```

```cpp
#include <hip/hip_runtime.h>
#include <hip/hip_cooperative_groups.h>
#include <stdint.h>
#include <math.h>
#include <stdio.h>
namespace cg = cooperative_groups;

typedef unsigned short bf16_t;
typedef short bf16x8 __attribute__((ext_vector_type(8)));
typedef short s16x4 __attribute__((ext_vector_type(4)));
typedef float f32x4 __attribute__((ext_vector_type(4)));
typedef float f32x16 __attribute__((ext_vector_type(16)));
typedef unsigned u32x4 __attribute__((ext_vector_type(4)));
typedef unsigned u32x2 __attribute__((ext_vector_type(2)));
typedef __bf16 bf2_t __attribute__((ext_vector_type(2)));
typedef float f32x2 __attribute__((ext_vector_type(2)));
#define DI __device__ __forceinline__

constexpr int M_TOK = 32768, SEQ = 4096, DM = 1024, INW = 1888, INWP = 2048, DFF = 2816, DFF2 = 5632;
constexpr float EPS = 1e-6f;
constexpr float LOG2E = 1.4426950408889634f;
constexpr int NTHR = 512, NWAVE = NTHR / 64;
constexpr int XLD = 1024 + 64, ALD = DFF + 64;

constexpr size_t SZ_WIN = (size_t)2 * INWP * XLD * 2, SZ_WUQ = (size_t)2 * 512 * 192 * 2, SZ_WUKV = (size_t)2 * 512 * 128 * 2,
                 SZ_WOUT = (size_t)2 * 1024 * XLD * 2, SZ_WUP = (size_t)2 * DFF2 * XLD * 2, SZ_WDN = (size_t)2 * 1024 * ALD * 2;
constexpr size_t OFF_WIN = 0, OFF_WUQ = OFF_WIN + SZ_WIN, OFF_WUKV = OFF_WUQ + SZ_WUQ, OFF_WOUT = OFF_WUKV + SZ_WUKV,
                 OFF_WUP = OFF_WOUT + SZ_WOUT, OFF_WDN = OFF_WUP + SZ_WUP, OFF_TAB = OFF_WDN + SZ_WDN, OFF_XB = OFF_TAB + 16384;
constexpr size_t OFF_SSX = OFF_XB + (size_t)M_TOK * XLD * 2, OFF_SSCQ = OFF_SSX + (size_t)M_TOK * 16 * 4, OFF_SSCKV = OFF_SSCQ + (size_t)M_TOK * 4 * 4,
                 OFF_BIG = OFF_SSCKV + (size_t)M_TOK * 2 * 4;
constexpr size_t OFF_QA = OFF_BIG, OFF_KA = OFF_QA + (size_t)M_TOK * 512 * 2,
                 OFF_VA = OFF_KA + (size_t)M_TOK * 128 * 2, OFF_CQ = OFF_VA + (size_t)M_TOK * 128 * 2, OFF_CKV = OFF_CQ + (size_t)M_TOK * 192 * 2,
                 OFF_QB = OFF_CKV + (size_t)M_TOK * 128 * 2, OFF_KB = OFF_QB + (size_t)M_TOK * 384 * 2, OFF_VB = OFF_KB + (size_t)M_TOK * 384 * 2,
                 OFF_QC = OFF_VB + (size_t)M_TOK * 256 * 2, OFF_KC = OFF_QC + (size_t)M_TOK * 256 * 2, OFF_VC = OFF_KC + (size_t)M_TOK * 256 * 2,
                 OFF_MIX = OFF_VC + (size_t)M_TOK * 256 * 2, OFF_END1 = OFF_MIX + (size_t)M_TOK * XLD * 2;
constexpr size_t OFF_ACT = OFF_BIG, OFF_END2 = OFF_ACT + (size_t)M_TOK * ALD * 2;
constexpr size_t OFF_BAR = ((OFF_END1 > OFF_END2 ? OFF_END1 : OFF_END2) + 255) & ~(size_t)255;
static_assert(OFF_BAR + 16384 <= (size_t)512 * 1024 * 1024, "workspace");

struct Params {
    const float *x, *norm_attn, *w_in, *qn_a, *kn_a, *qan_b, *w_uq, *kvn_b, *w_ukv, *lq1, *lk1, *lq2, *lk2, *subln, *w_out, *norm_ffn, *w_up,
        *conv_w, *conv_b, *w_down, *final_norm;
    float* out;
    unsigned char* ws;
};

DI unsigned pk2(float a, float b) { f32x2 v = {a, b}; bf2_t r = __builtin_convertvector(v, bf2_t); return __builtin_bit_cast(unsigned, r); }
DI void unpack8(u32x4 r, float* v) {
    v[0] = __uint_as_float(r.x << 16); v[1] = __uint_as_float(r.x & 0xffff0000u);
    v[2] = __uint_as_float(r.y << 16); v[3] = __uint_as_float(r.y & 0xffff0000u);
    v[4] = __uint_as_float(r.z << 16); v[5] = __uint_as_float(r.z & 0xffff0000u);
    v[6] = __uint_as_float(r.w << 16); v[7] = __uint_as_float(r.w & 0xffff0000u);
}
DI u32x4 pack8(const float* v) { u32x4 r; r.x = pk2(v[0], v[1]); r.y = pk2(v[2], v[3]); r.z = pk2(v[4], v[5]); r.w = pk2(v[6], v[7]); return r; }
DI int tid_opaque(int wv) { int t; asm volatile("v_mbcnt_lo_u32_b32 %0, -1, 0\n\tv_mbcnt_hi_u32_b32 %0, -1, %0" : "=v"(t)); return t | (wv << 6); }
DI int bid_opaque() { int b = blockIdx.x; asm volatile("" : "+s"(b)); return b; }
DI float shflx(float v, int mask, int lane) { return __int_as_float(__builtin_amdgcn_ds_bpermute((lane ^ mask) << 2, __float_as_int(v))); }
DI float wave_sum(float v, int lane) {
#pragma unroll
    for (int o = 32; o >= 1; o >>= 1) v += shflx(v, o, lane);
    return v;
}

template <bool UPPERM>
DI void prep_weight(const float* __restrict__ W, const float* __restrict__ gain, bf16_t* __restrict__ Wt, int ldw, int K, int N, int Npad, unsigned char* smem, int wv) {
    bf16_t* Ts = (bf16_t*)smem;
    const int tid = tid_opaque(wv);
    const int nkt = K / 64, ntile = (Npad / 64) * nkt;
    for (int t = bid_opaque(); t < ntile; t += gridDim.x) {
        const int n0 = (t / nkt) * 64, k0 = (t % nkt) * 64;
        int ns0 = n0;
        if (UPPERM) { const int j = n0 >> 8, r = n0 & 255; ns0 = (r < 128) ? (128 * j + r) : (DFF + 128 * j + r - 128); }
        const int kr = tid >> 4, nc = (tid & 15) * 4;
#pragma unroll
        for (int hh = 0; hh < 2; ++hh) {
            const int k = k0 + kr + 32 * hh;
            const float gk = gain ? gain[k] : 1.0f;
#pragma unroll
            for (int e = 0; e < 4; ++e) {
                const float v = (n0 + nc + e < N) ? W[(size_t)k * N + ns0 + nc + e] * gk : 0.f;
                Ts[(nc + e) * 72 + kr + 32 * hh] = (bf16_t)(pk2(v, 0.f) & 0xffffu);
            }
        }
        __syncthreads();
        { const int n = tid >> 3, kc = tid & 7; *(u32x4*)(Wt + (size_t)(n0 + n) * ldw + k0 + kc * 8) = *(const u32x4*)(Ts + n * 72 + kc * 8); }
        __syncthreads();
    }
}

DI void convert_x(const float* X, bf16_t* XB, float* SSX, int wv) {
    const int tid_ = tid_opaque(wv);
    const int lane = tid_ & 63, gw = bid_opaque() * NWAVE + (tid_ >> 6), nw = gridDim.x * NWAVE;
    for (int row = gw; row < M_TOK; row += nw) {
        const f32x4* xr = (const f32x4*)(X + (size_t)row * 1024);
        float ss = 0.f;
#pragma unroll
        for (int i = 0; i < 4; ++i) {
            const f32x4 v = xr[lane + 64 * i];
            ss += v[0] * v[0] + v[1] * v[1] + v[2] * v[2] + v[3] * v[3];
            u32x2 w; w.x = pk2(v[0], v[1]); w.y = pk2(v[2], v[3]);
            *(u32x2*)(XB + (size_t)row * XLD + (lane + 64 * i) * 4) = w;
        }
        ss = wave_sum(ss, lane);
        if (lane < 16) SSX[(size_t)row * 16 + lane] = (lane == 0) ? ss : 0.f;
    }
}
DI void final_norm(const bf16_t* XB, float* Out, const float* __restrict__ g, const float* SSX, int wv) {
    const int tid_ = tid_opaque(wv);
    const int lane = tid_ & 63, gw = bid_opaque() * NWAVE + (tid_ >> 6), nw = gridDim.x * NWAVE;
    for (int row = gw; row < M_TOK; row += nw) {
        float ss = (lane < 16) ? SSX[(size_t)row * 16 + lane] : 0.f;
        ss = wave_sum(ss, lane);
        const float rstd = rsqrtf(ss * (1.0f / 1024.0f) + EPS);
        f32x4* orow = (f32x4*)(Out + (size_t)row * 1024);
#pragma unroll
        for (int i = 0; i < 4; ++i) {
            const u32x2 w = *(const u32x2*)(XB + (size_t)row * XLD + (lane + 64 * i) * 4);
            f32x4 r; r[0] = __uint_as_float(w.x << 16); r[1] = __uint_as_float(w.x & 0xffff0000u); r[2] = __uint_as_float(w.y << 16); r[3] = __uint_as_float(w.y & 0xffff0000u);
            const f32x4 gv = ((const f32x4*)g)[lane + 64 * i];
            orow[lane + 64 * i] = r * rstd * gv;
        }
    }
}
DI float row_rstd(const float* ssx, int m) {
    const f32x4* pp = (const f32x4*)(ssx + (size_t)m * 16);
    const f32x4 a = (pp[0] + pp[1]) + (pp[2] + pp[3]);
    return rsqrtf(((a[0] + a[1]) + (a[2] + a[3])) * (1.0f / 1024.0f) + EPS);
}

constexpr int GSTR = 128, GOP = 256 * GSTR;
constexpr int SMEM_BYTES = 4 * GOP;
constexpr int SMEM_CONV = 256 * 264 * 2;
constexpr int SMEM_TOTAL = SMEM_CONV > SMEM_BYTES ? SMEM_CONV : SMEM_BYTES;

DI void gemm_mainloop(const bf16_t* __restrict__ Ab, const unsigned (&aoff)[4], const bool (&av)[4], const bf16_t* __restrict__ Bb, unsigned boff, int ldb, int nk, unsigned char* smem, f32x4 (&acc)[8][4], int tid) {
    const int lane = tid & 63, wid = tid >> 6, wr = wid >> 2, wc = wid & 3;
    const int lrow = tid >> 3, lc = tid & 7;
    u32x4 ra[4], rb[4];
#pragma unroll
    for (int i = 0; i < 8; ++i)
#pragma unroll
        for (int j = 0; j < 4; ++j) acc[i][j] = (f32x4){0.f, 0.f, 0.f, 0.f};
    const u32x4 zero4 = {0u, 0u, 0u, 0u};
#define G_LOAD(KT) { _Pragma("unroll") for (int i = 0; i < 4; ++i) { const u32x4 t_ = *(const u32x4*)((const unsigned char*)Ab + (size_t)(aoff[i] + (unsigned)((KT) * 128))); ra[i] = av[i] ? t_ : zero4; rb[i] = *(const u32x4*)((const unsigned char*)Bb + (size_t)(boff + (unsigned)(i * 128 * ldb) + (unsigned)((KT) * 128))); } }
#define G_WRITE(BUF) { int so_ = (BUF) * 2 * GOP + wboff; asm volatile("" : "+v"(so_)); unsigned char* wb_ = smem + so_; _Pragma("unroll") for (int i = 0; i < 4; ++i) { *(u32x4*)(wb_ + i * 64 * GSTR) = ra[i]; *(u32x4*)(wb_ + GOP + i * 64 * GSTR) = rb[i]; } }
    const int wboff = lrow * GSTR + ((lc ^ (lrow & 7)) << 4);
    const int foff = (lane & 15) * GSTR;
    const int fsw[2] = {(((lane >> 4)) ^ (lane & 7)) << 4, (((lane >> 4) + 4) ^ (lane & 7)) << 4};
    G_LOAD(0);
    G_WRITE(0);
    __syncthreads();
    for (int kt = 0; kt < nk; ++kt) {
        { const int kl = (kt + 1 < nk) ? kt + 1 : nk - 1; G_LOAD(kl); }
        const unsigned char* sa = smem + (kt & 1) * 2 * GOP + wr * 128 * GSTR + foff;
        const unsigned char* sb = smem + (kt & 1) * 2 * GOP + GOP + wc * 64 * GSTR + foff;
        int so_ = ((kt + 1) & 1) * 2 * GOP + wboff; asm volatile("" : "+v"(so_));
        unsigned char* wb_ = smem + so_;
#pragma unroll
        for (int kk = 0; kk < 2; ++kk) {
            bf16x8 af[8], bfr[4];
#pragma unroll
            for (int i = 0; i < 4; ++i) bfr[i] = *(const bf16x8*)(sb + i * 16 * GSTR + fsw[kk]);
#pragma unroll
            for (int i = 0; i < 8; ++i) af[i] = *(const bf16x8*)(sa + i * 16 * GSTR + fsw[kk]);
#pragma unroll
            for (int mi = 0; mi < 8; ++mi) {
#pragma unroll
                for (int ni = 0; ni < 4; ++ni) acc[mi][ni] = __builtin_amdgcn_mfma_f32_16x16x32_bf16(bfr[ni], af[mi], acc[mi][ni], 0, 0, 0);
                if (kk == 1) { if (mi < 4) *(u32x4*)(wb_ + mi * 64 * GSTR) = ra[mi]; else *(u32x4*)(wb_ + GOP + (mi - 4) * 64 * GSTR) = rb[mi - 4]; }
            }
        }
        __builtin_amdgcn_sched_group_barrier(0x008, 32, 0);
#pragma unroll
        for (int g = 0; g < 8; ++g) { __builtin_amdgcn_sched_group_barrier(0x008, 4, 0); __builtin_amdgcn_sched_group_barrier(0x200, 1, 0); }
        __syncthreads();
    }
#undef G_LOAD
#undef G_WRITE
}

template <class Epi>
DI void gemm_tile(const bf16_t* __restrict__ A, int lda, const bf16_t* __restrict__ Bt, int ldb, int K, int m0, int n0, unsigned char* smem, const Epi& epi, int wv) {
    const int tid = tid_opaque(wv), lane = tid & 63, wid = tid >> 6, wr = wid >> 2, wc = wid & 3;
    const int lrow = tid >> 3, lc = tid & 7;
    unsigned aoff[4];
    const bool av[4] = {true, true, true, true};
#pragma unroll
    for (int i = 0; i < 4; ++i) aoff[i] = (unsigned)((lrow + 64 * i) * lda + lc * 8) * 2u;
    const unsigned boff = (unsigned)(lrow * ldb + lc * 8) * 2u;
    f32x4 acc[8][4];
    gemm_mainloop(A + (size_t)m0 * lda, aoff, av, Bt + (size_t)n0 * ldb, boff, ldb, K / 64, smem, acc, tid);
    epi(acc, m0 + wr * 128, n0 + wc * 64, lane);
}

template <class Epi>
DI void gemm_phase(const bf16_t* A, int lda, const bf16_t* Bt, int ldb, int K, int Mrows, int Ncols, unsigned char* smem, const Epi& epi, int wv) {
    const int nN = Ncols / 256, nM = Mrows / 256;
    const int bid = bid_opaque(), G = gridDim.x;
    const int xcd = bid & 7, lb = bid >> 3, nlb = G >> 3, mper = nM >> 3, nloc = mper * nN;
    for (int j = lb; j < nloc; j += nlb) {
        const int g = j / (4 * nN), rem = j - g * 4 * nN;
        const int mt = xcd * mper + g * 4 + (rem & 3), nt = rem >> 2;
        gemm_tile(A, lda, Bt, ldb, K, mt * 256, nt * 256, smem, epi, wv);
    }
}

DI float dot4(f32x4 a) { return (a[0] * a[0] + a[1] * a[1]) + (a[2] * a[2] + a[3] * a[3]); }
DI void st4bf(bf16_t* dst, f32x4 v) { u32x2 w; w.x = pk2(v[0], v[1]); w.y = pk2(v[2], v[3]); *(u32x2*)dst = w; }

template <bool XIN_F32>
struct EpiResid2 {
    const float* Xin; bf16_t* XB; float* SSX;
    DI void operator()(const f32x4 (&acc)[8][4], int mb, int nb, int lane) const {
        const int q = lane >> 4;
#pragma unroll
        for (int mi = 0; mi < 8; ++mi) {
            const int m = mb + mi * 16 + (lane & 15);
            float ss = 0.f;
#pragma unroll
            for (int ni = 0; ni < 4; ++ni) {
                const int col = nb + ni * 16 + q * 4;
                bf16_t* xb = XB + (size_t)m * XLD + col;
                f32x4 r;
                if (XIN_F32) r = *(const f32x4*)(Xin + (size_t)m * 1024 + col);
                else { const u32x2 w = *(const u32x2*)xb; r[0] = __uint_as_float(w.x << 16); r[1] = __uint_as_float(w.x & 0xffff0000u); r[2] = __uint_as_float(w.y << 16); r[3] = __uint_as_float(w.y & 0xffff0000u); }
                r += acc[mi][ni];
                st4bf(xb, r);
                ss += dot4(r);
            }
            ss += shflx(ss, 16, lane); ss += shflx(ss, 32, lane);
            if (q == 0) SSX[(size_t)m * 16 + (nb >> 6)] = ss;
        }
    }
};

struct EpiInProj {
    const float *ssx, *tab, *gq, *gk;
    bf16_t *QA, *KA, *VA, *CQ, *CKV, *KB, *QC, *KC, *VC;
    float *sscq, *ssckv;
    DI void operator()(const f32x4 (&acc)[8][4], int mb, int nb, int lane) const {
        const int q = lane >> 4, ml = lane & 15;
        const float qsA = 0.125f * LOG2E, qsC = 0.17677669529663687f * LOG2E;
        if (nb < 640) {
            const bool isq = nb < 512;
            const int head = isq ? (nb >> 6) : ((nb - 512) >> 6);
            const float* g = isq ? gq : gk;
            f32x4 gv[4];
#pragma unroll
            for (int ni = 0; ni < 4; ++ni) gv[ni] = *(const f32x4*)(g + ni * 16 + q * 4);
#pragma unroll
            for (int mi = 0; mi < 8; ++mi) {
                const int m = mb + mi * 16 + ml, b = m >> 12, s = m & 4095;
                const float rs = row_rstd(ssx, m);
                f32x4 v[4];
                float ss = 0.f;
#pragma unroll
                for (int ni = 0; ni < 4; ++ni) { v[ni] = acc[mi][ni] * rs; ss += dot4(v[ni]); }
                ss += shflx(ss, 16, lane); ss += shflx(ss, 32, lane);
                const float r2 = rsqrtf(ss * (1.0f / 64.0f) + EPS);
#pragma unroll
                for (int ni = 0; ni < 4; ++ni) v[ni] = v[ni] * r2 * gv[ni];
                const float* tr = tab + (s >> 6) * 16 + q * 4;
                const float* tq = tab + (s & 63) * 16 + q * 4;
                const f32x4 c0 = *(const f32x4*)tr, s0 = *(const f32x4*)(tr + 1024), c1 = *(const f32x4*)tq, s1 = *(const f32x4*)(tq + 1024);
                f32x4 o0 = v[0] * c0 - v[1] * s0, o1 = v[1] * c0 + v[0] * s0, o2 = v[2] * c1 - v[3] * s1, o3 = v[3] * c1 + v[2] * s1;
                bf16_t* dst;
                if (isq) { o0 *= qsA; o1 *= qsA; o2 *= qsA; o3 *= qsA; dst = QA + ((size_t)(b * 8 + head) * SEQ + s) * 64 + q * 4; }
                else dst = KA + ((size_t)(b * 2 + head) * SEQ + s) * 64 + q * 4;
                st4bf(dst, o0); st4bf(dst + 16, o1); st4bf(dst + 32, o2); st4bf(dst + 48, o3);
            }
        } else if (nb < 768) {
            const int head = (nb - 640) >> 6;
#pragma unroll
            for (int mi = 0; mi < 8; ++mi) {
                const int m = mb + mi * 16 + ml, b = m >> 12, s = m & 4095;
                const float rs = row_rstd(ssx, m);
                bf16_t* dst = VA + ((size_t)(b * 2 + head) * SEQ + s) * 64 + q * 4;
#pragma unroll
                for (int ni = 0; ni < 4; ++ni) st4bf(dst + ni * 16, acc[mi][ni] * rs);
            }
        } else {
            const bool sq = nb < 1088;
#pragma unroll
            for (int mi = 0; mi < 8; ++mi) {
                const int m = mb + mi * 16 + ml, b = m >> 12, s = m & 4095;
                const float rs = row_rstd(ssx, m);
                float ss = 0.f;
#pragma unroll
                for (int ni = 0; ni < 4; ++ni) {
                    const int n16 = nb + ni * 16;
                    f32x4 v = acc[mi][ni] * rs;
                    if (n16 < 960) { st4bf(CQ + (size_t)m * 192 + (n16 - 768) + q * 4, v); ss += dot4(v); }
                    else if (n16 < 1088) { st4bf(CKV + (size_t)m * 128 + (n16 - 960) + q * 4, v); ss += dot4(v); }
                    else if (n16 < 1120) {
                        f32x4 pr;
#pragma unroll
                        for (int i = 0; i < 4; ++i) pr[i] = shflx(v[i], 32, lane);
                        const int pos = (n16 >= 1104) ? (s & 63) : (s >> 6);
                        const float* tc = tab + 2048 + pos * 8 + (q & 1) * 4;
                        const f32x4 c = *(const f32x4*)tc, sn = *(const f32x4*)(tc + 512);
                        const f32x4 o = (q < 2) ? (v * c - pr * sn) : (v * c + pr * sn);
#pragma unroll
                        for (int hh = 0; hh < 4; ++hh) st4bf(KB + ((size_t)(b * 4 + hh) * SEQ + s) * 96 + 64 + (n16 - 1088) + q * 4, o);
                    } else if (n16 < 1376) { const int c = n16 - 1120 + q * 4; st4bf(QC + ((size_t)(b * 4 + (c >> 6)) * SEQ + s) * 64 + (c & 63), v * qsC); }
                    else if (n16 < 1632) { const int c = n16 - 1376 + q * 4; st4bf(KC + ((size_t)(b * 4 + (c >> 6)) * SEQ + s) * 64 + (c & 63), v); }
                    else if (n16 < 1888) { const int c = n16 - 1632 + q * 4; st4bf(VC + ((size_t)(b * 4 + (c >> 6)) * SEQ + s) * 64 + (c & 63), v); }
                }
                if (sq) {
                    ss += shflx(ss, 16, lane); ss += shflx(ss, 32, lane);
                    if (q == 0) { if (nb < 960) sscq[(size_t)m * 4 + ((nb - 768) >> 6)] = ss; else ssckv[(size_t)m * 2 + ((nb - 960) >> 6)] = ss; }
                }
            }
        }
    }
};
struct EpiMlaQ {
    bf16_t* QB; const float* tab; const float* sscq; float qscale;
    DI void operator()(const f32x4 (&acc)[8][4], int mb, int nb, int lane) const {
#pragma unroll
        for (int mi = 0; mi < 8; ++mi) {
            const int m = mb + mi * 16 + (lane & 15), q = lane >> 4, b = m >> 12, s = m & 4095;
            const f32x4 sp = *(const f32x4*)(sscq + (size_t)m * 4);
            const float rs = rsqrtf((sp[0] + sp[1] + sp[2]) * (1.0f / 192.0f) + EPS) * qscale;
#pragma unroll
            for (int ni = 0; ni < 4; ++ni) {
                const int nt = nb + ni * 16;
                if (nt >= 384) continue;
                const int head = nt / 96, dt = nt - head * 96;
                f32x4 v = acc[mi][ni] * rs;
                f32x4 pr;
#pragma unroll
                for (int i = 0; i < 4; ++i) pr[i] = shflx(v[i], 32, lane);
                if (dt >= 64) {
                    const int pos = (dt >= 80) ? (s & 63) : (s >> 6);
                    const float* tc = tab + 2048 + pos * 8 + (q & 1) * 4;
                    const f32x4 c = *(const f32x4*)tc, sn = *(const f32x4*)(tc + 512);
                    v = (q < 2) ? (v * c - pr * sn) : (v * c + pr * sn);
                }
                st4bf(QB + ((size_t)(b * 4 + head) * SEQ + s) * 96 + dt + q * 4, v);
            }
        }
    }
};
struct EpiMlaKV {
    bf16_t* KB; bf16_t* VB; const float* ssckv;
    DI void operator()(const f32x4 (&acc)[8][4], int mb, int nb, int lane) const {
#pragma unroll
        for (int mi = 0; mi < 8; ++mi) {
            const int m = mb + mi * 16 + (lane & 15), b = m >> 12, s = m & 4095;
            const f32x2 sp = *(const f32x2*)(ssckv + (size_t)m * 2);
            const float rs = rsqrtf((sp[0] + sp[1]) * (1.0f / 128.0f) + EPS);
#pragma unroll
            for (int ni = 0; ni < 4; ++ni) {
                const int n = nb + ni * 16 + (lane >> 4) * 4;
                const int head = n >> 7, d = n & 127;
                const size_t rowi = (size_t)(b * 4 + head) * SEQ + s;
                if (d < 64) st4bf(KB + rowi * 96 + d, acc[mi][ni] * rs);
                else st4bf(VB + rowi * 64 + (d - 64), acc[mi][ni] * rs);
            }
        }
    }
};

DI void up_conv_tile(const bf16_t* __restrict__ XB, const bf16_t* __restrict__ Wt, const float* __restrict__ ssx, const float* __restrict__ cw, const float* __restrict__ cb,
                     bf16_t* __restrict__ ACT, int b, int jt, int nt, unsigned char* smem, int wv) {
    const int tid = tid_opaque(wv), lane = tid & 63, wid = tid >> 6, wr = wid >> 2, wc = wid & 3;
    const int lrow = tid >> 3, lc = tid & 7;
    const int tbase = jt * 254 - 1;
    unsigned aoff[4];
    bool av[4];
#pragma unroll
    for (int i = 0; i < 4; ++i) {
        const int tl = tbase + lrow + 64 * i;
        av[i] = (unsigned)tl < 4096u;
        const int tc = tl < 0 ? 0 : (tl > 4095 ? 4095 : tl);
        aoff[i] = (unsigned)(tc * XLD + lc * 8) * 2u;
    }
    const unsigned boff = (unsigned)(lrow * XLD + lc * 8) * 2u;
    f32x4 acc[8][4];
    gemm_mainloop(XB + (size_t)b * SEQ * XLD, aoff, av, Wt + (size_t)nt * 256 * XLD, boff, XLD, 16, smem, acc, tid);
    bf16_t* T = (bf16_t*)smem;
    constexpr int TLD = 264;
    {
        const int q = lane >> 4, ml = lane & 15;
#pragma unroll
        for (int mi = 0; mi < 8; ++mi) {
            const int il = wr * 128 + mi * 16 + ml, tl = tbase + il;
            const int tc = tl < 0 ? 0 : (tl > 4095 ? 4095 : tl);
            const float rs = row_rstd(ssx, b * SEQ + tc);
#pragma unroll
            for (int ni = 0; ni < 4; ++ni) st4bf(T + il * TLD + wc * 64 + ni * 16 + q * 4, acc[mi][ni] * rs);
        }
    }
    __syncthreads();
    {
        const int cq = tid & 31, rg = tid >> 5, ch = nt * 128 + cq * 4;
        const f32x4 wg0 = *(const f32x4*)(cw + ch), wg1 = *(const f32x4*)(cw + DFF2 + ch), wg2 = *(const f32x4*)(cw + 2 * DFF2 + ch), bg = *(const f32x4*)(cb + ch);
        const f32x4 wv0 = *(const f32x4*)(cw + DFF + ch), wv1 = *(const f32x4*)(cw + DFF2 + DFF + ch), wv2 = *(const f32x4*)(cw + 2 * DFF2 + DFF + ch), bv = *(const f32x4*)(cb + DFF + ch);
#define LD4(R, C) ({ const u32x2 w_ = *(const u32x2*)(T + (R) * TLD + (C)); f32x4 r_; r_[0] = __uint_as_float(w_.x << 16); r_[1] = __uint_as_float(w_.x & 0xffff0000u); r_[2] = __uint_as_float(w_.y << 16); r_[3] = __uint_as_float(w_.y & 0xffff0000u); r_; })
        const int r0 = rg * 16, rm = r0 > 0 ? r0 - 1 : 0;
        f32x4 gm = LD4(rm, cq * 4), vm = LD4(rm, 128 + cq * 4);
        f32x4 g0 = LD4(r0, cq * 4), v0 = LD4(r0, 128 + cq * 4);
#pragma unroll
        for (int rr = 0; rr < 16; ++rr) {
            const int r = r0 + rr, rp = r < 255 ? r + 1 : 255;
            const f32x4 gp = LD4(rp, cq * 4), vp = LD4(rp, 128 + cq * 4);
            const f32x4 gg = wg0 * gm + wg1 * g0 + wg2 * gp + bg;
            const f32x4 vv = wv0 * vm + wv1 * v0 + wv2 * vp + bv;
            f32x4 o;
#pragma unroll
            for (int e = 0; e < 4; ++e) o[e] = gg[e] * __builtin_amdgcn_rcpf(1.0f + __builtin_amdgcn_exp2f(-LOG2E * gg[e])) * vv[e];
            const int tl = tbase + r;
            if (r >= 1 && r <= 254 && tl <= 4095) st4bf(ACT + ((size_t)b * SEQ + tl) * ALD + ch, o);
            gm = g0; g0 = gp; vm = v0; v0 = vp;
        }
#undef LD4
    }
    __syncthreads();
}
DI void up_conv_phase(const bf16_t* XB, const bf16_t* Wt, const float* ssx, const float* cw, const float* cb, bf16_t* ACT, unsigned char* smem, int wv) {
    constexpr int NT = DFF / 128, MT = 17;
    const int bid = bid_opaque(), G = gridDim.x;
    const int xcd = bid & 7, lb = bid >> 3, nlb = G >> 3, nloc = MT * NT, full = (MT / 4) * 4 * NT, gs = MT - (MT / 4) * 4;
    for (int j = lb; j < nloc; j += nlb) {
        int jt, nt;
        if (j < full) { const int g = j / (4 * NT), rem = j - g * 4 * NT; jt = g * 4 + (rem & 3); nt = rem >> 2; }
        else { const int j2 = j - full; jt = (MT / 4) * 4 + j2 % gs; nt = j2 / gs; }
        up_conv_tile(XB, Wt, ssx, cw, cb, ACT, xcd, jt, nt, smem, wv);
    }
}

constexpr int ATT_STAGE = 64 * 208 + 8192;

template <int DQK, bool DIFF>
DI void attn_tile(const unsigned char* cur, int kt, f32x16 (&O)[DIFF ? 2 : 1][2], float (&mrun)[DIFF ? 2 : 1], float (&lsum)[DIFF ? 2 : 1], const bf16x8 (&qf)[DIFF ? 2 : 1][DIFF ? 2 : DQK / 16],
               int kfo, int vfo0, int vfo1, float qpos, float slope2, int h) {
    constexpr int NQT = DIFF ? 2 : 1, KS = DIFF ? 2 : DQK / 16, KSTR = DQK * 2 + 16;
        bf16x8 kfr[2][KS], vfr[2][2][2];
#pragma unroll
        for (int kh = 0; kh < 2; ++kh)
#pragma unroll
            for (int ks = 0; ks < KS; ++ks) kfr[kh][ks] = *(const bf16x8*)(cur + kfo + kh * 32 * KSTR + (ks * 16) * 2);
        if (!DIFF) {
#pragma unroll
            for (int kh = 0; kh < 2; ++kh)
#pragma unroll
                for (int s2 = 0; s2 < 2; ++s2)
#pragma unroll
                    for (int d = 0; d < 2; ++d) {
                        const unsigned char* va = cur + (d ? vfo1 : vfo0) + (kh * 32 + 16 * s2) * 128;
                        const s16x4 lo = __builtin_amdgcn_ds_read_tr16_b64_v4i16((__attribute__((address_space(3))) s16x4*)(va));
                        const s16x4 hi = __builtin_amdgcn_ds_read_tr16_b64_v4i16((__attribute__((address_space(3))) s16x4*)(va + 8 * 128));
                        vfr[kh][s2][d] = __builtin_shufflevector(lo, hi, 0, 1, 2, 3, 4, 5, 6, 7);
                    }
        }
        __builtin_amdgcn_sched_barrier(0);
#pragma unroll
        for (int qt = 0; qt < NQT; ++qt) {
            bf16x8 pf[2][2];
            f32x16 S[2];
#pragma unroll
            for (int kh = 0; kh < 2; ++kh) {
#pragma unroll
                for (int i = 0; i < 16; ++i) S[kh][i] = 0.f;
#pragma unroll
                for (int ks = 0; ks < KS; ++ks) S[kh] = __builtin_amdgcn_mfma_f32_32x32x16_bf16(kfr[kh][ks], qf[qt][ks], S[kh], 0, 0, 0);
            }
            if (DIFF && qt == 0) {
#pragma unroll
                for (int kh = 0; kh < 2; ++kh)
#pragma unroll
                    for (int ks = 0; ks < KS; ++ks) kfr[kh][ks] = *(const bf16x8*)(cur + kfo + kh * 32 * KSTR + (32 + ks * 16) * 2);
            }
            if (DIFF) {
                const float d0 = qpos - (float)(kt * 64 + 4 * h);
#pragma unroll
                for (int kh = 0; kh < 2; ++kh)
#pragma unroll
                    for (int i = 0; i < 16; ++i) S[kh][i] -= slope2 * fabsf(d0 - (float)(kh * 32 + (i & 3) + 8 * (i >> 2)));
            }
            float mx = __builtin_elementwise_maximum(S[0][0], S[1][0]);
#pragma unroll
            for (int i = 1; i < 16; ++i) mx = __builtin_elementwise_maximum(mx, __builtin_elementwise_maximum(S[0][i], S[1][i]));
            { const auto sw = __builtin_amdgcn_permlane32_swap(__float_as_uint(mx), __float_as_uint(mx), false, false); mx = __builtin_elementwise_maximum(__uint_as_float(sw[0]), __uint_as_float(sw[1])); }
            const float rel = mx - mrun[qt];
            const bool need = (rel > 8.0f) || (kt == 0 && rel < -8.0f);
            if (__builtin_amdgcn_ballot_w64(need) != 0ull) {
                const float delta = need ? rel : 0.f;
                const float alpha = (kt == 0) ? 1.0f : __builtin_amdgcn_exp2f(-delta);
                mrun[qt] += delta;
                lsum[qt] *= alpha;
#pragma unroll
                for (int d = 0; d < 2; ++d)
#pragma unroll
                    for (int i = 0; i < 16; ++i) O[qt][d][i] *= alpha;
            }
            float ps = 0.f;
            if (__builtin_amdgcn_ballot_w64(mrun[qt] != 0.f) != 0ull) {
#pragma unroll
                for (int kh = 0; kh < 2; ++kh)
#pragma unroll
                    for (int i = 0; i < 16; ++i) { const float pv = __builtin_amdgcn_exp2f(S[kh][i] - mrun[qt]); S[kh][i] = pv; ps += pv; }
            } else {
#pragma unroll
                for (int kh = 0; kh < 2; ++kh)
#pragma unroll
                    for (int i = 0; i < 16; ++i) { const float pv = __builtin_amdgcn_exp2f(S[kh][i]); S[kh][i] = pv; ps += pv; }
            }
            lsum[qt] += ps;
#pragma unroll
            for (int kh = 0; kh < 2; ++kh)
#pragma unroll
                for (int s2 = 0; s2 < 2; ++s2) {
                    u32x4 w;
                    w.x = pk2(S[kh][8 * s2 + 0], S[kh][8 * s2 + 1]); w.y = pk2(S[kh][8 * s2 + 2], S[kh][8 * s2 + 3]);
                    w.z = pk2(S[kh][8 * s2 + 4], S[kh][8 * s2 + 5]); w.w = pk2(S[kh][8 * s2 + 6], S[kh][8 * s2 + 7]);
                    pf[kh][s2] = __builtin_bit_cast(bf16x8, w);
                }
#pragma unroll
            for (int kh = 0; kh < 2; ++kh)
#pragma unroll
                for (int s2 = 0; s2 < 2; ++s2)
#pragma unroll
                    for (int d = 0; d < 2; ++d) {
                        if (DIFF) {
                            const unsigned char* va = cur + (d ? vfo1 : vfo0) + (kh * 32 + 16 * s2) * 128;
                            const s16x4 lo = __builtin_amdgcn_ds_read_tr16_b64_v4i16((__attribute__((address_space(3))) s16x4*)(va));
                            const s16x4 hi = __builtin_amdgcn_ds_read_tr16_b64_v4i16((__attribute__((address_space(3))) s16x4*)(va + 8 * 128));
                            vfr[kh][s2][d] = __builtin_shufflevector(lo, hi, 0, 1, 2, 3, 4, 5, 6, 7);
                        }
                        O[qt][d] = __builtin_amdgcn_mfma_f32_32x32x16_bf16(vfr[kh][s2][d], pf[kh][s2], O[qt][d], 0, 0, 0);
                    }
            if (DIFF) __builtin_amdgcn_sched_barrier(0);
        }
}

template <int DQK, bool DIFF>
DI void attn_unit(const bf16_t* __restrict__ Qg, const bf16_t* __restrict__ Kg, const bf16_t* __restrict__ Vg, int q0, bf16_t* __restrict__ outp,
                  float slope2, float lam, float outmul, const float* __restrict__ subln, unsigned char* smem, int wv) {
    constexpr int NQT = DIFF ? 2 : 1, KS = DIFF ? 2 : DQK / 16, KSTR = DQK * 2 + 16, CPR = DQK / 8, KCH = (64 * CPR + NTHR - 1) / NTHR, KBYTES = 64 * 208;
    const int tid = tid_opaque(wv), lane = tid & 63, wid = tid >> 6, r = lane & 31, h = lane >> 5;
    const int qrow = q0 + wid * 32 + r;
    bf16x8 qf[NQT][KS];
#pragma unroll
    for (int qt = 0; qt < NQT; ++qt)
#pragma unroll
        for (int ks = 0; ks < KS; ++ks) qf[qt][ks] = *(const bf16x8*)(Qg + (size_t)qrow * DQK + qt * 32 + ks * 16 + h * 8);
    f32x16 O[NQT][2];
    float mrun[NQT], lsum[NQT];
#pragma unroll
    for (int qt = 0; qt < NQT; ++qt) {
        mrun[qt] = 0.f; lsum[qt] = 0.f;
#pragma unroll
        for (int d = 0; d < 2; ++d)
#pragma unroll
            for (int i = 0; i < 16; ++i) O[qt][d][i] = 0.f;
    }
    int koff[KCH], voff;
    bool kval[KCH];
#pragma unroll
    for (int i = 0; i < KCH; ++i) { const int id = tid + NTHR * i, key = id / CPR, c = id % CPR; koff[i] = key * KSTR + c * 16; kval[i] = id < 64 * CPR; }
    { const int key = tid >> 3, c = tid & 7; voff = KBYTES + key * 128 + ((c ^ (((key >> 1) & 1) << 2)) * 16); }
    u32x4 rk[KCH], rv;
#pragma unroll
    for (int i = 0; i < KCH; ++i) if (kval[i]) rk[i] = *(const u32x4*)(Kg + (size_t)(tid + NTHR * i) * 8);
    rv = *(const u32x4*)(Vg + (size_t)tid * 8);
#pragma unroll
    for (int i = 0; i < KCH; ++i) if (kval[i]) *(u32x4*)(smem + koff[i]) = rk[i];
    *(u32x4*)(smem + voff) = rv;
    __syncthreads();
    const int kfo = r * KSTR + h * 16;
    const int qq = (lane >> 2) & 3;
    const int colb0 = ((qq >> 1) & 1) * 64 + 32 * ((lane >> 4) & 1) + 8 * (lane & 3);
    const int vfo0 = KBYTES + (4 * h + qq) * 128 + colb0, vfo1 = KBYTES + (4 * h + qq) * 128 + (colb0 ^ 64);
    const float qpos = (float)qrow;

    u32x4 rk2[KCH], rv2;
#define AT_LOAD(RK, RV, T) { const int tn_ = (T) < SEQ / 64 ? (T) : SEQ / 64 - 1; _Pragma("unroll") for (int i = 0; i < KCH; ++i) RK[i] = *(const u32x4*)(Kg + (size_t)tn_ * 64 * DQK + (size_t)(kval[i] ? tid + NTHR * i : tid) * 8);     RV = *(const u32x4*)(Vg + (size_t)tn_ * 64 * 64 + (size_t)tid * 8); }
#define AT_WRITE(RK, RV, SO) { _Pragma("unroll") for (int i = 0; i < KCH; ++i) if (kval[i]) *(u32x4*)(smem + (SO) + koff[i]) = RK[i]; *(u32x4*)(smem + (SO) + voff) = RV; }
    AT_LOAD(rk2, rv2, 1);
    for (int kt = 0; kt < SEQ / 64; kt += 2) {
        AT_LOAD(rk, rv, kt + 2);
        attn_tile<DQK, DIFF>(smem, kt, O, mrun, lsum, qf, kfo, vfo0, vfo1, qpos, slope2, h);
        AT_WRITE(rk2, rv2, ATT_STAGE);
        __syncthreads();
        AT_LOAD(rk2, rv2, kt + 3);
        attn_tile<DQK, DIFF>(smem + ATT_STAGE, kt + 1, O, mrun, lsum, qf, kfo, vfo0, vfo1, qpos, slope2, h);
        AT_WRITE(rk, rv, 0);
        __syncthreads();
    }
#undef AT_LOAD
#undef AT_WRITE
    const int tid2 = tid_opaque(wv), lane2 = tid2 & 63;
    const int h2 = lane2 >> 5;
    float inv[NQT];
#pragma unroll
    for (int qt = 0; qt < NQT; ++qt) { const float lt = lsum[qt] + shflx(lsum[qt], 32, lane2); inv[qt] = 1.0f / lt; }
    float o[2][16];
    if (DIFF) {
        float ss = 0.f;
#pragma unroll
        for (int d = 0; d < 2; ++d)
#pragma unroll
            for (int i = 0; i < 16; ++i) { const float x = O[0][d][i] * inv[0] - lam * (O[NQT - 1][d][i] * inv[NQT - 1]); o[d][i] = x; ss += x * x; }
        ss += shflx(ss, 32, lane2);
        const float rstd = rsqrtf(ss * (1.0f / 64.0f) + EPS) * outmul;
#pragma unroll
        for (int d = 0; d < 2; ++d)
#pragma unroll
            for (int i = 0; i < 16; ++i) o[d][i] *= rstd * subln[d * 32 + (i & 3) + 8 * (i >> 2) + 4 * h2];
    } else {
#pragma unroll
        for (int d = 0; d < 2; ++d)
#pragma unroll
            for (int i = 0; i < 16; ++i) o[d][i] = O[0][d][i] * inv[0];
    }
    const int qrow2 = q0 + (lane2 & 31) + ((tid2 >> 6) << 5);
    bf16_t* orow = outp + (size_t)qrow2 * XLD;
#pragma unroll
    for (int d = 0; d < 2; ++d)
#pragma unroll
        for (int g = 0; g < 4; ++g) {
            u32x2 w; w.x = pk2(o[d][4 * g], o[d][4 * g + 1]); w.y = pk2(o[d][4 * g + 2], o[d][4 * g + 3]);
            *(u32x2*)(orow + d * 32 + 8 * g + 4 * h2) = w;
        }
}

DI void attn_phase(const Params& p, int layer, float lam_init, float outmul, unsigned char* smem, int wv) {
    unsigned char* ws = p.ws;
    const bf16_t *QA = (const bf16_t*)(ws + OFF_QA), *KA = (const bf16_t*)(ws + OFF_KA), *VA = (const bf16_t*)(ws + OFF_VA), *QB = (const bf16_t*)(ws + OFF_QB),
                 *KB = (const bf16_t*)(ws + OFF_KB), *VB = (const bf16_t*)(ws + OFF_VB), *QC = (const bf16_t*)(ws + OFF_QC), *KC = (const bf16_t*)(ws + OFF_KC),
                 *VC = (const bf16_t*)(ws + OFF_VC);
    bf16_t* MIX = (bf16_t*)(ws + OFF_MIX);
    float s1 = 0.f, s2 = 0.f;
    for (int j = 0; j < 32; ++j) { s1 += p.lq1[layer * 32 + j] * p.lk1[layer * 32 + j]; s2 += p.lq2[layer * 32 + j] * p.lk2[layer * 32 + j]; }
    const float lam = __int_as_float(__builtin_amdgcn_readfirstlane(__float_as_int(expf(s1) - expf(s2) + lam_init)));
    for (int v = bid_opaque(); v < 2048; v += gridDim.x) {
        const int base = v & ~255, i = v & 255, j = i >> 3;
        const int u = base + ((i & 7) * 2 + (j >> 4)) * 16 + (j & 15);
        if (u < 512) {
            const int qb = u & 15, hh = (u >> 4) & 3, b = u >> 6;
            const size_t ro = (size_t)(b * 4 + hh) * SEQ * 64;
            const float slope2 = __int_as_float(__builtin_amdgcn_readfirstlane(__float_as_int(exp2f(-2.0f * (float)(hh + 1)) * LOG2E)));
            attn_unit<64, true>(QC + ro, KC + ro, VC + ro, qb * 256, MIX + (size_t)b * SEQ * XLD + 768 + hh * 64, slope2, lam, outmul,
                                p.subln + layer * 64, smem, wv);
        } else if (u < 1024) {
            const int w = u - 512, qb = w & 15, hh = (w >> 4) & 3, b = w >> 6;
            const size_t rq = (size_t)(b * 4 + hh) * SEQ;
            attn_unit<96, false>(QB + rq * 96, KB + rq * 96, VB + rq * 64, qb * 256, MIX + (size_t)b * SEQ * XLD + 512 + hh * 64, 0.f, 0.f, 0.f, nullptr, smem, wv);
        } else {
            const int w = u - 1024, qb = w & 15, hh = (w >> 4) & 7, b = w >> 7;
            const size_t rq = (size_t)(b * 8 + hh) * SEQ, rk = (size_t)(b * 2 + (hh >> 2)) * SEQ;
            attn_unit<64, false>(QA + rq * 64, KA + rk * 64, VA + rk * 64, qb * 256, MIX + (size_t)b * SEQ * XLD + hh * 64, 0.f, 0.f, 0.f, nullptr, smem, wv);
        }
    }
}

#define GB_XCNT(j) (64 * (j))
#define GB_XSUB(j) (1024 + 64 * (j))
#define GB_XGEN(j) (2048 + 64 * (j))
#define GB_TOP 3072
#define GB_TOPGEN 3136
constexpr int GB_WORDS = 3200;
DI unsigned gb_ld(unsigned* p) { return __hip_atomic_load(p, __ATOMIC_RELAXED, __HIP_MEMORY_SCOPE_AGENT); }
DI unsigned gb_add(unsigned* p) { return __hip_atomic_fetch_add(p, 1u, __ATOMIC_RELAXED, __HIP_MEMORY_SCOPE_AGENT); }
DI unsigned gb_xcc() { return (unsigned)__builtin_amdgcn_s_getreg((3 << 11) | 20) & 0xFu; }
#define GB_SPIN(cond) { unsigned sp_ = 0; while (cond) { __builtin_amdgcn_s_sleep(1); if (++sp_ > (1u << 24)) break; } }
DI void grid_bar(unsigned* bar, unsigned x, unsigned nloc, unsigned nx, unsigned& ep, int wv) {
    asm volatile("s_waitcnt vmcnt(0)" ::: "memory");
    __syncthreads();
    asm volatile("" : "+s"(nloc), "+s"(nx), "+s"(x));
    unsigned epl = ep; asm volatile("" : "+s"(epl));
    if (tid_opaque(wv) == 0) {
        const unsigned old = gb_add(&bar[GB_XSUB(x)]);
        if (old + 1u == (epl + 1u) * nloc) {
            __builtin_amdgcn_fence(__ATOMIC_RELEASE, "agent");
            asm volatile("s_waitcnt vmcnt(0)" ::: "memory");
            const unsigned og = gb_add(&bar[GB_TOP]);
            if (og + 1u == (epl + 1u) * nx) gb_add(&bar[GB_TOPGEN]);
            else GB_SPIN(gb_ld(&bar[GB_TOPGEN]) == epl);
            __builtin_amdgcn_fence(__ATOMIC_ACQUIRE, "agent");
            gb_add(&bar[GB_XGEN(x)]);
            asm volatile("s_waitcnt vmcnt(0)" ::: "memory");
        } else {
            GB_SPIN(gb_ld(&bar[GB_XGEN(x)]) == epl);
            __builtin_amdgcn_fence(__ATOMIC_ACQUIRE, "agent");
            asm volatile("s_waitcnt vmcnt(0)" ::: "memory");
        }
    }
    ep += 1u;
    __syncthreads();
}

__global__ void __launch_bounds__(NTHR, 2) mega(Params p) {
    extern __shared__ __attribute__((aligned(16))) unsigned char smem[];
    cg::grid_group grid = cg::this_grid();
    unsigned char* ws = p.ws;
    const int gtid = blockIdx.x * NTHR + threadIdx.x, gthreads = gridDim.x * NTHR;
    const int wv = __builtin_amdgcn_readfirstlane((int)(threadIdx.x >> 6));
    bf16_t* XB = (bf16_t*)(ws + OFF_XB);
    float* SSX = (float*)(ws + OFF_SSX);
    float* tab = (float*)(ws + OFF_TAB);

    unsigned* bar = (unsigned*)(ws + OFF_BAR);
    const unsigned myx = gb_xcc();
    if (threadIdx.x == 0) gb_add(&bar[GB_XCNT(myx)]);
    for (int l = 0; l < 2; ++l) {
        prep_weight<false>(p.w_in + (size_t)l * 1024 * INW, p.norm_attn + l * 1024, (bf16_t*)(ws + OFF_WIN) + (size_t)l * INWP * XLD, XLD, 1024, INW, INWP, smem, wv);
        prep_weight<false>(p.w_uq + (size_t)l * 192 * 384, p.qan_b + l * 192, (bf16_t*)(ws + OFF_WUQ) + (size_t)l * 512 * 192, 192, 192, 384, 512, smem, wv);
        prep_weight<false>(p.w_ukv + (size_t)l * 128 * 512, p.kvn_b + l * 128, (bf16_t*)(ws + OFF_WUKV) + (size_t)l * 512 * 128, 128, 128, 512, 512, smem, wv);
        prep_weight<false>(p.w_out + (size_t)l * 1024 * 1024, nullptr, (bf16_t*)(ws + OFF_WOUT) + (size_t)l * 1024 * XLD, XLD, 1024, 1024, 1024, smem, wv);
        prep_weight<true>(p.w_up + (size_t)l * 1024 * DFF2, p.norm_ffn + l * 1024, (bf16_t*)(ws + OFF_WUP) + (size_t)l * DFF2 * XLD, XLD, 1024, DFF2, DFF2, smem, wv);
        prep_weight<false>(p.w_down + (size_t)l * DFF * 1024, nullptr, (bf16_t*)(ws + OFF_WDN) + (size_t)l * 1024 * ALD, ALD, DFF, 1024, 1024, smem, wv);
    }
    for (int idx = gtid; idx < 1024 + 512; idx += gthreads) {
        if (idx < 1024) { const int pos = idx >> 4, f = idx & 15; const float ang = (float)pos * powf(10000.0f, -(float)f / 16.0f); tab[idx] = cosf(ang); tab[1024 + idx] = sinf(ang); }
        else { const int k = idx - 1024, pos = k >> 3, f = k & 7; const float ang = (float)pos * powf(10000.0f, -(float)f / 8.0f); tab[2048 + k] = cosf(ang); tab[2560 + k] = sinf(ang); }
    }
    convert_x(p.x, XB, SSX, wv);
    grid.sync();

    unsigned nloc = 1u, nx = 0u, ep = 0u;
    for (unsigned j = 0; j < 16; ++j) { const unsigned c = gb_ld(&bar[GB_XCNT(j)]); nx += (c > 0u) ? 1u : 0u; nloc = (j == myx) ? c : nloc; }
    nloc = __builtin_amdgcn_readfirstlane(nloc > 0u ? nloc : 1u); nx = __builtin_amdgcn_readfirstlane(nx > 0u ? nx : 1u);
    for (int l = 0; l < 2; ++l) {
        const float lam_init = __int_as_float(__builtin_amdgcn_readfirstlane(__float_as_int((l == 0) ? 0.2f : 0.35550906759096984f)));
        gemm_phase(XB, XLD, (const bf16_t*)(ws + OFF_WIN) + (size_t)l * INWP * XLD, XLD, 1024, M_TOK, INWP, smem,
                   EpiInProj{SSX, tab, p.qn_a + l * 64, p.kn_a + l * 64, (bf16_t*)(ws + OFF_QA), (bf16_t*)(ws + OFF_KA), (bf16_t*)(ws + OFF_VA), (bf16_t*)(ws + OFF_CQ),
                             (bf16_t*)(ws + OFF_CKV), (bf16_t*)(ws + OFF_KB), (bf16_t*)(ws + OFF_QC), (bf16_t*)(ws + OFF_KC), (bf16_t*)(ws + OFF_VC),
                             (float*)(ws + OFF_SSCQ), (float*)(ws + OFF_SSCKV)}, wv);
        grid_bar(bar, myx, nloc, nx, ep, wv);
        gemm_phase((const bf16_t*)(ws + OFF_CQ), 192, (const bf16_t*)(ws + OFF_WUQ) + (size_t)l * 512 * 192, 192, 192, M_TOK, 512, smem,
                   EpiMlaQ{(bf16_t*)(ws + OFF_QB), tab, (const float*)(ws + OFF_SSCQ), 0.10206207261596575f * LOG2E}, wv);
        gemm_phase((const bf16_t*)(ws + OFF_CKV), 128, (const bf16_t*)(ws + OFF_WUKV) + (size_t)l * 512 * 128, 128, 128, M_TOK, 512, smem,
                   EpiMlaKV{(bf16_t*)(ws + OFF_KB), (bf16_t*)(ws + OFF_VB), (const float*)(ws + OFF_SSCKV)}, wv);
        grid_bar(bar, myx, nloc, nx, ep, wv);
        attn_phase(p, l, lam_init, __int_as_float(__builtin_amdgcn_readfirstlane(__float_as_int((l == 0) ? 0.8f : 0.64449093240903016f))), smem, wv);
        grid_bar(bar, myx, nloc, nx, ep, wv);
        if (l == 0) gemm_phase((const bf16_t*)(ws + OFF_MIX), XLD, (const bf16_t*)(ws + OFF_WOUT) + (size_t)l * 1024 * XLD, XLD, 1024, M_TOK, 1024, smem, EpiResid2<true>{p.x, XB, SSX}, wv);
        else gemm_phase((const bf16_t*)(ws + OFF_MIX), XLD, (const bf16_t*)(ws + OFF_WOUT) + (size_t)l * 1024 * XLD, XLD, 1024, M_TOK, 1024, smem, EpiResid2<false>{nullptr, XB, SSX}, wv);
        grid_bar(bar, myx, nloc, nx, ep, wv);
        up_conv_phase(XB, (const bf16_t*)(ws + OFF_WUP) + (size_t)l * DFF2 * XLD, SSX, p.conv_w + (size_t)l * 3 * DFF2, p.conv_b + (size_t)l * DFF2, (bf16_t*)(ws + OFF_ACT), smem, wv);
        grid_bar(bar, myx, nloc, nx, ep, wv);
        gemm_phase((const bf16_t*)(ws + OFF_ACT), ALD, (const bf16_t*)(ws + OFF_WDN) + (size_t)l * 1024 * ALD, ALD, DFF, M_TOK, 1024, smem, EpiResid2<false>{nullptr, XB, SSX}, wv);
        grid_bar(bar, myx, nloc, nx, ep, wv);
    }
    final_norm(XB, p.out, p.final_norm, SSX, wv);
}

extern "C" void kernel_launch(void* const* d_in, const int* in_sizes, int n_in, void* d_out, int out_size, void* d_ws, size_t ws_size, hipStream_t stream) {
    static int grid_blocks = 0;
    if (!grid_blocks) {
        int dev = 0, cus = 0, per_cu = 0;
        hipGetDevice(&dev);
        hipDeviceGetAttribute(&cus, hipDeviceAttributeMultiprocessorCount, dev);
        hipFuncSetAttribute((const void*)mega, hipFuncAttributeMaxDynamicSharedMemorySize, SMEM_TOTAL);
        hipOccupancyMaxActiveBlocksPerMultiprocessor(&per_cu, mega, NTHR, SMEM_TOTAL);
        if (per_cu > 1) per_cu = 1;
        if (per_cu < 1) per_cu = 1;
        grid_blocks = (cus * per_cu) & ~7;
    }
    Params p{};
    const float** pp = (const float**)&p;
    for (int i = 0; i < 21; ++i) pp[i] = (const float*)d_in[i];
    p.out = (float*)d_out;
    p.ws = (unsigned char*)d_ws;
    hipMemsetAsync((unsigned char*)d_ws + OFF_BAR, 0, GB_WORDS * 4, stream);
    void* args[] = {&p};
    hipError_t e = hipLaunchCooperativeKernel((void*)mega, dim3(grid_blocks), dim3(NTHR), args, SMEM_TOTAL, stream);
    if (e != hipSuccess) fprintf(stderr, "cooperative launch failed: %s (grid %d)\n", hipGetErrorString(e), grid_blocks);
}
```

```cpp
#include <hip/hip_runtime.h>
#include <hip/hip_cooperative_groups.h>
#include <stdint.h>
#include <math.h>
#include <stdio.h>
namespace cg = cooperative_groups;

typedef unsigned short bf16_t;
typedef short bf16x8 __attribute__((ext_vector_type(8)));
typedef short s16x4 __attribute__((ext_vector_type(4)));
typedef float f32x4 __attribute__((ext_vector_type(4)));
typedef float f32x16 __attribute__((ext_vector_type(16)));
typedef unsigned u32x4 __attribute__((ext_vector_type(4)));
typedef unsigned u32x2 __attribute__((ext_vector_type(2)));
typedef __bf16 bf2_t __attribute__((ext_vector_type(2)));
typedef float f32x2 __attribute__((ext_vector_type(2)));
#define DI __device__ __forceinline__

constexpr int M_TOK = 32768, SEQ = 4096, DM = 1024, INW = 1888, INWP = 2048, DFF = 2816, DFF2 = 5632;
constexpr float EPS = 1e-6f;
constexpr float LOG2E = 1.4426950408889634f;
constexpr int NTHR = 512, NWAVE = NTHR / 64;
constexpr int XLD = 1024 + 64, ALD = DFF + 64;

constexpr size_t SZ_WIN = (size_t)2 * INWP * XLD * 2, SZ_WUQ = (size_t)2 * 512 * 192 * 2, SZ_WUKV = (size_t)2 * 512 * 128 * 2,
                 SZ_WOUT = (size_t)2 * 1024 * XLD * 2, SZ_WUP = (size_t)2 * DFF2 * XLD * 2, SZ_WDN = (size_t)2 * 1024 * ALD * 2;
constexpr size_t OFF_WIN = 0, OFF_WUQ = OFF_WIN + SZ_WIN, OFF_WUKV = OFF_WUQ + SZ_WUQ, OFF_WOUT = OFF_WUKV + SZ_WUKV,
                 OFF_WUP = OFF_WOUT + SZ_WOUT, OFF_WDN = OFF_WUP + SZ_WUP, OFF_TAB = OFF_WDN + SZ_WDN, OFF_XB = OFF_TAB + 16384;
constexpr size_t OFF_SSX = OFF_XB + (size_t)M_TOK * XLD * 2, OFF_SSCQ = OFF_SSX + (size_t)M_TOK * 16 * 4, OFF_SSCKV = OFF_SSCQ + (size_t)M_TOK * 4 * 4,
                 OFF_BIG = OFF_SSCKV + (size_t)M_TOK * 2 * 4;
constexpr size_t OFF_QA = OFF_BIG, OFF_KA = OFF_QA + (size_t)M_TOK * 512 * 2,
                 OFF_VA = OFF_KA + (size_t)M_TOK * 128 * 2, OFF_CQ = OFF_VA + (size_t)M_TOK * 128 * 2, OFF_CKV = OFF_CQ + (size_t)M_TOK * 192 * 2,
                 OFF_QB = OFF_CKV + (size_t)M_TOK * 128 * 2, OFF_KB = OFF_QB + (size_t)M_TOK * 384 * 2, OFF_VB = OFF_KB + (size_t)M_TOK * 384 * 2,
                 OFF_QC = OFF_VB + (size_t)M_TOK * 256 * 2, OFF_KC = OFF_QC + (size_t)M_TOK * 256 * 2, OFF_VC = OFF_KC + (size_t)M_TOK * 256 * 2,
                 OFF_MIX = OFF_VC + (size_t)M_TOK * 256 * 2, OFF_END1 = OFF_MIX + (size_t)M_TOK * XLD * 2;
constexpr size_t OFF_ACT = OFF_BIG, OFF_END2 = OFF_ACT + (size_t)M_TOK * ALD * 2;
constexpr size_t OFF_BAR = ((OFF_END1 > OFF_END2 ? OFF_END1 : OFF_END2) + 255) & ~(size_t)255;
static_assert(OFF_BAR + 16384 <= (size_t)512 * 1024 * 1024, "workspace");

struct Params {
    const float *x, *norm_attn, *w_in, *qn_a, *kn_a, *qan_b, *w_uq, *kvn_b, *w_ukv, *lq1, *lk1, *lq2, *lk2, *subln, *w_out, *norm_ffn, *w_up,
        *conv_w, *conv_b, *w_down, *final_norm;
    float* out;
    unsigned char* ws;
};

DI unsigned pk2(float a, float b) { f32x2 v = {a, b}; bf2_t r = __builtin_convertvector(v, bf2_t); return __builtin_bit_cast(unsigned, r); }
DI void unpack8(u32x4 r, float* v) {
    v[0] = __uint_as_float(r.x << 16); v[1] = __uint_as_float(r.x & 0xffff0000u);
    v[2] = __uint_as_float(r.y << 16); v[3] = __uint_as_float(r.y & 0xffff0000u);
    v[4] = __uint_as_float(r.z << 16); v[5] = __uint_as_float(r.z & 0xffff0000u);
    v[6] = __uint_as_float(r.w << 16); v[7] = __uint_as_float(r.w & 0xffff0000u);
}
DI u32x4 pack8(const float* v) { u32x4 r; r.x = pk2(v[0], v[1]); r.y = pk2(v[2], v[3]); r.z = pk2(v[4], v[5]); r.w = pk2(v[6], v[7]); return r; }
DI int tid_opaque(int wv) { int t; asm volatile("v_mbcnt_lo_u32_b32 %0, -1, 0\n\tv_mbcnt_hi_u32_b32 %0, -1, %0" : "=v"(t)); return t | (wv << 6); }
DI int bid_opaque() { int b = blockIdx.x; asm volatile("" : "+s"(b)); return b; }
DI float shflx(float v, int mask, int lane) { return __int_as_float(__builtin_amdgcn_ds_bpermute((lane ^ mask) << 2, __float_as_int(v))); }
DI float wave_sum(float v, int lane) {
#pragma unroll
    for (int o = 32; o >= 1; o >>= 1) v += shflx(v, o, lane);
    return v;
}

template <bool UPPERM>
DI void prep_weight(const float* __restrict__ W, const float* __restrict__ gain, bf16_t* __restrict__ Wt, int ldw, int K, int N, int Npad, unsigned char* smem, int wv) {
    bf16_t* Ts = (bf16_t*)smem;
    const int tid = tid_opaque(wv);
    const int nkt = K / 64, ntile = (Npad / 64) * nkt;
    for (int t = bid_opaque(); t < ntile; t += gridDim.x) {
        const int n0 = (t / nkt) * 64, k0 = (t % nkt) * 64;
        int ns0 = n0;
        if (UPPERM) { const int j = n0 >> 8, r = n0 & 255; ns0 = (r < 128) ? (128 * j + r) : (DFF + 128 * j + r - 128); }
        const int kr = tid >> 4, nc = (tid & 15) * 4;
        if (n0 + 64 <= N) {
            f32x4 v4[2];
#pragma unroll
            for (int hh = 0; hh < 2; ++hh) v4[hh] = *(const f32x4*)(W + (size_t)(k0 + kr + 32 * hh) * N + ns0 + nc);
#pragma unroll
            for (int hh = 0; hh < 2; ++hh) {
                const float gk = gain ? gain[k0 + kr + 32 * hh] : 1.0f;
#pragma unroll
                for (int e = 0; e < 4; ++e) Ts[(nc + e) * 72 + kr + 32 * hh] = (bf16_t)(pk2(v4[hh][e] * gk, 0.f) & 0xffffu);
            }
        } else {
#pragma unroll
        for (int hh = 0; hh < 2; ++hh) {
            const int k = k0 + kr + 32 * hh;
            const float gk = gain ? gain[k] : 1.0f;
#pragma unroll
            for (int e = 0; e < 4; ++e) {
                const float v = (n0 + nc + e < N) ? W[(size_t)k * N + ns0 + nc + e] * gk : 0.f;
                Ts[(nc + e) * 72 + kr + 32 * hh] = (bf16_t)(pk2(v, 0.f) & 0xffffu);
            }
        }
        }
        __syncthreads();
        { const int n = tid >> 3, kc = tid & 7; *(u32x4*)(Wt + (size_t)(n0 + n) * ldw + k0 + kc * 8) = *(const u32x4*)(Ts + n * 72 + kc * 8); }
        __syncthreads();
    }
}

DI void convert_x(const float* X, bf16_t* XB, float* SSX, int wv) {
    const int tid_ = tid_opaque(wv);
    const int lane = tid_ & 63, gw = bid_opaque() * NWAVE + (tid_ >> 6), nw = gridDim.x * NWAVE;
    constexpr int RB = 4;
    for (int row0 = gw; row0 < M_TOK; row0 += RB * nw) {
        f32x4 v[RB][4];
#pragma unroll
        for (int rr = 0; rr < RB; ++rr) {
            const int row = row0 + rr * nw;
            const f32x4* xr = (const f32x4*)(X + (size_t)(row < M_TOK ? row : row0) * 1024);
#pragma unroll
            for (int i = 0; i < 4; ++i) v[rr][i] = xr[lane + 64 * i];
        }
#pragma unroll
        for (int rr = 0; rr < RB; ++rr) {
            const int row = row0 + rr * nw;
            if (row < M_TOK) {
                float ss = 0.f;
#pragma unroll
                for (int i = 0; i < 4; ++i) {
                    const f32x4 t = v[rr][i];
                    ss += t[0] * t[0] + t[1] * t[1] + t[2] * t[2] + t[3] * t[3];
                    u32x2 w; w.x = pk2(t[0], t[1]); w.y = pk2(t[2], t[3]);
                    *(u32x2*)(XB + (size_t)row * XLD + (lane + 64 * i) * 4) = w;
                }
                ss = wave_sum(ss, lane);
                if (lane < 16) SSX[(size_t)row * 16 + lane] = (lane == 0) ? ss : 0.f;
            }
        }
    }
}
DI void final_norm(const bf16_t* XB, float* Out, const float* __restrict__ g, const float* SSX, int wv) {
    const int tid_ = tid_opaque(wv);
    const int lane = tid_ & 63, gw = bid_opaque() * NWAVE + (tid_ >> 6), nw = gridDim.x * NWAVE;
    constexpr int RB = 4;
    f32x4 gv[4];
#pragma unroll
    for (int i = 0; i < 4; ++i) gv[i] = ((const f32x4*)g)[lane + 64 * i];
    for (int row0 = gw; row0 < M_TOK; row0 += RB * nw) {
        float ssv[RB]; u32x2 w[RB][4];
#pragma unroll
        for (int rr = 0; rr < RB; ++rr) {
            const int row = (row0 + rr * nw < M_TOK) ? row0 + rr * nw : row0;
            ssv[rr] = (lane < 16) ? SSX[(size_t)row * 16 + lane] : 0.f;
#pragma unroll
            for (int i = 0; i < 4; ++i) w[rr][i] = *(const u32x2*)(XB + (size_t)row * XLD + (lane + 64 * i) * 4);
        }
#pragma unroll
        for (int rr = 0; rr < RB; ++rr) {
            const int row = row0 + rr * nw;
            if (row < M_TOK) {
                const float rstd = rsqrtf(wave_sum(ssv[rr], lane) * (1.0f / 1024.0f) + EPS);
                f32x4* orow = (f32x4*)(Out + (size_t)row * 1024);
#pragma unroll
                for (int i = 0; i < 4; ++i) {
                    f32x4 r; r[0] = __uint_as_float(w[rr][i].x << 16); r[1] = __uint_as_float(w[rr][i].x & 0xffff0000u); r[2] = __uint_as_float(w[rr][i].y << 16); r[3] = __uint_as_float(w[rr][i].y & 0xffff0000u);
                    orow[lane + 64 * i] = r * rstd * gv[i];
                }
            }
        }
    }
}
DI float row_rstd(const float* ssx, int m) {
    const f32x4* pp = (const f32x4*)(ssx + (size_t)m * 16);
    const f32x4 a = (pp[0] + pp[1]) + (pp[2] + pp[3]);
    return rsqrtf(((a[0] + a[1]) + (a[2] + a[3])) * (1.0f / 1024.0f) + EPS);
}

constexpr int GSTR = 128, GOP = 256 * GSTR;
constexpr int SMEM_BYTES = 4 * GOP;
constexpr int SMEM_CONV = 256 * 264 * 2;
constexpr int SMEM_TOTAL = SMEM_CONV > SMEM_BYTES ? SMEM_CONV : SMEM_BYTES;

DI void gemm_mainloop(const bf16_t* __restrict__ Ab, const unsigned (&aoff)[4], const bool (&av)[4], const bf16_t* __restrict__ Bb, unsigned boff, int ldb, int nk, unsigned char* smem, f32x4 (&acc)[8][4], int tid,
                      const unsigned char* zline) {
    const int lane = tid & 63, wid = tid >> 6, wr = wid >> 2, wc = wid & 3;
#pragma unroll
    for (int i = 0; i < 8; ++i)
#pragma unroll
        for (int j = 0; j < 4; ++j) acc[i][j] = (f32x4){0.f, 0.f, 0.f, 0.f};
#define G_DMA(KT, BUF) { _Pragma("unroll") for (int i = 0; i < 4; ++i) { \
        const unsigned char* ga_ = av[i] ? ((const unsigned char*)Ab + (size_t)(aoff[i] + (unsigned)((KT) * 128))) : zline; \
        __builtin_amdgcn_global_load_lds((const unsigned*)ga_, (unsigned*)(smem + (BUF) * 2 * GOP + i * 8192 + tid * 16), 16, 0, 0); \
        __builtin_amdgcn_global_load_lds((const unsigned*)((const unsigned char*)Bb + (size_t)(boff + (unsigned)(i * 128 * ldb) + (unsigned)((KT) * 128))), (unsigned*)(smem + (BUF) * 2 * GOP + GOP + i * 8192 + tid * 16), 16, 0, 0); } }
    const int foff = (lane & 15) * GSTR;
    const int fsw[2] = {(((lane >> 4)) ^ (lane & 7)) << 4, (((lane >> 4) + 4) ^ (lane & 7)) << 4};
    G_DMA(0, 0);
    __syncthreads();
    for (int kt = 0; kt < nk; ++kt) {
        { const int kl = (kt + 1 < nk) ? kt + 1 : nk - 1; G_DMA(kl, (kt + 1) & 1); }
        const unsigned char* sa = smem + (kt & 1) * 2 * GOP + wr * 128 * GSTR + foff;
        const unsigned char* sb = smem + (kt & 1) * 2 * GOP + GOP + wc * 64 * GSTR + foff;
#pragma unroll
        for (int kk = 0; kk < 2; ++kk) {
            bf16x8 af[8], bfr[4];
#pragma unroll
            for (int i = 0; i < 4; ++i) bfr[i] = *(const bf16x8*)(sb + i * 16 * GSTR + fsw[kk]);
#pragma unroll
            for (int i = 0; i < 8; ++i) af[i] = *(const bf16x8*)(sa + i * 16 * GSTR + fsw[kk]);
            if (kk == 0) __builtin_amdgcn_s_setprio(1);
#pragma unroll
            for (int mi = 0; mi < 8; ++mi)
#pragma unroll
                for (int ni = 0; ni < 4; ++ni) acc[mi][ni] = __builtin_amdgcn_mfma_f32_16x16x32_bf16(bfr[ni], af[mi], acc[mi][ni], 0, 0, 0);
        }
        __builtin_amdgcn_sched_group_barrier(0x100, 12, 0);
#pragma unroll
        for (int g = 0; g < 12; ++g) { __builtin_amdgcn_sched_group_barrier(0x008, 2, 0); __builtin_amdgcn_sched_group_barrier(0x100, 1, 0); }
        __builtin_amdgcn_sched_group_barrier(0x008, 40, 0);
        __builtin_amdgcn_s_setprio(0);
        __syncthreads();
    }
#undef G_DMA
}

template <class Epi>
DI void gemm_tile(const bf16_t* __restrict__ A, int lda, const bf16_t* __restrict__ Bt, int ldb, int K, int m0, int n0, unsigned char* smem, const Epi& epi, int wv) {
    const int tid = tid_opaque(wv), lane = tid & 63, wid = tid >> 6, wr = wid >> 2, wc = wid & 3;
    const int lrow = tid >> 3, lc = tid & 7;
    unsigned aoff[4];
    const bool av[4] = {true, true, true, true};
#pragma unroll
    for (int i = 0; i < 4; ++i) aoff[i] = (unsigned)((lrow + 64 * i) * lda + (lc ^ (lrow & 7)) * 8) * 2u;
    const unsigned boff = (unsigned)(lrow * ldb + (lc ^ (lrow & 7)) * 8) * 2u;
    f32x4 acc[8][4];
    gemm_mainloop(A + (size_t)m0 * lda, aoff, av, Bt + (size_t)n0 * ldb, boff, ldb, K / 64, smem, acc, tid, nullptr);
    epi(acc, m0 + wr * 128, n0 + wc * 64, lane);
}

template <class Epi>
DI void gemm_phase(const bf16_t* A, int lda, const bf16_t* Bt, int ldb, int K, int Mrows, int Ncols, unsigned char* smem, const Epi& epi, int wv) {
    const int nN = Ncols / 256, nM = Mrows / 256;
    const int bid = bid_opaque(), G = gridDim.x;
    const int xcd = bid & 7, lb = bid >> 3, nlb = G >> 3, mper = nM >> 3, nloc = mper * nN;
    for (int j = lb; j < nloc; j += nlb) {
        const int g = j / (8 * nN), rem = j - g * 8 * nN;
        const int mt = xcd * mper + g * 8 + (rem & 7), nt = rem >> 3;
        gemm_tile(A, lda, Bt, ldb, K, mt * 256, nt * 256, smem, epi, wv);
    }
}

DI float dot4(f32x4 a) { return (a[0] * a[0] + a[1] * a[1]) + (a[2] * a[2] + a[3] * a[3]); }
DI void st4bf(bf16_t* dst, f32x4 v) { u32x2 w; w.x = pk2(v[0], v[1]); w.y = pk2(v[2], v[3]); *(u32x2*)dst = w; }

template <bool XIN_F32>
struct EpiResid2 {
    const float* Xin; bf16_t* XB; float* SSX;
    DI void operator()(const f32x4 (&acc)[8][4], int mb, int nb, int lane) const {
        const int q = lane >> 4;
        u32x2 xin[XIN_F32 ? 1 : 8][4];
        if (!XIN_F32) {
#pragma unroll
            for (int mi = 0; mi < 8; ++mi)
#pragma unroll
                for (int ni = 0; ni < 4; ++ni) xin[mi][ni] = *(const u32x2*)(XB + (size_t)(mb + mi * 16 + (lane & 15)) * XLD + nb + ni * 16 + q * 4);
        }
#pragma unroll
        for (int mi = 0; mi < 8; ++mi) {
            const int m = mb + mi * 16 + (lane & 15);
            float ss = 0.f;
#pragma unroll
            for (int ni = 0; ni < 4; ++ni) {
                const int col = nb + ni * 16 + q * 4;
                bf16_t* xb = XB + (size_t)m * XLD + col;
                f32x4 r;
                if (XIN_F32) r = *(const f32x4*)(Xin + (size_t)m * 1024 + col);
                else { const u32x2 w = xin[XIN_F32 ? 0 : mi][ni]; r[0] = __uint_as_float(w.x << 16); r[1] = __uint_as_float(w.x & 0xffff0000u); r[2] = __uint_as_float(w.y << 16); r[3] = __uint_as_float(w.y & 0xffff0000u); }
                r += acc[mi][ni];
                st4bf(xb, r);
                ss += dot4(r);
            }
            ss += shflx(ss, 16, lane); ss += shflx(ss, 32, lane);
            if (q == 0) SSX[(size_t)m * 16 + (nb >> 6)] = ss;
        }
    }
};

struct EpiInProj {
    const float *ssx, *tab, *gq, *gk;
    bf16_t *QA, *KA, *VA, *CQ, *CKV, *KB, *QC, *KC, *VC;
    float *sscq, *ssckv;
    DI void operator()(const f32x4 (&acc)[8][4], int mb, int nb, int lane) const {
        const int q = lane >> 4, ml = lane & 15;
        const float qsA = 0.125f * LOG2E, qsC = 0.17677669529663687f * LOG2E;
        float rsv[8];
#pragma unroll
        for (int mi = 0; mi < 8; ++mi) rsv[mi] = row_rstd(ssx, mb + mi * 16 + ml);
        if (nb < 640) {
            const bool isq = nb < 512;
            const int head = isq ? (nb >> 6) : ((nb - 512) >> 6);
            const float* g = isq ? gq : gk;
            f32x4 gv[4];
#pragma unroll
            for (int ni = 0; ni < 4; ++ni) gv[ni] = *(const f32x4*)(g + ni * 16 + q * 4);
#pragma unroll
            for (int mi = 0; mi < 8; ++mi) {
                const int m = mb + mi * 16 + ml, b = m >> 12, s = m & 4095;
                const float rs = rsv[mi];
                f32x4 v[4];
                float ss = 0.f;
#pragma unroll
                for (int ni = 0; ni < 4; ++ni) { v[ni] = acc[mi][ni] * rs; ss += dot4(v[ni]); }
                ss += shflx(ss, 16, lane); ss += shflx(ss, 32, lane);
                const float r2 = rsqrtf(ss * (1.0f / 64.0f) + EPS);
#pragma unroll
                for (int ni = 0; ni < 4; ++ni) v[ni] = v[ni] * r2 * gv[ni];
                const float* tr = tab + (s >> 6) * 16 + q * 4;
                const float* tq = tab + (s & 63) * 16 + q * 4;
                const f32x4 c0 = *(const f32x4*)tr, s0 = *(const f32x4*)(tr + 1024), c1 = *(const f32x4*)tq, s1 = *(const f32x4*)(tq + 1024);
                f32x4 o0 = v[0] * c0 - v[1] * s0, o1 = v[1] * c0 + v[0] * s0, o2 = v[2] * c1 - v[3] * s1, o3 = v[3] * c1 + v[2] * s1;
                bf16_t* dst;
                if (isq) { o0 *= qsA; o1 *= qsA; o2 *= qsA; o3 *= qsA; dst = QA + ((size_t)(b * 8 + head) * SEQ + s) * 64 + q * 4; }
                else dst = KA + ((size_t)(b * 2 + head) * SEQ + s) * 64 + q * 4;
                st4bf(dst, o0); st4bf(dst + 16, o1); st4bf(dst + 32, o2); st4bf(dst + 48, o3);
            }
        } else if (nb < 768) {
            const int head = (nb - 640) >> 6;
#pragma unroll
            for (int mi = 0; mi < 8; ++mi) {
                const int m = mb + mi * 16 + ml, b = m >> 12, s = m & 4095;
                const float rs = rsv[mi];
                bf16_t* dst = VA + ((size_t)(b * 2 + head) * SEQ + s) * 64 + q * 4;
#pragma unroll
                for (int ni = 0; ni < 4; ++ni) st4bf(dst + ni * 16, acc[mi][ni] * rs);
            }
        } else {
            const bool sq = nb < 1088;
#pragma unroll
            for (int mi = 0; mi < 8; ++mi) {
                const int m = mb + mi * 16 + ml, b = m >> 12, s = m & 4095;
                const float rs = rsv[mi];
                float ss = 0.f;
#pragma unroll
                for (int ni = 0; ni < 4; ++ni) {
                    const int n16 = nb + ni * 16;
                    f32x4 v = acc[mi][ni] * rs;
                    if (n16 < 960) { st4bf(CQ + (size_t)m * 192 + (n16 - 768) + q * 4, v); ss += dot4(v); }
                    else if (n16 < 1088) { st4bf(CKV + (size_t)m * 128 + (n16 - 960) + q * 4, v); ss += dot4(v); }
                    else if (n16 < 1120) {
                        f32x4 pr;
#pragma unroll
                        for (int i = 0; i < 4; ++i) pr[i] = shflx(v[i], 32, lane);
                        const int pos = (n16 >= 1104) ? (s & 63) : (s >> 6);
                        const float* tc = tab + 2048 + pos * 8 + (q & 1) * 4;
                        const f32x4 c = *(const f32x4*)tc, sn = *(const f32x4*)(tc + 512);
                        const f32x4 o = (q < 2) ? (v * c - pr * sn) : (v * c + pr * sn);
#pragma unroll
                        for (int hh = 0; hh < 4; ++hh) st4bf(KB + ((size_t)(b * 4 + hh) * SEQ + s) * 96 + 64 + (n16 - 1088) + q * 4, o);
                    } else if (n16 < 1376) { const int c = n16 - 1120 + q * 4; st4bf(QC + ((size_t)(b * 4 + (c >> 6)) * SEQ + s) * 64 + (c & 63), v * qsC); }
                    else if (n16 < 1632) { const int c = n16 - 1376 + q * 4; st4bf(KC + ((size_t)(b * 4 + (c >> 6)) * SEQ + s) * 64 + (c & 63), v); }
                    else if (n16 < 1888) { const int c = n16 - 1632 + q * 4; st4bf(VC + ((size_t)(b * 4 + (c >> 6)) * SEQ + s) * 64 + (c & 63), v); }
                }
                if (sq) {
                    ss += shflx(ss, 16, lane); ss += shflx(ss, 32, lane);
                    if (q == 0) { if (nb < 960) sscq[(size_t)m * 4 + ((nb - 768) >> 6)] = ss; else ssckv[(size_t)m * 2 + ((nb - 960) >> 6)] = ss; }
                }
            }
        }
    }
};
struct EpiMlaQ {
    bf16_t* QB; const float* tab; const float* sscq; float qscale;
    DI void operator()(const f32x4 (&acc)[8][4], int mb, int nb, int lane) const {
#pragma unroll
        for (int mi = 0; mi < 8; ++mi) {
            const int m = mb + mi * 16 + (lane & 15), q = lane >> 4, b = m >> 12, s = m & 4095;
            const f32x4 sp = *(const f32x4*)(sscq + (size_t)m * 4);
            const float rs = rsqrtf((sp[0] + sp[1] + sp[2]) * (1.0f / 192.0f) + EPS) * qscale;
#pragma unroll
            for (int ni = 0; ni < 4; ++ni) {
                const int nt = nb + ni * 16;
                if (nt >= 384) continue;
                const int head = nt / 96, dt = nt - head * 96;
                f32x4 v = acc[mi][ni] * rs;
                f32x4 pr;
#pragma unroll
                for (int i = 0; i < 4; ++i) pr[i] = shflx(v[i], 32, lane);
                if (dt >= 64) {
                    const int pos = (dt >= 80) ? (s & 63) : (s >> 6);
                    const float* tc = tab + 2048 + pos * 8 + (q & 1) * 4;
                    const f32x4 c = *(const f32x4*)tc, sn = *(const f32x4*)(tc + 512);
                    v = (q < 2) ? (v * c - pr * sn) : (v * c + pr * sn);
                }
                st4bf(QB + ((size_t)(b * 4 + head) * SEQ + s) * 96 + dt + q * 4, v);
            }
        }
    }
};
struct EpiMlaKV {
    bf16_t* KB; bf16_t* VB; const float* ssckv;
    DI void operator()(const f32x4 (&acc)[8][4], int mb, int nb, int lane) const {
#pragma unroll
        for (int mi = 0; mi < 8; ++mi) {
            const int m = mb + mi * 16 + (lane & 15), b = m >> 12, s = m & 4095;
            const f32x2 sp = *(const f32x2*)(ssckv + (size_t)m * 2);
            const float rs = rsqrtf((sp[0] + sp[1]) * (1.0f / 128.0f) + EPS);
#pragma unroll
            for (int ni = 0; ni < 4; ++ni) {
                const int n = nb + ni * 16 + (lane >> 4) * 4;
                const int head = n >> 7, d = n & 127;
                const size_t rowi = (size_t)(b * 4 + head) * SEQ + s;
                if (d < 64) st4bf(KB + rowi * 96 + d, acc[mi][ni] * rs);
                else st4bf(VB + rowi * 64 + (d - 64), acc[mi][ni] * rs);
            }
        }
    }
};

DI void up_conv_tile(const bf16_t* __restrict__ XB, const bf16_t* __restrict__ Wt, const float* __restrict__ ssx, const float* __restrict__ cw, const float* __restrict__ cb,
                     bf16_t* __restrict__ ACT, int b, int jt, int nt, unsigned char* smem, int wv, const unsigned char* zline) {
    const int tid = tid_opaque(wv), lane = tid & 63, wid = tid >> 6, wr = wid >> 2, wc = wid & 3;
    const int lrow = tid >> 3, lc = tid & 7;
    const int tbase = jt * 254 - 1;
    unsigned aoff[4];
    bool av[4];
#pragma unroll
    for (int i = 0; i < 4; ++i) {
        const int tl = tbase + lrow + 64 * i;
        av[i] = (unsigned)tl < 4096u;
        const int tc = tl < 0 ? 0 : (tl > 4095 ? 4095 : tl);
        aoff[i] = (unsigned)(tc * XLD + (lc ^ (lrow & 7)) * 8) * 2u;
    }
    const unsigned boff = (unsigned)(lrow * XLD + (lc ^ (lrow & 7)) * 8) * 2u;
    f32x4 acc[8][4];
    gemm_mainloop(XB + (size_t)b * SEQ * XLD, aoff, av, Wt + (size_t)nt * 256 * XLD, boff, XLD, 16, smem, acc, tid, zline);
    bf16_t* T = (bf16_t*)smem;
    constexpr int TLD = 264;
    {
        const int q = lane >> 4, ml = lane & 15;
        float rsv[8];
#pragma unroll
        for (int mi = 0; mi < 8; ++mi) { const int tl = tbase + wr * 128 + mi * 16 + ml; const int tc = tl < 0 ? 0 : (tl > 4095 ? 4095 : tl); rsv[mi] = row_rstd(ssx, b * SEQ + tc); }
#pragma unroll
        for (int mi = 0; mi < 8; ++mi) {
            const int il = wr * 128 + mi * 16 + ml;
            const float rs = rsv[mi];
#pragma unroll
            for (int ni = 0; ni < 4; ++ni) st4bf(T + il * TLD + wc * 64 + ni * 16 + q * 4, acc[mi][ni] * rs);
        }
    }
    __syncthreads();
    {
        const int cq = tid & 31, rg = tid >> 5, ch = nt * 128 + cq * 4;
        const f32x4 wg0 = *(const f32x4*)(cw + ch), wg1 = *(const f32x4*)(cw + DFF2 + ch), wg2 = *(const f32x4*)(cw + 2 * DFF2 + ch), bg = *(const f32x4*)(cb + ch);
        const f32x4 wv0 = *(const f32x4*)(cw + DFF + ch), wv1 = *(const f32x4*)(cw + DFF2 + DFF + ch), wv2 = *(const f32x4*)(cw + 2 * DFF2 + DFF + ch), bv = *(const f32x4*)(cb + DFF + ch);
#define LD4(R, C) ({ const u32x2 w_ = *(const u32x2*)(T + (R) * TLD + (C)); f32x4 r_; r_[0] = __uint_as_float(w_.x << 16); r_[1] = __uint_as_float(w_.x & 0xffff0000u); r_[2] = __uint_as_float(w_.y << 16); r_[3] = __uint_as_float(w_.y & 0xffff0000u); r_; })
        const int r0 = rg * 16, rm = r0 > 0 ? r0 - 1 : 0;
        f32x4 gm = LD4(rm, cq * 4), vm = LD4(rm, 128 + cq * 4);
        f32x4 g0 = LD4(r0, cq * 4), v0 = LD4(r0, 128 + cq * 4);
#pragma unroll
        for (int rr = 0; rr < 16; ++rr) {
            const int r = r0 + rr, rp = r < 255 ? r + 1 : 255;
            const f32x4 gp = LD4(rp, cq * 4), vp = LD4(rp, 128 + cq * 4);
            const f32x4 gg = wg0 * gm + wg1 * g0 + wg2 * gp + bg;
            const f32x4 vv = wv0 * vm + wv1 * v0 + wv2 * vp + bv;
            f32x4 o;
#pragma unroll
            for (int e = 0; e < 4; ++e) o[e] = gg[e] * __builtin_amdgcn_rcpf(1.0f + __builtin_amdgcn_exp2f(-LOG2E * gg[e])) * vv[e];
            const int tl = tbase + r;
            if (r >= 1 && r <= 254 && tl <= 4095) st4bf(ACT + ((size_t)b * SEQ + tl) * ALD + ch, o);
            gm = g0; g0 = gp; vm = v0; v0 = vp;
        }
#undef LD4
    }
    __syncthreads();
}
DI void up_conv_phase(const bf16_t* XB, const bf16_t* Wt, const float* ssx, const float* cw, const float* cb, bf16_t* ACT, unsigned char* smem, int wv, const unsigned char* zline) {
    constexpr int NT = DFF / 128, MT = 17;
    const int bid = bid_opaque(), G = gridDim.x;
    const int xcd = bid & 7, lb = bid >> 3, nlb = G >> 3, nloc = MT * NT, full = (MT / 8) * 8 * NT, gs = MT - (MT / 8) * 8;
    for (int j = lb; j < nloc; j += nlb) {
        int jt, nt;
        if (j < full) { const int g = j / (8 * NT), rem = j - g * 8 * NT; jt = g * 8 + (rem & 7); nt = rem >> 3; }
        else { const int j2 = j - full; jt = (MT / 8) * 8 + j2 % gs; nt = j2 / gs; }
        up_conv_tile(XB, Wt, ssx, cw, cb, ACT, xcd, jt, nt, smem, wv, zline);
    }
}

constexpr int ATT_STAGE = 64 * 208 + 8192;

template <int DQK, int MODE>
DI void attn_tile(const unsigned char* cur, int kt, bool first, f32x16 (&O)[MODE ? 2 : 1][2], float (&mrun)[MODE ? 2 : 1], float (&lsum)[MODE ? 2 : 1], const bf16x8 (&qf)[MODE ? 2 : 1][MODE == 1 ? 2 : DQK / 16],
               int kfo, int vfo0, int vfo1, float qpos, float slope2, int h) {
    constexpr bool DIFF = (MODE == 1);
    constexpr int NQT = MODE ? 2 : 1, KS = DIFF ? 2 : DQK / 16, KSTR = DQK * 2 + 16;
        bf16x8 kfr[2][KS], vfr[2][2][2];
#pragma unroll
        for (int kh = 0; kh < 2; ++kh)
#pragma unroll
            for (int ks = 0; ks < KS; ++ks) kfr[kh][ks] = *(const bf16x8*)(cur + kfo + kh * 32 * KSTR + (ks * 16) * 2);
        if (MODE == 0) {
#pragma unroll
            for (int kh = 0; kh < 2; ++kh)
#pragma unroll
                for (int s2 = 0; s2 < 2; ++s2)
#pragma unroll
                    for (int d = 0; d < 2; ++d) {
                        const unsigned char* va = cur + (d ? vfo1 : vfo0) + (kh * 32 + 16 * s2) * 128;
                        const s16x4 lo = __builtin_amdgcn_ds_read_tr16_b64_v4i16((__attribute__((address_space(3))) s16x4*)(va));
                        const s16x4 hi = __builtin_amdgcn_ds_read_tr16_b64_v4i16((__attribute__((address_space(3))) s16x4*)(va + 8 * 128));
                        vfr[kh][s2][d] = __builtin_shufflevector(lo, hi, 0, 1, 2, 3, 4, 5, 6, 7);
                    }
        }
        __builtin_amdgcn_sched_barrier(0);
#pragma unroll
        for (int qt = 0; qt < NQT; ++qt) {
            bf16x8 pf[2][2];
            f32x16 S[2];
#pragma unroll
            for (int kh = 0; kh < 2; ++kh) {
#pragma unroll
                for (int i = 0; i < 16; ++i) S[kh][i] = 0.f;
#pragma unroll
                for (int ks = 0; ks < KS; ++ks) S[kh] = __builtin_amdgcn_mfma_f32_32x32x16_bf16(kfr[kh][ks], qf[qt][ks], S[kh], 0, 0, 0);
            }
            if (DIFF && qt == 0) {
#pragma unroll
                for (int kh = 0; kh < 2; ++kh)
#pragma unroll
                    for (int ks = 0; ks < KS; ++ks) kfr[kh][ks] = *(const bf16x8*)(cur + kfo + kh * 32 * KSTR + (32 + ks * 16) * 2);
            }
            float kd = 0.f;
            if (DIFF) {
                const float d0 = qpos - (float)(kt * 64 + 4 * h);
                const unsigned long long bl = __builtin_amdgcn_ballot_w64(d0 >= 59.0f), br = __builtin_amdgcn_ballot_w64(d0 <= 0.0f);
                if (bl == ~0ull) {
                    kd = slope2 * d0;
#pragma unroll
                    for (int kh = 0; kh < 2; ++kh)
#pragma unroll
                        for (int i = 0; i < 16; ++i) S[kh][i] = S[kh][i] + slope2 * (float)(kh * 32 + (i & 3) + 8 * (i >> 2));
                } else if (br == ~0ull) {
                    kd = -slope2 * d0;
#pragma unroll
                    for (int kh = 0; kh < 2; ++kh)
#pragma unroll
                        for (int i = 0; i < 16; ++i) S[kh][i] = S[kh][i] - slope2 * (float)(kh * 32 + (i & 3) + 8 * (i >> 2));
                } else {
#pragma unroll
                    for (int kh = 0; kh < 2; ++kh)
#pragma unroll
                        for (int i = 0; i < 16; ++i) S[kh][i] -= slope2 * fabsf(d0 - (float)(kh * 32 + (i & 3) + 8 * (i >> 2)));
                }
            }
            float mx = __builtin_elementwise_maximum(S[0][0], S[1][0]);
#pragma unroll
            for (int i = 1; i < 16; ++i) mx = __builtin_elementwise_maximum(mx, __builtin_elementwise_maximum(S[0][i], S[1][i]));
            mx -= kd;
            { const auto sw = __builtin_amdgcn_permlane32_swap(__float_as_uint(mx), __float_as_uint(mx), false, false); mx = __builtin_elementwise_maximum(__uint_as_float(sw[0]), __uint_as_float(sw[1])); }
            float mref = mrun[qt] + kd;
            const float rel = mx - mrun[qt];
            const bool dead = DIFF && !first && (__builtin_amdgcn_ballot_w64(rel < -160.0f) == ~0ull);
            if (!dead) {
            const bool need = (rel > 8.0f) || (first && rel < -8.0f);
            if (__builtin_amdgcn_ballot_w64(need) != 0ull) {
                const float delta = need ? rel : 0.f;
                const float alpha = first ? 1.0f : __builtin_amdgcn_exp2f(-delta);
                mrun[qt] += delta; mref += delta;
                lsum[qt] *= alpha;
#pragma unroll
                for (int d = 0; d < 2; ++d)
#pragma unroll
                    for (int i = 0; i < 16; ++i) O[qt][d][i] *= alpha;
            }
            float ps = 0.f;
            if (__builtin_amdgcn_ballot_w64(mref != 0.f) != 0ull) {
#pragma unroll
                for (int kh = 0; kh < 2; ++kh)
#pragma unroll
                    for (int i = 0; i < 16; ++i) { const float pv = __builtin_amdgcn_exp2f(S[kh][i] - mref); S[kh][i] = pv; ps += pv; }
            } else {
#pragma unroll
                for (int kh = 0; kh < 2; ++kh)
#pragma unroll
                    for (int i = 0; i < 16; ++i) { const float pv = __builtin_amdgcn_exp2f(S[kh][i]); S[kh][i] = pv; ps += pv; }
            }
            lsum[qt] += ps;
#pragma unroll
            for (int kh = 0; kh < 2; ++kh)
#pragma unroll
                for (int s2 = 0; s2 < 2; ++s2) {
                    u32x4 w;
                    w.x = pk2(S[kh][8 * s2 + 0], S[kh][8 * s2 + 1]); w.y = pk2(S[kh][8 * s2 + 2], S[kh][8 * s2 + 3]);
                    w.z = pk2(S[kh][8 * s2 + 4], S[kh][8 * s2 + 5]); w.w = pk2(S[kh][8 * s2 + 6], S[kh][8 * s2 + 7]);
                    pf[kh][s2] = __builtin_bit_cast(bf16x8, w);
                }
#pragma unroll
            for (int kh = 0; kh < 2; ++kh)
#pragma unroll
                for (int s2 = 0; s2 < 2; ++s2)
#pragma unroll
                    for (int d = 0; d < 2; ++d) {
                        if (MODE != 0) {
                            const unsigned char* va = cur + (d ? vfo1 : vfo0) + (kh * 32 + 16 * s2) * 128;
                            const s16x4 lo = __builtin_amdgcn_ds_read_tr16_b64_v4i16((__attribute__((address_space(3))) s16x4*)(va));
                            const s16x4 hi = __builtin_amdgcn_ds_read_tr16_b64_v4i16((__attribute__((address_space(3))) s16x4*)(va + 8 * 128));
                            vfr[kh][s2][d] = __builtin_shufflevector(lo, hi, 0, 1, 2, 3, 4, 5, 6, 7);
                        }
                        O[qt][d] = __builtin_amdgcn_mfma_f32_32x32x16_bf16(vfr[kh][s2][d], pf[kh][s2], O[qt][d], 0, 0, 0);
                    }
            }
            if (DIFF) __builtin_amdgcn_sched_barrier(0);
        }
}

template <int DQK, int MODE>
DI void attn_unit(const bf16_t* __restrict__ Qg, const bf16_t* __restrict__ Kg, const bf16_t* __restrict__ Vg, int q0, bf16_t* __restrict__ outp,
                  float slope2, float lam, float outmul, const float* __restrict__ subln, unsigned char* smem, int wv) {
    constexpr bool DIFF = (MODE == 1);
    constexpr int NQT = MODE ? 2 : 1, QW = (MODE == 2) ? 64 : 32, KS = DIFF ? 2 : DQK / 16, KSTR = DQK * 2 + 16, CPR = DQK / 8, KCH = (64 * CPR + NTHR - 1) / NTHR, KBYTES = 64 * 208;
    const int tid = tid_opaque(wv), lane = tid & 63, wid = tid >> 6, r = lane & 31, h = lane >> 5;
    const int qrow = q0 + wid * QW + r;
    bf16x8 qf[NQT][KS];
#pragma unroll
    for (int qt = 0; qt < NQT; ++qt)
#pragma unroll
        for (int ks = 0; ks < KS; ++ks) qf[qt][ks] = *(const bf16x8*)(Qg + (size_t)(qrow + (MODE == 2 ? 32 * qt : 0)) * DQK + (DIFF ? qt * 32 : 0) + ks * 16 + h * 8);
    f32x16 O[NQT][2];
    float mrun[NQT], lsum[NQT];
#pragma unroll
    for (int qt = 0; qt < NQT; ++qt) {
        mrun[qt] = 0.f; lsum[qt] = 0.f;
#pragma unroll
        for (int d = 0; d < 2; ++d)
#pragma unroll
            for (int i = 0; i < 16; ++i) O[qt][d][i] = 0.f;
    }
    int koff[KCH], voff;
    bool kval[KCH];
#pragma unroll
    for (int i = 0; i < KCH; ++i) { const int id = tid + NTHR * i, key = id / CPR, c = id % CPR; koff[i] = key * KSTR + c * 16; kval[i] = id < 64 * CPR; }
    { const int key = tid >> 3, c = tid & 7; voff = KBYTES + key * 128 + ((c ^ (((key >> 1) & 1) << 2)) * 16); }
    const int c0 = DIFF ? (q0 >> 6) : 0;
#define ORD(I) (DIFF ? (((I) < SEQ / 64 - c0) ? c0 + (I) : SEQ / 64 - 1 - (I)) : (I))
    u32x4 rk[KCH], rv;
#pragma unroll
    for (int i = 0; i < KCH; ++i) if (kval[i]) rk[i] = *(const u32x4*)(Kg + (size_t)c0 * 64 * DQK + (size_t)(tid + NTHR * i) * 8);
    rv = *(const u32x4*)(Vg + (size_t)c0 * 64 * 64 + (size_t)tid * 8);
#pragma unroll
    for (int i = 0; i < KCH; ++i) if (kval[i]) *(u32x4*)(smem + koff[i]) = rk[i];
    *(u32x4*)(smem + voff) = rv;
    __syncthreads();
    const int kfo = r * KSTR + h * 16;
    const int qq = (lane >> 2) & 3;
    const int colb0 = ((qq >> 1) & 1) * 64 + 32 * ((lane >> 4) & 1) + 8 * (lane & 3);
    const int vfo0 = KBYTES + (4 * h + qq) * 128 + colb0, vfo1 = KBYTES + (4 * h + qq) * 128 + (colb0 ^ 64);
    const float qpos = (float)qrow;

    u32x4 rk2[KCH], rv2;
#define AT_LOAD(RK, RV, T) { const int ti_ = (T) < SEQ / 64 ? (T) : SEQ / 64 - 1; const int tn_ = ORD(ti_); _Pragma("unroll") for (int i = 0; i < KCH; ++i) RK[i] = *(const u32x4*)(Kg + (size_t)tn_ * 64 * DQK + (size_t)(kval[i] ? tid + NTHR * i : tid) * 8);     RV = *(const u32x4*)(Vg + (size_t)tn_ * 64 * 64 + (size_t)tid * 8); }
#define AT_WRITE(RK, RV, SO) { _Pragma("unroll") for (int i = 0; i < KCH; ++i) if (kval[i]) *(u32x4*)(smem + (SO) + koff[i]) = RK[i]; *(u32x4*)(smem + (SO) + voff) = RV; }
    AT_LOAD(rk2, rv2, 1);
    for (int kt = 0; kt < SEQ / 64; kt += 2) {
        AT_LOAD(rk, rv, kt + 2);
        attn_tile<DQK, MODE>(smem, ORD(kt), kt == 0, O, mrun, lsum, qf, kfo, vfo0, vfo1, qpos, slope2, h);
        AT_WRITE(rk2, rv2, ATT_STAGE);
        __syncthreads();
        AT_LOAD(rk2, rv2, kt + 3);
        attn_tile<DQK, MODE>(smem + ATT_STAGE, ORD(kt + 1), false, O, mrun, lsum, qf, kfo, vfo0, vfo1, qpos, slope2, h);
        AT_WRITE(rk, rv, 0);
        __syncthreads();
    }
#undef AT_LOAD
#undef AT_WRITE
#undef ORD
    const int tid2 = tid_opaque(wv), lane2 = tid2 & 63;
    const int h2 = lane2 >> 5;
    float inv[NQT];
#pragma unroll
    for (int qt = 0; qt < NQT; ++qt) { const float lt = lsum[qt] + shflx(lsum[qt], 32, lane2); inv[qt] = 1.0f / lt; }
    if (MODE == 2) {
#pragma unroll
        for (int qt = 0; qt < NQT; ++qt) {
            const int qrow2 = q0 + ((tid2 >> 6) * QW) + 32 * qt + (lane2 & 31);
            bf16_t* orow = outp + (size_t)qrow2 * XLD;
#pragma unroll
            for (int d = 0; d < 2; ++d)
#pragma unroll
                for (int g = 0; g < 4; ++g) {
                    u32x2 w; w.x = pk2(O[qt][d][4 * g] * inv[qt], O[qt][d][4 * g + 1] * inv[qt]); w.y = pk2(O[qt][d][4 * g + 2] * inv[qt], O[qt][d][4 * g + 3] * inv[qt]);
                    *(u32x2*)(orow + d * 32 + 8 * g + 4 * h2) = w;
                }
        }
        return;
    }
    float o[2][16];
    if (DIFF) {
        float ss = 0.f;
#pragma unroll
        for (int d = 0; d < 2; ++d)
#pragma unroll
            for (int i = 0; i < 16; ++i) { const float x = O[0][d][i] * inv[0] - lam * (O[NQT - 1][d][i] * inv[NQT - 1]); o[d][i] = x; ss += x * x; }
        ss += shflx(ss, 32, lane2);
        const float rstd = rsqrtf(ss * (1.0f / 64.0f) + EPS) * outmul;
#pragma unroll
        for (int d = 0; d < 2; ++d)
#pragma unroll
            for (int i = 0; i < 16; ++i) o[d][i] *= rstd * subln[d * 32 + (i & 3) + 8 * (i >> 2) + 4 * h2];
    } else {
#pragma unroll
        for (int d = 0; d < 2; ++d)
#pragma unroll
            for (int i = 0; i < 16; ++i) o[d][i] = O[0][d][i] * inv[0];
    }
    const int qrow2 = q0 + (lane2 & 31) + ((tid2 >> 6) << 5);
    bf16_t* orow = outp + (size_t)qrow2 * XLD;
#pragma unroll
    for (int d = 0; d < 2; ++d)
#pragma unroll
        for (int g = 0; g < 4; ++g) {
            u32x2 w; w.x = pk2(o[d][4 * g], o[d][4 * g + 1]); w.y = pk2(o[d][4 * g + 2], o[d][4 * g + 3]);
            *(u32x2*)(orow + d * 32 + 8 * g + 4 * h2) = w;
        }
}

DI void attn_phase(const Params& p, int layer, float lam_init, float outmul, unsigned char* smem, int wv) {
    unsigned char* ws = p.ws;
    const bf16_t *QA = (const bf16_t*)(ws + OFF_QA), *KA = (const bf16_t*)(ws + OFF_KA), *VA = (const bf16_t*)(ws + OFF_VA), *QB = (const bf16_t*)(ws + OFF_QB),
                 *KB = (const bf16_t*)(ws + OFF_KB), *VB = (const bf16_t*)(ws + OFF_VB), *QC = (const bf16_t*)(ws + OFF_QC), *KC = (const bf16_t*)(ws + OFF_KC),
                 *VC = (const bf16_t*)(ws + OFF_VC);
    bf16_t* MIX = (bf16_t*)(ws + OFF_MIX);
    float s1 = 0.f, s2 = 0.f;
    for (int j = 0; j < 32; ++j) { s1 += p.lq1[layer * 32 + j] * p.lk1[layer * 32 + j]; s2 += p.lq2[layer * 32 + j] * p.lk2[layer * 32 + j]; }
    const float lam = __int_as_float(__builtin_amdgcn_readfirstlane(__float_as_int(expf(s1) - expf(s2) + lam_init)));
    for (int v = bid_opaque(); v < 1536; v += gridDim.x) {
        const int base = v & ~255, i = v & 255, j = i >> 3;
        const int u = base + ((i & 7) * 2 + (j >> 4)) * 16 + (j & 15);
        if (u < 512) {
            const int qb = u & 15, hh = (u >> 4) & 3, b = u >> 6;
            const size_t ro = (size_t)(b * 4 + hh) * SEQ * 64;
            const float slope2 = __int_as_float(__builtin_amdgcn_readfirstlane(__float_as_int(exp2f(-2.0f * (float)(hh + 1)) * LOG2E)));
            attn_unit<64, 1>(QC + ro, KC + ro, VC + ro, qb * 256, MIX + (size_t)b * SEQ * XLD + 768 + hh * 64, slope2, lam, outmul,
                             p.subln + layer * 64, smem, wv);
        } else if (u < 1024) {
            const int w = u - 512, qb = w & 15, hh = (w >> 4) & 3, b = w >> 6;
            const size_t rq = (size_t)(b * 4 + hh) * SEQ;
            attn_unit<96, 0>(QB + rq * 96, KB + rq * 96, VB + rq * 64, qb * 256, MIX + (size_t)b * SEQ * XLD + 512 + hh * 64, 0.f, 0.f, 0.f, nullptr, smem, wv);
        } else {
            const int w = u - 1024, qb = w & 7, hh = (w >> 3) & 7, b = w >> 6;
            const size_t rq = (size_t)(b * 8 + hh) * SEQ, rk = (size_t)(b * 2 + (hh >> 2)) * SEQ;
            attn_unit<64, 2>(QA + rq * 64, KA + rk * 64, VA + rk * 64, qb * 512, MIX + (size_t)b * SEQ * XLD + hh * 64, 0.f, 0.f, 0.f, nullptr, smem, wv);
        }
    }
}

#define GB_XCNT(j) (64 * (j))
#define GB_XSUB(j) (1024 + 64 * (j))
#define GB_XGEN(j) (2048 + 64 * (j))
#define GB_TOP 3072
#define GB_TOPGEN 3136
constexpr int GB_WORDS = 3200;
DI unsigned gb_ld(unsigned* p) { return __hip_atomic_load(p, __ATOMIC_RELAXED, __HIP_MEMORY_SCOPE_AGENT); }
DI unsigned gb_add(unsigned* p) { return __hip_atomic_fetch_add(p, 1u, __ATOMIC_RELAXED, __HIP_MEMORY_SCOPE_AGENT); }
DI unsigned gb_xcc() { return (unsigned)__builtin_amdgcn_s_getreg((3 << 11) | 20) & 0xFu; }
#define GB_SPIN(cond) { unsigned sp_ = 0; while (cond) { __builtin_amdgcn_s_sleep(1); if (++sp_ > (1u << 24)) break; } }
DI void grid_bar(unsigned* bar, unsigned x, unsigned nloc, unsigned nx, unsigned& ep, int wv) {
    asm volatile("s_waitcnt vmcnt(0)" ::: "memory");
    __syncthreads();
    asm volatile("" : "+s"(nloc), "+s"(nx), "+s"(x));
    unsigned epl = ep; asm volatile("" : "+s"(epl));
    if (tid_opaque(wv) == 0) {
        const unsigned old = gb_add(&bar[GB_XSUB(x)]);
        if (old + 1u == (epl + 1u) * nloc) {
            __builtin_amdgcn_fence(__ATOMIC_RELEASE, "agent");
            asm volatile("s_waitcnt vmcnt(0)" ::: "memory");
            const unsigned og = gb_add(&bar[GB_TOP]);
            if (og + 1u == (epl + 1u) * nx) gb_add(&bar[GB_TOPGEN]);
            else GB_SPIN(gb_ld(&bar[GB_TOPGEN]) == epl);
            __builtin_amdgcn_fence(__ATOMIC_ACQUIRE, "agent");
            gb_add(&bar[GB_XGEN(x)]);
            asm volatile("s_waitcnt vmcnt(0)" ::: "memory");
        } else {
            GB_SPIN(gb_ld(&bar[GB_XGEN(x)]) == epl);
            __builtin_amdgcn_fence(__ATOMIC_ACQUIRE, "agent");
            asm volatile("s_waitcnt vmcnt(0)" ::: "memory");
        }
    }
    ep += 1u;
    __syncthreads();
}

__global__ void __launch_bounds__(NTHR, 2) mega(Params p) {
    extern __shared__ __attribute__((aligned(16))) unsigned char smem[];
    cg::grid_group grid = cg::this_grid();
    unsigned char* ws = p.ws;
    const int gtid = blockIdx.x * NTHR + threadIdx.x, gthreads = gridDim.x * NTHR;
    const int wv = __builtin_amdgcn_readfirstlane((int)(threadIdx.x >> 6));
    bf16_t* XB = (bf16_t*)(ws + OFF_XB);
    float* SSX = (float*)(ws + OFF_SSX);
    float* tab = (float*)(ws + OFF_TAB);

    unsigned* bar = (unsigned*)(ws + OFF_BAR);
    const unsigned myx = gb_xcc();
    if (threadIdx.x == 0) gb_add(&bar[GB_XCNT(myx)]);
    for (int l = 0; l < 2; ++l) {
        prep_weight<false>(p.w_in + (size_t)l * 1024 * INW, p.norm_attn + l * 1024, (bf16_t*)(ws + OFF_WIN) + (size_t)l * INWP * XLD, XLD, 1024, INW, INWP, smem, wv);
        prep_weight<false>(p.w_uq + (size_t)l * 192 * 384, p.qan_b + l * 192, (bf16_t*)(ws + OFF_WUQ) + (size_t)l * 512 * 192, 192, 192, 384, 512, smem, wv);
        prep_weight<false>(p.w_ukv + (size_t)l * 128 * 512, p.kvn_b + l * 128, (bf16_t*)(ws + OFF_WUKV) + (size_t)l * 512 * 128, 128, 128, 512, 512, smem, wv);
        prep_weight<false>(p.w_out + (size_t)l * 1024 * 1024, nullptr, (bf16_t*)(ws + OFF_WOUT) + (size_t)l * 1024 * XLD, XLD, 1024, 1024, 1024, smem, wv);
        prep_weight<true>(p.w_up + (size_t)l * 1024 * DFF2, p.norm_ffn + l * 1024, (bf16_t*)(ws + OFF_WUP) + (size_t)l * DFF2 * XLD, XLD, 1024, DFF2, DFF2, smem, wv);
        prep_weight<false>(p.w_down + (size_t)l * DFF * 1024, nullptr, (bf16_t*)(ws + OFF_WDN) + (size_t)l * 1024 * ALD, ALD, DFF, 1024, 1024, smem, wv);
    }
    for (int idx = gtid; idx < 1024 + 512; idx += gthreads) {
        if (idx < 1024) { const int pos = idx >> 4, f = idx & 15; const float ang = (float)pos * powf(10000.0f, -(float)f / 16.0f); tab[idx] = cosf(ang); tab[1024 + idx] = sinf(ang); }
        else { const int k = idx - 1024, pos = k >> 3, f = k & 7; const float ang = (float)pos * powf(10000.0f, -(float)f / 8.0f); tab[2048 + k] = cosf(ang); tab[2560 + k] = sinf(ang); }
    }
    convert_x(p.x, XB, SSX, wv);
    grid.sync();

    unsigned nloc = 1u, nx = 0u, ep = 0u;
    for (unsigned j = 0; j < 16; ++j) { const unsigned c = gb_ld(&bar[GB_XCNT(j)]); nx += (c > 0u) ? 1u : 0u; nloc = (j == myx) ? c : nloc; }
    nloc = __builtin_amdgcn_readfirstlane(nloc > 0u ? nloc : 1u); nx = __builtin_amdgcn_readfirstlane(nx > 0u ? nx : 1u);
    for (int l = 0; l < 2; ++l) {
        const float lam_init = __int_as_float(__builtin_amdgcn_readfirstlane(__float_as_int((l == 0) ? 0.2f : 0.35550906759096984f)));
        gemm_phase(XB, XLD, (const bf16_t*)(ws + OFF_WIN) + (size_t)l * INWP * XLD, XLD, 1024, M_TOK, INWP, smem,
                   EpiInProj{SSX, tab, p.qn_a + l * 64, p.kn_a + l * 64, (bf16_t*)(ws + OFF_QA), (bf16_t*)(ws + OFF_KA), (bf16_t*)(ws + OFF_VA), (bf16_t*)(ws + OFF_CQ),
                             (bf16_t*)(ws + OFF_CKV), (bf16_t*)(ws + OFF_KB), (bf16_t*)(ws + OFF_QC), (bf16_t*)(ws + OFF_KC), (bf16_t*)(ws + OFF_VC),
                             (float*)(ws + OFF_SSCQ), (float*)(ws + OFF_SSCKV)}, wv);
        grid_bar(bar, myx, nloc, nx, ep, wv);
        gemm_phase((const bf16_t*)(ws + OFF_CQ), 192, (const bf16_t*)(ws + OFF_WUQ) + (size_t)l * 512 * 192, 192, 192, M_TOK, 512, smem,
                   EpiMlaQ{(bf16_t*)(ws + OFF_QB), tab, (const float*)(ws + OFF_SSCQ), 0.10206207261596575f * LOG2E}, wv);
        gemm_phase((const bf16_t*)(ws + OFF_CKV), 128, (const bf16_t*)(ws + OFF_WUKV) + (size_t)l * 512 * 128, 128, 128, M_TOK, 512, smem,
                   EpiMlaKV{(bf16_t*)(ws + OFF_KB), (bf16_t*)(ws + OFF_VB), (const float*)(ws + OFF_SSCKV)}, wv);
        grid_bar(bar, myx, nloc, nx, ep, wv);
        attn_phase(p, l, lam_init, __int_as_float(__builtin_amdgcn_readfirstlane(__float_as_int((l == 0) ? 0.8f : 0.64449093240903016f))), smem, wv);
        grid_bar(bar, myx, nloc, nx, ep, wv);
        if (l == 0) gemm_phase((const bf16_t*)(ws + OFF_MIX), XLD, (const bf16_t*)(ws + OFF_WOUT) + (size_t)l * 1024 * XLD, XLD, 1024, M_TOK, 1024, smem, EpiResid2<true>{p.x, XB, SSX}, wv);
        else gemm_phase((const bf16_t*)(ws + OFF_MIX), XLD, (const bf16_t*)(ws + OFF_WOUT) + (size_t)l * 1024 * XLD, XLD, 1024, M_TOK, 1024, smem, EpiResid2<false>{nullptr, XB, SSX}, wv);
        grid_bar(bar, myx, nloc, nx, ep, wv);
        up_conv_phase(XB, (const bf16_t*)(ws + OFF_WUP) + (size_t)l * DFF2 * XLD, SSX, p.conv_w + (size_t)l * 3 * DFF2, p.conv_b + (size_t)l * DFF2, (bf16_t*)(ws + OFF_ACT), smem, wv, ws + OFF_BAR + GB_WORDS * 4);
        grid_bar(bar, myx, nloc, nx, ep, wv);
        gemm_phase((const bf16_t*)(ws + OFF_ACT), ALD, (const bf16_t*)(ws + OFF_WDN) + (size_t)l * 1024 * ALD, ALD, DFF, M_TOK, 1024, smem, EpiResid2<false>{nullptr, XB, SSX}, wv);
        grid_bar(bar, myx, nloc, nx, ep, wv);
    }
    final_norm(XB, p.out, p.final_norm, SSX, wv);
}

extern "C" void kernel_launch(void* const* d_in, const int* in_sizes, int n_in, void* d_out, int out_size, void* d_ws, size_t ws_size, hipStream_t stream) {
    static int grid_blocks = 0;
    if (!grid_blocks) {
        int dev = 0, cus = 0, per_cu = 0;
        hipGetDevice(&dev);
        hipDeviceGetAttribute(&cus, hipDeviceAttributeMultiprocessorCount, dev);
        hipFuncSetAttribute((const void*)mega, hipFuncAttributeMaxDynamicSharedMemorySize, SMEM_TOTAL);
        hipOccupancyMaxActiveBlocksPerMultiprocessor(&per_cu, mega, NTHR, SMEM_TOTAL);
        if (per_cu > 1) per_cu = 1;
        if (per_cu < 1) per_cu = 1;
        grid_blocks = (cus * per_cu) & ~7;
    }
    Params p{};
    const float** pp = (const float**)&p;
    for (int i = 0; i < 21; ++i) pp[i] = (const float*)d_in[i];
    p.out = (float*)d_out;
    p.ws = (unsigned char*)d_ws;
    hipMemsetAsync((unsigned char*)d_ws + OFF_BAR, 0, GB_WORDS * 4 + 256, stream);
    void* args[] = {&p};
    hipError_t e = hipLaunchCooperativeKernel((void*)mega, dim3(grid_blocks), dim3(NTHR), args, SMEM_TOTAL, stream);
    if (e != hipSuccess) fprintf(stderr, "cooperative launch failed: %s (grid %d)\n", hipGetErrorString(e), grid_blocks);
}
```

```cpp
#include <hip/hip_runtime.h>
#include <hip/hip_cooperative_groups.h>
#include <stdint.h>
#include <math.h>
#include <stdio.h>
namespace cg = cooperative_groups;

typedef unsigned short bf16_t;
typedef short bf16x8 __attribute__((ext_vector_type(8)));
typedef short s16x4 __attribute__((ext_vector_type(4)));
typedef float f32x4 __attribute__((ext_vector_type(4)));
typedef float f32x16 __attribute__((ext_vector_type(16)));
typedef unsigned u32x4 __attribute__((ext_vector_type(4)));
typedef unsigned u32x2 __attribute__((ext_vector_type(2)));
typedef __bf16 bf2_t __attribute__((ext_vector_type(2)));
typedef float f32x2 __attribute__((ext_vector_type(2)));
#define DI __device__ __forceinline__

constexpr int M_TOK = 32768, SEQ = 4096, DM = 1024, INW = 1888, INWP = 2048, DFF = 2816, DFF2 = 5632;
constexpr float EPS = 1e-6f;
constexpr float LOG2E = 1.4426950408889634f;
constexpr int NTHR = 512, NWAVE = NTHR / 64;
constexpr int XLD = 1024 + 64, ALD = DFF + 64;

constexpr size_t SZ_WIN = (size_t)2 * INWP * XLD * 2, SZ_WUQ = (size_t)2 * 512 * 192 * 2, SZ_WUKV = (size_t)2 * 512 * 128 * 2,
                 SZ_WOUT = (size_t)2 * 1024 * XLD * 2, SZ_WUP = (size_t)2 * DFF2 * XLD * 2, SZ_WDN = (size_t)2 * 1024 * ALD * 2;
constexpr size_t OFF_WIN = 0, OFF_WUQ = OFF_WIN + SZ_WIN, OFF_WUKV = OFF_WUQ + SZ_WUQ, OFF_WOUT = OFF_WUKV + SZ_WUKV,
                 OFF_WUP = OFF_WOUT + SZ_WOUT, OFF_WDN = OFF_WUP + SZ_WUP, OFF_TAB = OFF_WDN + SZ_WDN, OFF_XB = OFF_TAB + 16384;
constexpr size_t OFF_SSX = OFF_XB + (size_t)M_TOK * XLD * 2, OFF_SSCQ = OFF_SSX + (size_t)M_TOK * 16 * 4, OFF_SSCKV = OFF_SSCQ + (size_t)M_TOK * 4 * 4,
                 OFF_BIG = OFF_SSCKV + (size_t)M_TOK * 2 * 4;
constexpr size_t OFF_QA = OFF_BIG, OFF_KA = OFF_QA + (size_t)M_TOK * 512 * 2,
                 OFF_VA = OFF_KA + (size_t)M_TOK * 128 * 2, OFF_CQ = OFF_VA + (size_t)M_TOK * 128 * 2, OFF_CKV = OFF_CQ + (size_t)M_TOK * 192 * 2,
                 OFF_QB = OFF_CKV + (size_t)M_TOK * 128 * 2, OFF_KB = OFF_QB + (size_t)M_TOK * 384 * 2, OFF_VB = OFF_KB + (size_t)M_TOK * 384 * 2,
                 OFF_QC = OFF_VB + (size_t)M_TOK * 256 * 2, OFF_KC = OFF_QC + (size_t)M_TOK * 256 * 2, OFF_VC = OFF_KC + (size_t)M_TOK * 256 * 2,
                 OFF_MIX = OFF_VC + (size_t)M_TOK * 256 * 2, OFF_END1 = OFF_MIX + (size_t)M_TOK * XLD * 2;
constexpr size_t OFF_ACT = OFF_BIG, OFF_END2 = OFF_ACT + (size_t)M_TOK * ALD * 2;
constexpr size_t OFF_BAR = ((OFF_END1 > OFF_END2 ? OFF_END1 : OFF_END2) + 255) & ~(size_t)255;
static_assert(OFF_BAR + 16384 <= (size_t)512 * 1024 * 1024, "workspace");

struct Params {
    const float *x, *norm_attn, *w_in, *qn_a, *kn_a, *qan_b, *w_uq, *kvn_b, *w_ukv, *lq1, *lk1, *lq2, *lk2, *subln, *w_out, *norm_ffn, *w_up,
        *conv_w, *conv_b, *w_down, *final_norm;
    float* out;
    unsigned char* ws;
};

DI unsigned pk2(float a, float b) { f32x2 v = {a, b}; bf2_t r = __builtin_convertvector(v, bf2_t); return __builtin_bit_cast(unsigned, r); }
DI void unpack8(u32x4 r, float* v) {
    v[0] = __uint_as_float(r.x << 16); v[1] = __uint_as_float(r.x & 0xffff0000u);
    v[2] = __uint_as_float(r.y << 16); v[3] = __uint_as_float(r.y & 0xffff0000u);
    v[4] = __uint_as_float(r.z << 16); v[5] = __uint_as_float(r.z & 0xffff0000u);
    v[6] = __uint_as_float(r.w << 16); v[7] = __uint_as_float(r.w & 0xffff0000u);
}
DI u32x4 pack8(const float* v) { u32x4 r; r.x = pk2(v[0], v[1]); r.y = pk2(v[2], v[3]); r.z = pk2(v[4], v[5]); r.w = pk2(v[6], v[7]); return r; }
DI int tid_opaque(int wv) { int t; asm volatile("v_mbcnt_lo_u32_b32 %0, -1, 0\n\tv_mbcnt_hi_u32_b32 %0, -1, %0" : "=v"(t)); return t | (wv << 6); }
DI int bid_opaque() { int b = blockIdx.x; asm volatile("" : "+s"(b)); return b; }
DI float shflx(float v, int mask, int lane) { return __int_as_float(__builtin_amdgcn_ds_bpermute((lane ^ mask) << 2, __float_as_int(v))); }
DI float wave_sum(float v, int lane) {
#pragma unroll
    for (int o = 32; o >= 1; o >>= 1) v += shflx(v, o, lane);
    return v;
}

template <bool UPPERM>
DI void prep_weight(const float* __restrict__ W, const float* __restrict__ gain, bf16_t* __restrict__ Wt, int ldw, int K, int N, int Npad, unsigned char* smem, int wv) {
    bf16_t* Ts = (bf16_t*)smem;
    const int tid = tid_opaque(wv);
    const int nkt = K / 64, ntile = (Npad / 64) * nkt;
    for (int t = bid_opaque(); t < ntile; t += gridDim.x) {
        const int n0 = (t / nkt) * 64, k0 = (t % nkt) * 64;
        int ns0 = n0;
        if (UPPERM) { const int j = n0 >> 8, r = n0 & 255; ns0 = (r < 128) ? (128 * j + r) : (DFF + 128 * j + r - 128); }
        const int kr = tid >> 4, nc = (tid & 15) * 4;
        if (n0 + 64 <= N) {
            f32x4 v4[2];
#pragma unroll
            for (int hh = 0; hh < 2; ++hh) v4[hh] = *(const f32x4*)(W + (size_t)(k0 + kr + 32 * hh) * N + ns0 + nc);
#pragma unroll
            for (int hh = 0; hh < 2; ++hh) {
                const float gk = gain ? gain[k0 + kr + 32 * hh] : 1.0f;
#pragma unroll
                for (int e = 0; e < 4; ++e) Ts[(nc + e) * 72 + kr + 32 * hh] = (bf16_t)(pk2(v4[hh][e] * gk, 0.f) & 0xffffu);
            }
        } else {
#pragma unroll
        for (int hh = 0; hh < 2; ++hh) {
            const int k = k0 + kr + 32 * hh;
            const float gk = gain ? gain[k] : 1.0f;
#pragma unroll
            for (int e = 0; e < 4; ++e) {
                const float v = (n0 + nc + e < N) ? W[(size_t)k * N + ns0 + nc + e] * gk : 0.f;
                Ts[(nc + e) * 72 + kr + 32 * hh] = (bf16_t)(pk2(v, 0.f) & 0xffffu);
            }
        }
        }
        __syncthreads();
        { const int n = tid >> 3, kc = tid & 7; *(u32x4*)(Wt + (size_t)(n0 + n) * ldw + k0 + kc * 8) = *(const u32x4*)(Ts + n * 72 + kc * 8); }
        __syncthreads();
    }
}

DI void convert_x(const float* X, bf16_t* XB, float* SSX, int wv) {
    const int tid_ = tid_opaque(wv);
    const int lane = tid_ & 63, gw = bid_opaque() * NWAVE + (tid_ >> 6), nw = gridDim.x * NWAVE;
    for (int row = gw; row < M_TOK; row += nw) {
        const f32x4* xr = (const f32x4*)(X + (size_t)row * 1024);
        float ss = 0.f;
#pragma unroll
        for (int i = 0; i < 4; ++i) {
            const f32x4 v = xr[lane + 64 * i];
            ss += v[0] * v[0] + v[1] * v[1] + v[2] * v[2] + v[3] * v[3];
            u32x2 w; w.x = pk2(v[0], v[1]); w.y = pk2(v[2], v[3]);
            *(u32x2*)(XB + (size_t)row * XLD + (lane + 64 * i) * 4) = w;
        }
        ss = wave_sum(ss, lane);
        if (lane < 16) SSX[(size_t)row * 16 + lane] = (lane == 0) ? ss : 0.f;
    }
}
DI void final_norm(const bf16_t* XB, float* Out, const float* __restrict__ g, const float* SSX, int wv) {
    const int tid_ = tid_opaque(wv);
    const int lane = tid_ & 63, gw = bid_opaque() * NWAVE + (tid_ >> 6), nw = gridDim.x * NWAVE;
    for (int row = gw; row < M_TOK; row += nw) {
        float ss = (lane < 16) ? SSX[(size_t)row * 16 + lane] : 0.f;
        ss = wave_sum(ss, lane);
        const float rstd = rsqrtf(ss * (1.0f / 1024.0f) + EPS);
        f32x4* orow = (f32x4*)(Out + (size_t)row * 1024);
#pragma unroll
        for (int i = 0; i < 4; ++i) {
            const u32x2 w = *(const u32x2*)(XB + (size_t)row * XLD + (lane + 64 * i) * 4);
            f32x4 r; r[0] = __uint_as_float(w.x << 16); r[1] = __uint_as_float(w.x & 0xffff0000u); r[2] = __uint_as_float(w.y << 16); r[3] = __uint_as_float(w.y & 0xffff0000u);
            const f32x4 gv = ((const f32x4*)g)[lane + 64 * i];
            orow[lane + 64 * i] = r * rstd * gv;
        }
    }
}
DI float row_rstd(const float* ssx, int m) {
    const f32x4* pp = (const f32x4*)(ssx + (size_t)m * 16);
    const f32x4 a = (pp[0] + pp[1]) + (pp[2] + pp[3]);
    return rsqrtf(((a[0] + a[1]) + (a[2] + a[3])) * (1.0f / 1024.0f) + EPS);
}

constexpr int GSTR = 128, GOP = 256 * GSTR;
constexpr int SMEM_BYTES = 4 * GOP;
constexpr int SMEM_CONV = 256 * 264 * 2;
constexpr int SMEM_TOTAL = SMEM_CONV > SMEM_BYTES ? SMEM_CONV : SMEM_BYTES;

DI void gemm_mainloop(const bf16_t* __restrict__ Ab, const unsigned (&aoff)[4], const bool (&av)[4], const bf16_t* __restrict__ Bb, unsigned boff, int ldb, int nk, unsigned char* smem, f32x4 (&acc)[8][4], int tid,
                      const unsigned char* zline) {
    const int lane = tid & 63, wid = tid >> 6, wr = wid >> 2, wc = wid & 3;
#pragma unroll
    for (int i = 0; i < 8; ++i)
#pragma unroll
        for (int j = 0; j < 4; ++j) acc[i][j] = (f32x4){0.f, 0.f, 0.f, 0.f};
#define G_DMA(KT, BUF) { _Pragma("unroll") for (int i = 0; i < 4; ++i) { \
        const unsigned char* ga_ = av[i] ? ((const unsigned char*)Ab + (size_t)(aoff[i] + (unsigned)((KT) * 128))) : zline; \
        __builtin_amdgcn_global_load_lds((const unsigned*)ga_, (unsigned*)(smem + (BUF) * 2 * GOP + i * 8192 + tid * 16), 16, 0, 0); \
        __builtin_amdgcn_global_load_lds((const unsigned*)((const unsigned char*)Bb + (size_t)(boff + (unsigned)(i * 128 * ldb) + (unsigned)((KT) * 128))), (unsigned*)(smem + (BUF) * 2 * GOP + GOP + i * 8192 + tid * 16), 16, 0, 0); } }
    const int foff = (lane & 15) * GSTR;
    const int fsw[2] = {(((lane >> 4)) ^ (lane & 7)) << 4, (((lane >> 4) + 4) ^ (lane & 7)) << 4};
    G_DMA(0, 0);
    __syncthreads();
    for (int kt = 0; kt < nk; ++kt) {
        { const int kl = (kt + 1 < nk) ? kt + 1 : nk - 1; G_DMA(kl, (kt + 1) & 1); }
        const unsigned char* sa = smem + (kt & 1) * 2 * GOP + wr * 128 * GSTR + foff;
        const unsigned char* sb = smem + (kt & 1) * 2 * GOP + GOP + wc * 64 * GSTR + foff;
#pragma unroll
        for (int kk = 0; kk < 2; ++kk) {
            bf16x8 af[8], bfr[4];
#pragma unroll
            for (int i = 0; i < 4; ++i) bfr[i] = *(const bf16x8*)(sb + i * 16 * GSTR + fsw[kk]);
#pragma unroll
            for (int i = 0; i < 8; ++i) af[i] = *(const bf16x8*)(sa + i * 16 * GSTR + fsw[kk]);
#pragma unroll
            for (int mi = 0; mi < 8; ++mi)
#pragma unroll
                for (int ni = 0; ni < 4; ++ni) acc[mi][ni] = __builtin_amdgcn_mfma_f32_16x16x32_bf16(bfr[ni], af[mi], acc[mi][ni], 0, 0, 0);
        }
        __builtin_amdgcn_sched_group_barrier(0x100, 12, 0);
#pragma unroll
        for (int g = 0; g < 12; ++g) { __builtin_amdgcn_sched_group_barrier(0x008, 2, 0); __builtin_amdgcn_sched_group_barrier(0x100, 1, 0); }
        __builtin_amdgcn_sched_group_barrier(0x008, 40, 0);
        __syncthreads();
    }
#undef G_DMA
}

template <class Epi>
DI void gemm_tile(const bf16_t* __restrict__ A, int lda, const bf16_t* __restrict__ Bt, int ldb, int K, int m0, int n0, unsigned char* smem, const Epi& epi, int wv) {
    const int tid = tid_opaque(wv), lane = tid & 63, wid = tid >> 6, wr = wid >> 2, wc = wid & 3;
    const int lrow = tid >> 3, lc = tid & 7;
    unsigned aoff[4];
    const bool av[4] = {true, true, true, true};
#pragma unroll
    for (int i = 0; i < 4; ++i) aoff[i] = (unsigned)((lrow + 64 * i) * lda + (lc ^ (lrow & 7)) * 8) * 2u;
    const unsigned boff = (unsigned)(lrow * ldb + (lc ^ (lrow & 7)) * 8) * 2u;
    f32x4 acc[8][4];
    gemm_mainloop(A + (size_t)m0 * lda, aoff, av, Bt + (size_t)n0 * ldb, boff, ldb, K / 64, smem, acc, tid, nullptr);
    epi(acc, m0 + wr * 128, n0 + wc * 64, lane);
}

template <class Epi>
DI void gemm_phase(const bf16_t* A, int lda, const bf16_t* Bt, int ldb, int K, int Mrows, int Ncols, unsigned char* smem, const Epi& epi, int wv) {
    const int nN = Ncols / 256, nM = Mrows / 256;
    const int bid = bid_opaque(), G = gridDim.x;
    const int xcd = bid & 7, lb = bid >> 3, nlb = G >> 3, mper = nM >> 3, nloc = mper * nN;
    for (int j = lb; j < nloc; j += nlb) {
        const int g = j / (8 * nN), rem = j - g * 8 * nN;
        const int mt = xcd * mper + g * 8 + (rem & 7), nt = rem >> 3;
        gemm_tile(A, lda, Bt, ldb, K, mt * 256, nt * 256, smem, epi, wv);
    }
}

DI float dot4(f32x4 a) { return (a[0] * a[0] + a[1] * a[1]) + (a[2] * a[2] + a[3] * a[3]); }
DI void st4bf(bf16_t* dst, f32x4 v) { u32x2 w; w.x = pk2(v[0], v[1]); w.y = pk2(v[2], v[3]); *(u32x2*)dst = w; }

template <bool XIN_F32>
struct EpiResid2 {
    const float* Xin; bf16_t* XB; float* SSX;
    DI void operator()(const f32x4 (&acc)[8][4], int mb, int nb, int lane) const {
        const int q = lane >> 4;
        u32x2 xin[XIN_F32 ? 1 : 8][4];
        if (!XIN_F32) {
#pragma unroll
            for (int mi = 0; mi < 8; ++mi)
#pragma unroll
                for (int ni = 0; ni < 4; ++ni) xin[mi][ni] = *(const u32x2*)(XB + (size_t)(mb + mi * 16 + (lane & 15)) * XLD + nb + ni * 16 + q * 4);
        }
#pragma unroll
        for (int mi = 0; mi < 8; ++mi) {
            const int m = mb + mi * 16 + (lane & 15);
            float ss = 0.f;
#pragma unroll
            for (int ni = 0; ni < 4; ++ni) {
                const int col = nb + ni * 16 + q * 4;
                bf16_t* xb = XB + (size_t)m * XLD + col;
                f32x4 r;
                if (XIN_F32) r = *(const f32x4*)(Xin + (size_t)m * 1024 + col);
                else { const u32x2 w = xin[XIN_F32 ? 0 : mi][ni]; r[0] = __uint_as_float(w.x << 16); r[1] = __uint_as_float(w.x & 0xffff0000u); r[2] = __uint_as_float(w.y << 16); r[3] = __uint_as_float(w.y & 0xffff0000u); }
                r += acc[mi][ni];
                st4bf(xb, r);
                ss += dot4(r);
            }
            ss += shflx(ss, 16, lane); ss += shflx(ss, 32, lane);
            if (q == 0) SSX[(size_t)m * 16 + (nb >> 6)] = ss;
        }
    }
};

struct EpiInProj {
    const float *ssx, *tab, *gq, *gk;
    bf16_t *QA, *KA, *VA, *CQ, *CKV, *KB, *QC, *KC, *VC;
    float *sscq, *ssckv;
    DI void operator()(const f32x4 (&acc)[8][4], int mb, int nb, int lane) const {
        const int q = lane >> 4, ml = lane & 15;
        const float qsA = 0.125f * LOG2E, qsC = 0.17677669529663687f * LOG2E;
        float rsv[8];
#pragma unroll
        for (int mi = 0; mi < 8; ++mi) rsv[mi] = row_rstd(ssx, mb + mi * 16 + ml);
        if (nb < 640) {
            const bool isq = nb < 512;
            const int head = isq ? (nb >> 6) : ((nb - 512) >> 6);
            const float* g = isq ? gq : gk;
            f32x4 gv[4];
#pragma unroll
            for (int ni = 0; ni < 4; ++ni) gv[ni] = *(const f32x4*)(g + ni * 16 + q * 4);
#pragma unroll
            for (int mi = 0; mi < 8; ++mi) {
                const int m = mb + mi * 16 + ml, b = m >> 12, s = m & 4095;
                const float rs = rsv[mi];
                f32x4 v[4];
                float ss = 0.f;
#pragma unroll
                for (int ni = 0; ni < 4; ++ni) { v[ni] = acc[mi][ni] * rs; ss += dot4(v[ni]); }
                ss += shflx(ss, 16, lane); ss += shflx(ss, 32, lane);
                const float r2 = rsqrtf(ss * (1.0f / 64.0f) + EPS);
#pragma unroll
                for (int ni = 0; ni < 4; ++ni) v[ni] = v[ni] * r2 * gv[ni];
                const float* tr = tab + (s >> 6) * 16 + q * 4;
                const float* tq = tab + (s & 63) * 16 + q * 4;
                const f32x4 c0 = *(const f32x4*)tr, s0 = *(const f32x4*)(tr + 1024), c1 = *(const f32x4*)tq, s1 = *(const f32x4*)(tq + 1024);
                f32x4 o0 = v[0] * c0 - v[1] * s0, o1 = v[1] * c0 + v[0] * s0, o2 = v[2] * c1 - v[3] * s1, o3 = v[3] * c1 + v[2] * s1;
                bf16_t* dst;
                if (isq) { o0 *= qsA; o1 *= qsA; o2 *= qsA; o3 *= qsA; dst = QA + ((size_t)(b * 8 + head) * SEQ + s) * 64 + q * 4; }
                else dst = KA + ((size_t)(b * 2 + head) * SEQ + s) * 64 + q * 4;
                st4bf(dst, o0); st4bf(dst + 16, o1); st4bf(dst + 32, o2); st4bf(dst + 48, o3);
            }
        } else if (nb < 768) {
            const int head = (nb - 640) >> 6;
#pragma unroll
            for (int mi = 0; mi < 8; ++mi) {
                const int m = mb + mi * 16 + ml, b = m >> 12, s = m & 4095;
                const float rs = rsv[mi];
                bf16_t* dst = VA + ((size_t)(b * 2 + head) * SEQ + s) * 64 + q * 4;
#pragma unroll
                for (int ni = 0; ni < 4; ++ni) st4bf(dst + ni * 16, acc[mi][ni] * rs);
            }
        } else {
            const bool sq = nb < 1088;
#pragma unroll
            for (int mi = 0; mi < 8; ++mi) {
                const int m = mb + mi * 16 + ml, b = m >> 12, s = m & 4095;
                const float rs = rsv[mi];
                float ss = 0.f;
#pragma unroll
                for (int ni = 0; ni < 4; ++ni) {
                    const int n16 = nb + ni * 16;
                    f32x4 v = acc[mi][ni] * rs;
                    if (n16 < 960) { st4bf(CQ + (size_t)m * 192 + (n16 - 768) + q * 4, v); ss += dot4(v); }
                    else if (n16 < 1088) { st4bf(CKV + (size_t)m * 128 + (n16 - 960) + q * 4, v); ss += dot4(v); }
                    else if (n16 < 1120) {
                        f32x4 pr;
#pragma unroll
                        for (int i = 0; i < 4; ++i) pr[i] = shflx(v[i], 32, lane);
                        const int pos = (n16 >= 1104) ? (s & 63) : (s >> 6);
                        const float* tc = tab + 2048 + pos * 8 + (q & 1) * 4;
                        const f32x4 c = *(const f32x4*)tc, sn = *(const f32x4*)(tc + 512);
                        const f32x4 o = (q < 2) ? (v * c - pr * sn) : (v * c + pr * sn);
#pragma unroll
                        for (int hh = 0; hh < 4; ++hh) st4bf(KB + ((size_t)(b * 4 + hh) * SEQ + s) * 96 + 64 + (n16 - 1088) + q * 4, o);
                    } else if (n16 < 1376) { const int c = n16 - 1120 + q * 4; st4bf(QC + ((size_t)(b * 4 + (c >> 6)) * SEQ + s) * 64 + (c & 63), v * qsC); }
                    else if (n16 < 1632) { const int c = n16 - 1376 + q * 4; st4bf(KC + ((size_t)(b * 4 + (c >> 6)) * SEQ + s) * 64 + (c & 63), v); }
                    else if (n16 < 1888) { const int c = n16 - 1632 + q * 4; st4bf(VC + ((size_t)(b * 4 + (c >> 6)) * SEQ + s) * 64 + (c & 63), v); }
                }
                if (sq) {
                    ss += shflx(ss, 16, lane); ss += shflx(ss, 32, lane);
                    if (q == 0) { if (nb < 960) sscq[(size_t)m * 4 + ((nb - 768) >> 6)] = ss; else ssckv[(size_t)m * 2 + ((nb - 960) >> 6)] = ss; }
                }
            }
        }
    }
};
struct EpiMlaQ {
    bf16_t* QB; const float* tab; const float* sscq; float qscale;
    DI void operator()(const f32x4 (&acc)[8][4], int mb, int nb, int lane) const {
#pragma unroll
        for (int mi = 0; mi < 8; ++mi) {
            const int m = mb + mi * 16 + (lane & 15), q = lane >> 4, b = m >> 12, s = m & 4095;
            const f32x4 sp = *(const f32x4*)(sscq + (size_t)m * 4);
            const float rs = rsqrtf((sp[0] + sp[1] + sp[2]) * (1.0f / 192.0f) + EPS) * qscale;
#pragma unroll
            for (int ni = 0; ni < 4; ++ni) {
                const int nt = nb + ni * 16;
                if (nt >= 384) continue;
                const int head = nt / 96, dt = nt - head * 96;
                f32x4 v = acc[mi][ni] * rs;
                f32x4 pr;
#pragma unroll
                for (int i = 0; i < 4; ++i) pr[i] = shflx(v[i], 32, lane);
                if (dt >= 64) {
                    const int pos = (dt >= 80) ? (s & 63) : (s >> 6);
                    const float* tc = tab + 2048 + pos * 8 + (q & 1) * 4;
                    const f32x4 c = *(const f32x4*)tc, sn = *(const f32x4*)(tc + 512);
                    v = (q < 2) ? (v * c - pr * sn) : (v * c + pr * sn);
                }
                st4bf(QB + ((size_t)(b * 4 + head) * SEQ + s) * 96 + dt + q * 4, v);
            }
        }
    }
};
struct EpiMlaKV {
    bf16_t* KB; bf16_t* VB; const float* ssckv;
    DI void operator()(const f32x4 (&acc)[8][4], int mb, int nb, int lane) const {
#pragma unroll
        for (int mi = 0; mi < 8; ++mi) {
            const int m = mb + mi * 16 + (lane & 15), b = m >> 12, s = m & 4095;
            const f32x2 sp = *(const f32x2*)(ssckv + (size_t)m * 2);
            const float rs = rsqrtf((sp[0] + sp[1]) * (1.0f / 128.0f) + EPS);
#pragma unroll
            for (int ni = 0; ni < 4; ++ni) {
                const int n = nb + ni * 16 + (lane >> 4) * 4;
                const int head = n >> 7, d = n & 127;
                const size_t rowi = (size_t)(b * 4 + head) * SEQ + s;
                if (d < 64) st4bf(KB + rowi * 96 + d, acc[mi][ni] * rs);
                else st4bf(VB + rowi * 64 + (d - 64), acc[mi][ni] * rs);
            }
        }
    }
};

DI void up_conv_tile(const bf16_t* __restrict__ XB, const bf16_t* __restrict__ Wt, const float* __restrict__ ssx, const float* __restrict__ cw, const float* __restrict__ cb,
                     bf16_t* __restrict__ ACT, int b, int jt, int nt, unsigned char* smem, int wv, const unsigned char* zline) {
    const int tid = tid_opaque(wv), lane = tid & 63, wid = tid >> 6, wr = wid >> 2, wc = wid & 3;
    const int lrow = tid >> 3, lc = tid & 7;
    const int tbase = jt * 254 - 1;
    unsigned aoff[4];
    bool av[4];
#pragma unroll
    for (int i = 0; i < 4; ++i) {
        const int tl = tbase + lrow + 64 * i;
        av[i] = (unsigned)tl < 4096u;
        const int tc = tl < 0 ? 0 : (tl > 4095 ? 4095 : tl);
        aoff[i] = (unsigned)(tc * XLD + (lc ^ (lrow & 7)) * 8) * 2u;
    }
    const unsigned boff = (unsigned)(lrow * XLD + (lc ^ (lrow & 7)) * 8) * 2u;
    f32x4 acc[8][4];
    gemm_mainloop(XB + (size_t)b * SEQ * XLD, aoff, av, Wt + (size_t)nt * 256 * XLD, boff, XLD, 16, smem, acc, tid, zline);
    bf16_t* T = (bf16_t*)smem;
    constexpr int TLD = 264;
    {
        const int q = lane >> 4, ml = lane & 15;
        float rsv[8];
#pragma unroll
        for (int mi = 0; mi < 8; ++mi) { const int tl = tbase + wr * 128 + mi * 16 + ml; const int tc = tl < 0 ? 0 : (tl > 4095 ? 4095 : tl); rsv[mi] = row_rstd(ssx, b * SEQ + tc); }
#pragma unroll
        for (int mi = 0; mi < 8; ++mi) {
            const int il = wr * 128 + mi * 16 + ml;
            const float rs = rsv[mi];
#pragma unroll
            for (int ni = 0; ni < 4; ++ni) st4bf(T + il * TLD + wc * 64 + ni * 16 + q * 4, acc[mi][ni] * rs);
        }
    }
    __syncthreads();
    {
        const int cq = tid & 31, rg = tid >> 5, ch = nt * 128 + cq * 4;
        const f32x4 wg0 = *(const f32x4*)(cw + ch), wg1 = *(const f32x4*)(cw + DFF2 + ch), wg2 = *(const f32x4*)(cw + 2 * DFF2 + ch), bg = *(const f32x4*)(cb + ch);
        const f32x4 wv0 = *(const f32x4*)(cw + DFF + ch), wv1 = *(const f32x4*)(cw + DFF2 + DFF + ch), wv2 = *(const f32x4*)(cw + 2 * DFF2 + DFF + ch), bv = *(const f32x4*)(cb + DFF + ch);
#define LD4(R, C) ({ const u32x2 w_ = *(const u32x2*)(T + (R) * TLD + (C)); f32x4 r_; r_[0] = __uint_as_float(w_.x << 16); r_[1] = __uint_as_float(w_.x & 0xffff0000u); r_[2] = __uint_as_float(w_.y << 16); r_[3] = __uint_as_float(w_.y & 0xffff0000u); r_; })
        const int r0 = rg * 16, rm = r0 > 0 ? r0 - 1 : 0;
        f32x4 gm = LD4(rm, cq * 4), vm = LD4(rm, 128 + cq * 4);
        f32x4 g0 = LD4(r0, cq * 4), v0 = LD4(r0, 128 + cq * 4);
#pragma unroll
        for (int rr = 0; rr < 16; ++rr) {
            const int r = r0 + rr, rp = r < 255 ? r + 1 : 255;
            const f32x4 gp = LD4(rp, cq * 4), vp = LD4(rp, 128 + cq * 4);
            const f32x4 gg = wg0 * gm + wg1 * g0 + wg2 * gp + bg;
            const f32x4 vv = wv0 * vm + wv1 * v0 + wv2 * vp + bv;
            f32x4 o;
#pragma unroll
            for (int e = 0; e < 4; ++e) o[e] = gg[e] * __builtin_amdgcn_rcpf(1.0f + __builtin_amdgcn_exp2f(-LOG2E * gg[e])) * vv[e];
            const int tl = tbase + r;
            if (r >= 1 && r <= 254 && tl <= 4095) st4bf(ACT + ((size_t)b * SEQ + tl) * ALD + ch, o);
            gm = g0; g0 = gp; vm = v0; v0 = vp;
        }
#undef LD4
    }
    __syncthreads();
}
DI void up_conv_phase(const bf16_t* XB, const bf16_t* Wt, const float* ssx, const float* cw, const float* cb, bf16_t* ACT, unsigned char* smem, int wv, const unsigned char* zline) {
    constexpr int NT = DFF / 128, MT = 17;
    const int bid = bid_opaque(), G = gridDim.x;
    const int xcd = bid & 7, lb = bid >> 3, nlb = G >> 3, nloc = MT * NT, full = (MT / 8) * 8 * NT, gs = MT - (MT / 8) * 8;
    for (int j = lb; j < nloc; j += nlb) {
        int jt, nt;
        if (j < full) { const int g = j / (8 * NT), rem = j - g * 8 * NT; jt = g * 8 + (rem & 7); nt = rem >> 3; }
        else { const int j2 = j - full; jt = (MT / 8) * 8 + j2 % gs; nt = j2 / gs; }
        up_conv_tile(XB, Wt, ssx, cw, cb, ACT, xcd, jt, nt, smem, wv, zline);
    }
}

constexpr int ATT_STAGE = 64 * 208 + 8192;

template <int DQK, int MODE>
DI void attn_tile(const unsigned char* cur, int kt, bool first, f32x16 (&O)[MODE ? 2 : 1][2], float (&mrun)[MODE ? 2 : 1], float (&lsum)[MODE ? 2 : 1], const bf16x8 (&qf)[MODE ? 2 : 1][MODE == 1 ? 2 : DQK / 16],
               int kfo, int vfo0, int vfo1, float qpos, float slope2, int h) {
    constexpr bool DIFF = (MODE == 1);
    constexpr int NQT = MODE ? 2 : 1, KS = DIFF ? 2 : DQK / 16, KSTR = DQK * 2 + 16;
        bf16x8 kfr[2][KS], vfr[2][2][2];
#pragma unroll
        for (int kh = 0; kh < 2; ++kh)
#pragma unroll
            for (int ks = 0; ks < KS; ++ks) kfr[kh][ks] = *(const bf16x8*)(cur + kfo + kh * 32 * KSTR + (ks * 16) * 2);
        if (MODE == 0) {
#pragma unroll
            for (int kh = 0; kh < 2; ++kh)
#pragma unroll
                for (int s2 = 0; s2 < 2; ++s2)
#pragma unroll
                    for (int d = 0; d < 2; ++d) {
                        const unsigned char* va = cur + (d ? vfo1 : vfo0) + (kh * 32 + 16 * s2) * 128;
                        const s16x4 lo = __builtin_amdgcn_ds_read_tr16_b64_v4i16((__attribute__((address_space(3))) s16x4*)(va));
                        const s16x4 hi = __builtin_amdgcn_ds_read_tr16_b64_v4i16((__attribute__((address_space(3))) s16x4*)(va + 8 * 128));
                        vfr[kh][s2][d] = __builtin_shufflevector(lo, hi, 0, 1, 2, 3, 4, 5, 6, 7);
                    }
        }
        __builtin_amdgcn_sched_barrier(0);
#pragma unroll
        for (int qt = 0; qt < NQT; ++qt) {
            bf16x8 pf[2][2];
            f32x16 S[2];
#pragma unroll
            for (int kh = 0; kh < 2; ++kh) {
#pragma unroll
                for (int i = 0; i < 16; ++i) S[kh][i] = 0.f;
#pragma unroll
                for (int ks = 0; ks < KS; ++ks) S[kh] = __builtin_amdgcn_mfma_f32_32x32x16_bf16(kfr[kh][ks], qf[qt][ks], S[kh], 0, 0, 0);
            }
            if (DIFF && qt == 0) {
#pragma unroll
                for (int kh = 0; kh < 2; ++kh)
#pragma unroll
                    for (int ks = 0; ks < KS; ++ks) kfr[kh][ks] = *(const bf16x8*)(cur + kfo + kh * 32 * KSTR + (32 + ks * 16) * 2);
            }
            float kd = 0.f;
            if (DIFF) {
                const float d0 = qpos - (float)(kt * 64 + 4 * h);
                const unsigned long long bl = __builtin_amdgcn_ballot_w64(d0 >= 59.0f), br = __builtin_amdgcn_ballot_w64(d0 <= 0.0f);
                if (bl == ~0ull) {
                    kd = slope2 * d0;
#pragma unroll
                    for (int kh = 0; kh < 2; ++kh)
#pragma unroll
                        for (int i = 0; i < 16; ++i) S[kh][i] = S[kh][i] + slope2 * (float)(kh * 32 + (i & 3) + 8 * (i >> 2));
                } else if (br == ~0ull) {
                    kd = -slope2 * d0;
#pragma unroll
                    for (int kh = 0; kh < 2; ++kh)
#pragma unroll
                        for (int i = 0; i < 16; ++i) S[kh][i] = S[kh][i] - slope2 * (float)(kh * 32 + (i & 3) + 8 * (i >> 2));
                } else {
#pragma unroll
                    for (int kh = 0; kh < 2; ++kh)
#pragma unroll
                        for (int i = 0; i < 16; ++i) S[kh][i] -= slope2 * fabsf(d0 - (float)(kh * 32 + (i & 3) + 8 * (i >> 2)));
                }
            }
            float mx = __builtin_elementwise_maximum(S[0][0], S[1][0]);
#pragma unroll
            for (int i = 1; i < 16; ++i) mx = __builtin_elementwise_maximum(mx, __builtin_elementwise_maximum(S[0][i], S[1][i]));
            mx -= kd;
            { const auto sw = __builtin_amdgcn_permlane32_swap(__float_as_uint(mx), __float_as_uint(mx), false, false); mx = __builtin_elementwise_maximum(__uint_as_float(sw[0]), __uint_as_float(sw[1])); }
            float mref = mrun[qt] + kd;
            const float rel = mx - mrun[qt];
            const bool dead = DIFF && !first && (__builtin_amdgcn_ballot_w64(rel < -160.0f) == ~0ull);
            if (!dead) {
            const bool need = (rel > 8.0f) || (first && rel < -8.0f);
            if (__builtin_amdgcn_ballot_w64(need) != 0ull) {
                const float delta = need ? rel : 0.f;
                const float alpha = first ? 1.0f : __builtin_amdgcn_exp2f(-delta);
                mrun[qt] += delta; mref += delta;
                lsum[qt] *= alpha;
#pragma unroll
                for (int d = 0; d < 2; ++d)
#pragma unroll
                    for (int i = 0; i < 16; ++i) O[qt][d][i] *= alpha;
            }
            float ps = 0.f;
            if (__builtin_amdgcn_ballot_w64(mref != 0.f) != 0ull) {
#pragma unroll
                for (int kh = 0; kh < 2; ++kh)
#pragma unroll
                    for (int i = 0; i < 16; ++i) { const float pv = __builtin_amdgcn_exp2f(S[kh][i] - mref); S[kh][i] = pv; ps += pv; }
            } else {
#pragma unroll
                for (int kh = 0; kh < 2; ++kh)
#pragma unroll
                    for (int i = 0; i < 16; ++i) { const float pv = __builtin_amdgcn_exp2f(S[kh][i]); S[kh][i] = pv; ps += pv; }
            }
            lsum[qt] += ps;
#pragma unroll
            for (int kh = 0; kh < 2; ++kh)
#pragma unroll
                for (int s2 = 0; s2 < 2; ++s2) {
                    u32x4 w;
                    w.x = pk2(S[kh][8 * s2 + 0], S[kh][8 * s2 + 1]); w.y = pk2(S[kh][8 * s2 + 2], S[kh][8 * s2 + 3]);
                    w.z = pk2(S[kh][8 * s2 + 4], S[kh][8 * s2 + 5]); w.w = pk2(S[kh][8 * s2 + 6], S[kh][8 * s2 + 7]);
                    pf[kh][s2] = __builtin_bit_cast(bf16x8, w);
                }
#pragma unroll
            for (int kh = 0; kh < 2; ++kh)
#pragma unroll
                for (int s2 = 0; s2 < 2; ++s2)
#pragma unroll
                    for (int d = 0; d < 2; ++d) {
                        if (MODE != 0) {
                            const unsigned char* va = cur + (d ? vfo1 : vfo0) + (kh * 32 + 16 * s2) * 128;
                            const s16x4 lo = __builtin_amdgcn_ds_read_tr16_b64_v4i16((__attribute__((address_space(3))) s16x4*)(va));
                            const s16x4 hi = __builtin_amdgcn_ds_read_tr16_b64_v4i16((__attribute__((address_space(3))) s16x4*)(va + 8 * 128));
                            vfr[kh][s2][d] = __builtin_shufflevector(lo, hi, 0, 1, 2, 3, 4, 5, 6, 7);
                        }
                        O[qt][d] = __builtin_amdgcn_mfma_f32_32x32x16_bf16(vfr[kh][s2][d], pf[kh][s2], O[qt][d], 0, 0, 0);
                    }
            }
            if (DIFF) __builtin_amdgcn_sched_barrier(0);
        }
}

template <int DQK, int MODE>
DI void attn_unit(const bf16_t* __restrict__ Qg, const bf16_t* __restrict__ Kg, const bf16_t* __restrict__ Vg, int q0, bf16_t* __restrict__ outp,
                  float slope2, float lam, float outmul, const float* __restrict__ subln, unsigned char* smem, int wv) {
    constexpr bool DIFF = (MODE == 1);
    constexpr int NQT = MODE ? 2 : 1, QW = (MODE == 2) ? 64 : 32, KS = DIFF ? 2 : DQK / 16, KSTR = DQK * 2 + 16, CPR = DQK / 8, KCH = (64 * CPR + NTHR - 1) / NTHR, KBYTES = 64 * 208;
    const int tid = tid_opaque(wv), lane = tid & 63, wid = tid >> 6, r = lane & 31, h = lane >> 5;
    const int qrow = q0 + wid * QW + r;
    bf16x8 qf[NQT][KS];
#pragma unroll
    for (int qt = 0; qt < NQT; ++qt)
#pragma unroll
        for (int ks = 0; ks < KS; ++ks) qf[qt][ks] = *(const bf16x8*)(Qg + (size_t)(qrow + (MODE == 2 ? 32 * qt : 0)) * DQK + (DIFF ? qt * 32 : 0) + ks * 16 + h * 8);
    f32x16 O[NQT][2];
    float mrun[NQT], lsum[NQT];
#pragma unroll
    for (int qt = 0; qt < NQT; ++qt) {
        mrun[qt] = 0.f; lsum[qt] = 0.f;
#pragma unroll
        for (int d = 0; d < 2; ++d)
#pragma unroll
            for (int i = 0; i < 16; ++i) O[qt][d][i] = 0.f;
    }
    int koff[KCH], voff;
    bool kval[KCH];
#pragma unroll
    for (int i = 0; i < KCH; ++i) { const int id = tid + NTHR * i, key = id / CPR, c = id % CPR; koff[i] = key * KSTR + c * 16; kval[i] = id < 64 * CPR; }
    { const int key = tid >> 3, c = tid & 7; voff = KBYTES + key * 128 + ((c ^ (((key >> 1) & 1) << 2)) * 16); }
    const int c0 = DIFF ? (q0 >> 6) : 0;
#define ORD(I) (DIFF ? (((I) < SEQ / 64 - c0) ? c0 + (I) : SEQ / 64 - 1 - (I)) : (I))
    u32x4 rk[KCH], rv;
#pragma unroll
    for (int i = 0; i < KCH; ++i) if (kval[i]) rk[i] = *(const u32x4*)(Kg + (size_t)c0 * 64 * DQK + (size_t)(tid + NTHR * i) * 8);
    rv = *(const u32x4*)(Vg + (size_t)c0 * 64 * 64 + (size_t)tid * 8);
#pragma unroll
    for (int i = 0; i < KCH; ++i) if (kval[i]) *(u32x4*)(smem + koff[i]) = rk[i];
    *(u32x4*)(smem + voff) = rv;
    __syncthreads();
    const int kfo = r * KSTR + h * 16;
    const int qq = (lane >> 2) & 3;
    const int colb0 = ((qq >> 1) & 1) * 64 + 32 * ((lane >> 4) & 1) + 8 * (lane & 3);
    const int vfo0 = KBYTES + (4 * h + qq) * 128 + colb0, vfo1 = KBYTES + (4 * h + qq) * 128 + (colb0 ^ 64);
    const float qpos = (float)qrow;

    u32x4 rk2[KCH], rv2;
#define AT_LOAD(RK, RV, T) { const int ti_ = (T) < SEQ / 64 ? (T) : SEQ / 64 - 1; const int tn_ = ORD(ti_); _Pragma("unroll") for (int i = 0; i < KCH; ++i) RK[i] = *(const u32x4*)(Kg + (size_t)tn_ * 64 * DQK + (size_t)(kval[i] ? tid + NTHR * i : tid) * 8);     RV = *(const u32x4*)(Vg + (size_t)tn_ * 64 * 64 + (size_t)tid * 8); }
#define AT_WRITE(RK, RV, SO) { _Pragma("unroll") for (int i = 0; i < KCH; ++i) if (kval[i]) *(u32x4*)(smem + (SO) + koff[i]) = RK[i]; *(u32x4*)(smem + (SO) + voff) = RV; }
    AT_LOAD(rk2, rv2, 1);
    for (int kt = 0; kt < SEQ / 64; kt += 2) {
        AT_LOAD(rk, rv, kt + 2);
        attn_tile<DQK, MODE>(smem, ORD(kt), kt == 0, O, mrun, lsum, qf, kfo, vfo0, vfo1, qpos, slope2, h);
        AT_WRITE(rk2, rv2, ATT_STAGE);
        __syncthreads();
        AT_LOAD(rk2, rv2, kt + 3);
        attn_tile<DQK, MODE>(smem + ATT_STAGE, ORD(kt + 1), false, O, mrun, lsum, qf, kfo, vfo0, vfo1, qpos, slope2, h);
        AT_WRITE(rk, rv, 0);
        __syncthreads();
    }
#undef AT_LOAD
#undef AT_WRITE
#undef ORD
    const int tid2 = tid_opaque(wv), lane2 = tid2 & 63;
    const int h2 = lane2 >> 5;
    float inv[NQT];
#pragma unroll
    for (int qt = 0; qt < NQT; ++qt) { const float lt = lsum[qt] + shflx(lsum[qt], 32, lane2); inv[qt] = 1.0f / lt; }
    if (MODE == 2) {
#pragma unroll
        for (int qt = 0; qt < NQT; ++qt) {
            const int qrow2 = q0 + ((tid2 >> 6) * QW) + 32 * qt + (lane2 & 31);
            bf16_t* orow = outp + (size_t)qrow2 * XLD;
#pragma unroll
            for (int d = 0; d < 2; ++d)
#pragma unroll
                for (int g = 0; g < 4; ++g) {
                    u32x2 w; w.x = pk2(O[qt][d][4 * g] * inv[qt], O[qt][d][4 * g + 1] * inv[qt]); w.y = pk2(O[qt][d][4 * g + 2] * inv[qt], O[qt][d][4 * g + 3] * inv[qt]);
                    *(u32x2*)(orow + d * 32 + 8 * g + 4 * h2) = w;
                }
        }
        return;
    }
    float o[2][16];
    if (DIFF) {
        float ss = 0.f;
#pragma unroll
        for (int d = 0; d < 2; ++d)
#pragma unroll
            for (int i = 0; i < 16; ++i) { const float x = O[0][d][i] * inv[0] - lam * (O[NQT - 1][d][i] * inv[NQT - 1]); o[d][i] = x; ss += x * x; }
        ss += shflx(ss, 32, lane2);
        const float rstd = rsqrtf(ss * (1.0f / 64.0f) + EPS) * outmul;
#pragma unroll
        for (int d = 0; d < 2; ++d)
#pragma unroll
            for (int i = 0; i < 16; ++i) o[d][i] *= rstd * subln[d * 32 + (i & 3) + 8 * (i >> 2) + 4 * h2];
    } else {
#pragma unroll
        for (int d = 0; d < 2; ++d)
#pragma unroll
            for (int i = 0; i < 16; ++i) o[d][i] = O[0][d][i] * inv[0];
    }
    const int qrow2 = q0 + (lane2 & 31) + ((tid2 >> 6) << 5);
    bf16_t* orow = outp + (size_t)qrow2 * XLD;
#pragma unroll
    for (int d = 0; d < 2; ++d)
#pragma unroll
        for (int g = 0; g < 4; ++g) {
            u32x2 w; w.x = pk2(o[d][4 * g], o[d][4 * g + 1]); w.y = pk2(o[d][4 * g + 2], o[d][4 * g + 3]);
            *(u32x2*)(orow + d * 32 + 8 * g + 4 * h2) = w;
        }
}

DI void attn_phase(const Params& p, int layer, float lam_init, float outmul, unsigned char* smem, int wv) {
    unsigned char* ws = p.ws;
    const bf16_t *QA = (const bf16_t*)(ws + OFF_QA), *KA = (const bf16_t*)(ws + OFF_KA), *VA = (const bf16_t*)(ws + OFF_VA), *QB = (const bf16_t*)(ws + OFF_QB),
                 *KB = (const bf16_t*)(ws + OFF_KB), *VB = (const bf16_t*)(ws + OFF_VB), *QC = (const bf16_t*)(ws + OFF_QC), *KC = (const bf16_t*)(ws + OFF_KC),
                 *VC = (const bf16_t*)(ws + OFF_VC);
    bf16_t* MIX = (bf16_t*)(ws + OFF_MIX);
    float s1 = 0.f, s2 = 0.f;
    for (int j = 0; j < 32; ++j) { s1 += p.lq1[layer * 32 + j] * p.lk1[layer * 32 + j]; s2 += p.lq2[layer * 32 + j] * p.lk2[layer * 32 + j]; }
    const float lam = __int_as_float(__builtin_amdgcn_readfirstlane(__float_as_int(expf(s1) - expf(s2) + lam_init)));
    for (int v = bid_opaque(); v < 1536; v += gridDim.x) {
        const int base = v & ~255, i = v & 255, j = i >> 3;
        const int u = base + ((i & 7) * 2 + (j >> 4)) * 16 + (j & 15);
        if (u < 512) {
            const int qb = u & 15, hh = (u >> 4) & 3, b = u >> 6;
            const size_t ro = (size_t)(b * 4 + hh) * SEQ * 64;
            const float slope2 = __int_as_float(__builtin_amdgcn_readfirstlane(__float_as_int(exp2f(-2.0f * (float)(hh + 1)) * LOG2E)));
            attn_unit<64, 1>(QC + ro, KC + ro, VC + ro, qb * 256, MIX + (size_t)b * SEQ * XLD + 768 + hh * 64, slope2, lam, outmul,
                             p.subln + layer * 64, smem, wv);
        } else if (u < 1024) {
            const int w = u - 512, qb = w & 15, hh = (w >> 4) & 3, b = w >> 6;
            const size_t rq = (size_t)(b * 4 + hh) * SEQ;
            attn_unit<96, 0>(QB + rq * 96, KB + rq * 96, VB + rq * 64, qb * 256, MIX + (size_t)b * SEQ * XLD + 512 + hh * 64, 0.f, 0.f, 0.f, nullptr, smem, wv);
        } else {
            const int w = u - 1024, qb = w & 7, hh = (w >> 3) & 7, b = w >> 6;
            const size_t rq = (size_t)(b * 8 + hh) * SEQ, rk = (size_t)(b * 2 + (hh >> 2)) * SEQ;
            attn_unit<64, 2>(QA + rq * 64, KA + rk * 64, VA + rk * 64, qb * 512, MIX + (size_t)b * SEQ * XLD + hh * 64, 0.f, 0.f, 0.f, nullptr, smem, wv);
        }
    }
}

#define GB_XCNT(j) (64 * (j))
#define GB_XSUB(j) (1024 + 64 * (j))
#define GB_XGEN(j) (2048 + 64 * (j))
#define GB_TOP 3072
#define GB_TOPGEN 3136
constexpr int GB_WORDS = 3200;
DI unsigned gb_ld(unsigned* p) { return __hip_atomic_load(p, __ATOMIC_RELAXED, __HIP_MEMORY_SCOPE_AGENT); }
DI unsigned gb_add(unsigned* p) { return __hip_atomic_fetch_add(p, 1u, __ATOMIC_RELAXED, __HIP_MEMORY_SCOPE_AGENT); }
DI unsigned gb_xcc() { return (unsigned)__builtin_amdgcn_s_getreg((3 << 11) | 20) & 0xFu; }
#define GB_SPIN(cond) { unsigned sp_ = 0; while (cond) { __builtin_amdgcn_s_sleep(1); if (++sp_ > (1u << 24)) break; } }
DI void grid_bar(unsigned* bar, unsigned x, unsigned nloc, unsigned nx, unsigned& ep, int wv) {
    asm volatile("s_waitcnt vmcnt(0)" ::: "memory");
    __syncthreads();
    asm volatile("" : "+s"(nloc), "+s"(nx), "+s"(x));
    unsigned epl = ep; asm volatile("" : "+s"(epl));
    if (tid_opaque(wv) == 0) {
        const unsigned old = gb_add(&bar[GB_XSUB(x)]);
        if (old + 1u == (epl + 1u) * nloc) {
            __builtin_amdgcn_fence(__ATOMIC_RELEASE, "agent");
            asm volatile("s_waitcnt vmcnt(0)" ::: "memory");
            const unsigned og = gb_add(&bar[GB_TOP]);
            if (og + 1u == (epl + 1u) * nx) gb_add(&bar[GB_TOPGEN]);
            else GB_SPIN(gb_ld(&bar[GB_TOPGEN]) == epl);
            __builtin_amdgcn_fence(__ATOMIC_ACQUIRE, "agent");
            gb_add(&bar[GB_XGEN(x)]);
            asm volatile("s_waitcnt vmcnt(0)" ::: "memory");
        } else {
            GB_SPIN(gb_ld(&bar[GB_XGEN(x)]) == epl);
            __builtin_amdgcn_fence(__ATOMIC_ACQUIRE, "agent");
            asm volatile("s_waitcnt vmcnt(0)" ::: "memory");
        }
    }
    ep += 1u;
    __syncthreads();
}

__global__ void __launch_bounds__(NTHR, 2) mega(Params p) {
    extern __shared__ __attribute__((aligned(16))) unsigned char smem[];
    cg::grid_group grid = cg::this_grid();
    unsigned char* ws = p.ws;
    const int gtid = blockIdx.x * NTHR + threadIdx.x, gthreads = gridDim.x * NTHR;
    const int wv = __builtin_amdgcn_readfirstlane((int)(threadIdx.x >> 6));
    bf16_t* XB = (bf16_t*)(ws + OFF_XB);
    float* SSX = (float*)(ws + OFF_SSX);
    float* tab = (float*)(ws + OFF_TAB);

    unsigned* bar = (unsigned*)(ws + OFF_BAR);
    const unsigned myx = gb_xcc();
    if (threadIdx.x == 0) gb_add(&bar[GB_XCNT(myx)]);
    for (int l = 0; l < 2; ++l) {
        prep_weight<false>(p.w_in + (size_t)l * 1024 * INW, p.norm_attn + l * 1024, (bf16_t*)(ws + OFF_WIN) + (size_t)l * INWP * XLD, XLD, 1024, INW, INWP, smem, wv);
        prep_weight<false>(p.w_uq + (size_t)l * 192 * 384, p.qan_b + l * 192, (bf16_t*)(ws + OFF_WUQ) + (size_t)l * 512 * 192, 192, 192, 384, 512, smem, wv);
        prep_weight<false>(p.w_ukv + (size_t)l * 128 * 512, p.kvn_b + l * 128, (bf16_t*)(ws + OFF_WUKV) + (size_t)l * 512 * 128, 128, 128, 512, 512, smem, wv);
        prep_weight<false>(p.w_out + (size_t)l * 1024 * 1024, nullptr, (bf16_t*)(ws + OFF_WOUT) + (size_t)l * 1024 * XLD, XLD, 1024, 1024, 1024, smem, wv);
        prep_weight<true>(p.w_up + (size_t)l * 1024 * DFF2, p.norm_ffn + l * 1024, (bf16_t*)(ws + OFF_WUP) + (size_t)l * DFF2 * XLD, XLD, 1024, DFF2, DFF2, smem, wv);
        prep_weight<false>(p.w_down + (size_t)l * DFF * 1024, nullptr, (bf16_t*)(ws + OFF_WDN) + (size_t)l * 1024 * ALD, ALD, DFF, 1024, 1024, smem, wv);
    }
    for (int idx = gtid; idx < 1024 + 512; idx += gthreads) {
        if (idx < 1024) { const int pos = idx >> 4, f = idx & 15; const float ang = (float)pos * powf(10000.0f, -(float)f / 16.0f); tab[idx] = cosf(ang); tab[1024 + idx] = sinf(ang); }
        else { const int k = idx - 1024, pos = k >> 3, f = k & 7; const float ang = (float)pos * powf(10000.0f, -(float)f / 8.0f); tab[2048 + k] = cosf(ang); tab[2560 + k] = sinf(ang); }
    }
    convert_x(p.x, XB, SSX, wv);
    grid.sync();

    unsigned nloc = 1u, nx = 0u, ep = 0u;
    for (unsigned j = 0; j < 16; ++j) { const unsigned c = gb_ld(&bar[GB_XCNT(j)]); nx += (c > 0u) ? 1u : 0u; nloc = (j == myx) ? c : nloc; }
    nloc = __builtin_amdgcn_readfirstlane(nloc > 0u ? nloc : 1u); nx = __builtin_amdgcn_readfirstlane(nx > 0u ? nx : 1u);
    for (int l = 0; l < 2; ++l) {
        const float lam_init = __int_as_float(__builtin_amdgcn_readfirstlane(__float_as_int((l == 0) ? 0.2f : 0.35550906759096984f)));
        gemm_phase(XB, XLD, (const bf16_t*)(ws + OFF_WIN) + (size_t)l * INWP * XLD, XLD, 1024, M_TOK, INWP, smem,
                   EpiInProj{SSX, tab, p.qn_a + l * 64, p.kn_a + l * 64, (bf16_t*)(ws + OFF_QA), (bf16_t*)(ws + OFF_KA), (bf16_t*)(ws + OFF_VA), (bf16_t*)(ws + OFF_CQ),
                             (bf16_t*)(ws + OFF_CKV), (bf16_t*)(ws + OFF_KB), (bf16_t*)(ws + OFF_QC), (bf16_t*)(ws + OFF_KC), (bf16_t*)(ws + OFF_VC),
                             (float*)(ws + OFF_SSCQ), (float*)(ws + OFF_SSCKV)}, wv);
        grid_bar(bar, myx, nloc, nx, ep, wv);
        gemm_phase((const bf16_t*)(ws + OFF_CQ), 192, (const bf16_t*)(ws + OFF_WUQ) + (size_t)l * 512 * 192, 192, 192, M_TOK, 512, smem,
                   EpiMlaQ{(bf16_t*)(ws + OFF_QB), tab, (const float*)(ws + OFF_SSCQ), 0.10206207261596575f * LOG2E}, wv);
        gemm_phase((const bf16_t*)(ws + OFF_CKV), 128, (const bf16_t*)(ws + OFF_WUKV) + (size_t)l * 512 * 128, 128, 128, M_TOK, 512, smem,
                   EpiMlaKV{(bf16_t*)(ws + OFF_KB), (bf16_t*)(ws + OFF_VB), (const float*)(ws + OFF_SSCKV)}, wv);
        grid_bar(bar, myx, nloc, nx, ep, wv);
        attn_phase(p, l, lam_init, __int_as_float(__builtin_amdgcn_readfirstlane(__float_as_int((l == 0) ? 0.8f : 0.64449093240903016f))), smem, wv);
        grid_bar(bar, myx, nloc, nx, ep, wv);
        if (l == 0) gemm_phase((const bf16_t*)(ws + OFF_MIX), XLD, (const bf16_t*)(ws + OFF_WOUT) + (size_t)l * 1024 * XLD, XLD, 1024, M_TOK, 1024, smem, EpiResid2<true>{p.x, XB, SSX}, wv);
        else gemm_phase((const bf16_t*)(ws + OFF_MIX), XLD, (const bf16_t*)(ws + OFF_WOUT) + (size_t)l * 1024 * XLD, XLD, 1024, M_TOK, 1024, smem, EpiResid2<false>{nullptr, XB, SSX}, wv);
        grid_bar(bar, myx, nloc, nx, ep, wv);
        up_conv_phase(XB, (const bf16_t*)(ws + OFF_WUP) + (size_t)l * DFF2 * XLD, SSX, p.conv_w + (size_t)l * 3 * DFF2, p.conv_b + (size_t)l * DFF2, (bf16_t*)(ws + OFF_ACT), smem, wv, ws + OFF_BAR + GB_WORDS * 4);
        grid_bar(bar, myx, nloc, nx, ep, wv);
        gemm_phase((const bf16_t*)(ws + OFF_ACT), ALD, (const bf16_t*)(ws + OFF_WDN) + (size_t)l * 1024 * ALD, ALD, DFF, M_TOK, 1024, smem, EpiResid2<false>{nullptr, XB, SSX}, wv);
        grid_bar(bar, myx, nloc, nx, ep, wv);
    }
    final_norm(XB, p.out, p.final_norm, SSX, wv);
}

extern "C" void kernel_launch(void* const* d_in, const int* in_sizes, int n_in, void* d_out, int out_size, void* d_ws, size_t ws_size, hipStream_t stream) {
    static int grid_blocks = 0;
    if (!grid_blocks) {
        int dev = 0, cus = 0, per_cu = 0;
        hipGetDevice(&dev);
        hipDeviceGetAttribute(&cus, hipDeviceAttributeMultiprocessorCount, dev);
        hipFuncSetAttribute((const void*)mega, hipFuncAttributeMaxDynamicSharedMemorySize, SMEM_TOTAL);
        hipOccupancyMaxActiveBlocksPerMultiprocessor(&per_cu, mega, NTHR, SMEM_TOTAL);
        if (per_cu > 1) per_cu = 1;
        if (per_cu < 1) per_cu = 1;
        grid_blocks = (cus * per_cu) & ~7;
    }
    Params p{};
    const float** pp = (const float**)&p;
    for (int i = 0; i < 21; ++i) pp[i] = (const float*)d_in[i];
    p.out = (float*)d_out;
    p.ws = (unsigned char*)d_ws;
    hipMemsetAsync((unsigned char*)d_ws + OFF_BAR, 0, GB_WORDS * 4 + 256, stream);
    void* args[] = {&p};
    hipError_t e = hipLaunchCooperativeKernel((void*)mega, dim3(grid_blocks), dim3(NTHR), args, SMEM_TOTAL, stream);
    if (e != hipSuccess) fprintf(stderr, "cooperative launch failed: %s (grid %d)\n", hipGetErrorString(e), grid_blocks);
}
```

```cpp
#include <hip/hip_runtime.h>
#include <hip/hip_cooperative_groups.h>
#include <stdint.h>
#include <math.h>
#include <stdio.h>
namespace cg = cooperative_groups;

typedef unsigned short bf16_t;
typedef short bf16x8 __attribute__((ext_vector_type(8)));
typedef short s16x4 __attribute__((ext_vector_type(4)));
typedef float f32x4 __attribute__((ext_vector_type(4)));
typedef float f32x16 __attribute__((ext_vector_type(16)));
typedef unsigned u32x4 __attribute__((ext_vector_type(4)));
typedef unsigned u32x2 __attribute__((ext_vector_type(2)));
typedef __bf16 bf2_t __attribute__((ext_vector_type(2)));
typedef float f32x2 __attribute__((ext_vector_type(2)));
#define DI __device__ __forceinline__

constexpr int M_TOK = 32768, SEQ = 4096, DM = 1024, INW = 1888, INWP = 2048, DFF = 2816, DFF2 = 5632;
constexpr float EPS = 1e-6f;
constexpr float LOG2E = 1.4426950408889634f;
constexpr int NTHR = 512, NWAVE = NTHR / 64;
constexpr int XLD = 1024 + 64, ALD = DFF + 64;

constexpr size_t SZ_WIN = (size_t)2 * INWP * XLD * 2, SZ_WUQ = (size_t)2 * 512 * 192 * 2, SZ_WUKV = (size_t)2 * 512 * 128 * 2,
                 SZ_WOUT = (size_t)2 * 1024 * XLD * 2, SZ_WUP = (size_t)2 * DFF2 * XLD * 2, SZ_WDN = (size_t)2 * 1024 * ALD * 2;
constexpr size_t OFF_WIN = 0, OFF_WUQ = OFF_WIN + SZ_WIN, OFF_WUKV = OFF_WUQ + SZ_WUQ, OFF_WOUT = OFF_WUKV + SZ_WUKV,
                 OFF_WUP = OFF_WOUT + SZ_WOUT, OFF_WDN = OFF_WUP + SZ_WUP, OFF_TAB = OFF_WDN + SZ_WDN, OFF_XB = OFF_TAB + 16384;
constexpr size_t OFF_SSX = OFF_XB + (size_t)M_TOK * XLD * 2, OFF_SSCQ = OFF_SSX + (size_t)M_TOK * 16 * 4, OFF_SSCKV = OFF_SSCQ + (size_t)M_TOK * 4 * 4,
                 OFF_BIG = OFF_SSCKV + (size_t)M_TOK * 2 * 4;
constexpr size_t OFF_QA = OFF_BIG, OFF_KA = OFF_QA + (size_t)M_TOK * 512 * 2,
                 OFF_VA = OFF_KA + (size_t)M_TOK * 128 * 2, OFF_CQ = OFF_VA + (size_t)M_TOK * 128 * 2, OFF_CKV = OFF_CQ + (size_t)M_TOK * 192 * 2,
                 OFF_QB = OFF_CKV + (size_t)M_TOK * 128 * 2, OFF_KB = OFF_QB + (size_t)M_TOK * 384 * 2, OFF_VB = OFF_KB + (size_t)M_TOK * 384 * 2,
                 OFF_QC = OFF_VB + (size_t)M_TOK * 256 * 2, OFF_KC = OFF_QC + (size_t)M_TOK * 256 * 2, OFF_VC = OFF_KC + (size_t)M_TOK * 256 * 2,
                 OFF_MIX = OFF_VC + (size_t)M_TOK * 256 * 2, OFF_END1 = OFF_MIX + (size_t)M_TOK * XLD * 2;
constexpr size_t OFF_ACT = OFF_BIG, OFF_END2 = OFF_ACT + (size_t)M_TOK * ALD * 2;
constexpr size_t OFF_BAR = ((OFF_END1 > OFF_END2 ? OFF_END1 : OFF_END2) + 255) & ~(size_t)255;
static_assert(OFF_BAR + 16384 <= (size_t)512 * 1024 * 1024, "workspace");

struct Params {
    const float *x, *norm_attn, *w_in, *qn_a, *kn_a, *qan_b, *w_uq, *kvn_b, *w_ukv, *lq1, *lk1, *lq2, *lk2, *subln, *w_out, *norm_ffn, *w_up,
        *conv_w, *conv_b, *w_down, *final_norm;
    float* out;
    unsigned char* ws;
};

DI unsigned pk2(float a, float b) { f32x2 v = {a, b}; bf2_t r = __builtin_convertvector(v, bf2_t); return __builtin_bit_cast(unsigned, r); }
DI void unpack8(u32x4 r, float* v) {
    v[0] = __uint_as_float(r.x << 16); v[1] = __uint_as_float(r.x & 0xffff0000u);
    v[2] = __uint_as_float(r.y << 16); v[3] = __uint_as_float(r.y & 0xffff0000u);
    v[4] = __uint_as_float(r.z << 16); v[5] = __uint_as_float(r.z & 0xffff0000u);
    v[6] = __uint_as_float(r.w << 16); v[7] = __uint_as_float(r.w & 0xffff0000u);
}
DI u32x4 pack8(const float* v) { u32x4 r; r.x = pk2(v[0], v[1]); r.y = pk2(v[2], v[3]); r.z = pk2(v[4], v[5]); r.w = pk2(v[6], v[7]); return r; }
DI int tid_opaque(int wv) { int t; asm volatile("v_mbcnt_lo_u32_b32 %0, -1, 0\n\tv_mbcnt_hi_u32_b32 %0, -1, %0" : "=v"(t)); return t | (wv << 6); }
DI int bid_opaque() { int b = blockIdx.x; asm volatile("" : "+s"(b)); return b; }
DI float shflx(float v, int mask, int lane) { return __int_as_float(__builtin_amdgcn_ds_bpermute((lane ^ mask) << 2, __float_as_int(v))); }
DI float wave_sum(float v, int lane) {
#pragma unroll
    for (int o = 32; o >= 1; o >>= 1) v += shflx(v, o, lane);
    return v;
}

template <bool UPPERM>
DI void prep_weight(const float* __restrict__ W, const float* __restrict__ gain, bf16_t* __restrict__ Wt, int ldw, int K, int N, int Npad, unsigned char* smem, int wv) {
    bf16_t* Ts = (bf16_t*)smem;
    const int tid = tid_opaque(wv);
    const int nkt = K / 64, ntile = (Npad / 64) * nkt;
    for (int t = bid_opaque(); t < ntile; t += gridDim.x) {
        const int n0 = (t / nkt) * 64, k0 = (t % nkt) * 64;
        int ns0 = n0;
        if (UPPERM) { const int j = n0 >> 8, r = n0 & 255; ns0 = (r < 128) ? (128 * j + r) : (DFF + 128 * j + r - 128); }
        const int kr = tid >> 4, nc = (tid & 15) * 4;
        if (n0 + 64 <= N) {
            f32x4 v4[2];
#pragma unroll
            for (int hh = 0; hh < 2; ++hh) v4[hh] = *(const f32x4*)(W + (size_t)(k0 + kr + 32 * hh) * N + ns0 + nc);
#pragma unroll
            for (int hh = 0; hh < 2; ++hh) {
                const float gk = gain ? gain[k0 + kr + 32 * hh] : 1.0f;
#pragma unroll
                for (int e = 0; e < 4; ++e) Ts[(nc + e) * 72 + kr + 32 * hh] = (bf16_t)(pk2(v4[hh][e] * gk, 0.f) & 0xffffu);
            }
        } else {
#pragma unroll
        for (int hh = 0; hh < 2; ++hh) {
            const int k = k0 + kr + 32 * hh;
            const float gk = gain ? gain[k] : 1.0f;
#pragma unroll
            for (int e = 0; e < 4; ++e) {
                const float v = (n0 + nc + e < N) ? W[(size_t)k * N + ns0 + nc + e] * gk : 0.f;
                Ts[(nc + e) * 72 + kr + 32 * hh] = (bf16_t)(pk2(v, 0.f) & 0xffffu);
            }
        }
        }
        __syncthreads();
        { const int n = tid >> 3, kc = tid & 7; *(u32x4*)(Wt + (size_t)(n0 + n) * ldw + k0 + kc * 8) = *(const u32x4*)(Ts + n * 72 + kc * 8); }
        __syncthreads();
    }
}

DI void convert_x(const float* X, bf16_t* XB, float* SSX, int wv) {
    const int tid_ = tid_opaque(wv);
    const int lane = tid_ & 63, gw = bid_opaque() * NWAVE + (tid_ >> 6), nw = gridDim.x * NWAVE;
    for (int row = gw; row < M_TOK; row += nw) {
        const f32x4* xr = (const f32x4*)(X + (size_t)row * 1024);
        float ss = 0.f;
#pragma unroll
        for (int i = 0; i < 4; ++i) {
            const f32x4 v = xr[lane + 64 * i];
            ss += v[0] * v[0] + v[1] * v[1] + v[2] * v[2] + v[3] * v[3];
            u32x2 w; w.x = pk2(v[0], v[1]); w.y = pk2(v[2], v[3]);
            *(u32x2*)(XB + (size_t)row * XLD + (lane + 64 * i) * 4) = w;
        }
        ss = wave_sum(ss, lane);
        if (lane < 16) SSX[(size_t)row * 16 + lane] = (lane == 0) ? ss : 0.f;
    }
}
DI void final_norm(const bf16_t* XB, float* Out, const float* __restrict__ g, const float* SSX, int wv) {
    const int tid_ = tid_opaque(wv);
    const int lane = tid_ & 63, gw = bid_opaque() * NWAVE + (tid_ >> 6), nw = gridDim.x * NWAVE;
    for (int row = gw; row < M_TOK; row += nw) {
        float ss = (lane < 16) ? SSX[(size_t)row * 16 + lane] : 0.f;
        ss = wave_sum(ss, lane);
        const float rstd = rsqrtf(ss * (1.0f / 1024.0f) + EPS);
        f32x4* orow = (f32x4*)(Out + (size_t)row * 1024);
#pragma unroll
        for (int i = 0; i < 4; ++i) {
            const u32x2 w = *(const u32x2*)(XB + (size_t)row * XLD + (lane + 64 * i) * 4);
            f32x4 r; r[0] = __uint_as_float(w.x << 16); r[1] = __uint_as_float(w.x & 0xffff0000u); r[2] = __uint_as_float(w.y << 16); r[3] = __uint_as_float(w.y & 0xffff0000u);
            const f32x4 gv = ((const f32x4*)g)[lane + 64 * i];
            orow[lane + 64 * i] = r * rstd * gv;
        }
    }
}
DI float row_rstd(const float* ssx, int m) {
    const f32x4* pp = (const f32x4*)(ssx + (size_t)m * 16);
    const f32x4 a = (pp[0] + pp[1]) + (pp[2] + pp[3]);
    return rsqrtf(((a[0] + a[1]) + (a[2] + a[3])) * (1.0f / 1024.0f) + EPS);
}

constexpr int GSTR = 128, GOP = 256 * GSTR;
constexpr int SMEM_BYTES = 4 * GOP;
constexpr int SMEM_CONV = 256 * 264 * 2;
constexpr int SMEM_TOTAL = SMEM_CONV > SMEM_BYTES ? SMEM_CONV : SMEM_BYTES;

DI void gemm_mainloop(const bf16_t* __restrict__ Ab, const unsigned (&aoff)[4], const bool (&av)[4], const bf16_t* __restrict__ Bb, unsigned boff, int ldb, int nk, unsigned char* smem, f32x4 (&acc)[8][4], int tid,
                      const unsigned char* zline) {
    const int lane = tid & 63, wid = tid >> 6, wr = wid >> 2, wc = wid & 3;
#pragma unroll
    for (int i = 0; i < 8; ++i)
#pragma unroll
        for (int j = 0; j < 4; ++j) acc[i][j] = (f32x4){0.f, 0.f, 0.f, 0.f};
#define G_DMA(KT, BUF) { _Pragma("unroll") for (int i = 0; i < 4; ++i) { \
        const unsigned char* ga_ = av[i] ? ((const unsigned char*)Ab + (size_t)(aoff[i] + (unsigned)((KT) * 128))) : zline; \
        __builtin_amdgcn_global_load_lds((const unsigned*)ga_, (unsigned*)(smem + (BUF) * 2 * GOP + i * 8192 + tid * 16), 16, 0, 0); \
        __builtin_amdgcn_global_load_lds((const unsigned*)((const unsigned char*)Bb + (size_t)(boff + (unsigned)(i * 128 * ldb) + (unsigned)((KT) * 128))), (unsigned*)(smem + (BUF) * 2 * GOP + GOP + i * 8192 + tid * 16), 16, 0, 0); } }
    const int foff = (lane & 15) * GSTR;
    const int fsw[2] = {(((lane >> 4)) ^ (lane & 7)) << 4, (((lane >> 4) + 4) ^ (lane & 7)) << 4};
    G_DMA(0, 0);
    __syncthreads();
    for (int kt = 0; kt < nk; ++kt) {
        { const int kl = (kt + 1 < nk) ? kt + 1 : nk - 1; G_DMA(kl, (kt + 1) & 1); }
        const unsigned char* sa = smem + (kt & 1) * 2 * GOP + wr * 128 * GSTR + foff;
        const unsigned char* sb = smem + (kt & 1) * 2 * GOP + GOP + wc * 64 * GSTR + foff;
#pragma unroll
        for (int kk = 0; kk < 2; ++kk) {
            bf16x8 af[8], bfr[4];
#pragma unroll
            for (int i = 0; i < 4; ++i) bfr[i] = *(const bf16x8*)(sb + i * 16 * GSTR + fsw[kk]);
#pragma unroll
            for (int i = 0; i < 8; ++i) af[i] = *(const bf16x8*)(sa + i * 16 * GSTR + fsw[kk]);
#pragma unroll
            for (int mi = 0; mi < 8; ++mi)
#pragma unroll
                for (int ni = 0; ni < 4; ++ni) acc[mi][ni] = __builtin_amdgcn_mfma_f32_16x16x32_bf16(bfr[ni], af[mi], acc[mi][ni], 0, 0, 0);
        }
        __builtin_amdgcn_sched_group_barrier(0x100, 12, 0);
#pragma unroll
        for (int g = 0; g < 12; ++g) { __builtin_amdgcn_sched_group_barrier(0x008, 2, 0); __builtin_amdgcn_sched_group_barrier(0x100, 1, 0); }
        __builtin_amdgcn_sched_group_barrier(0x008, 40, 0);
        __syncthreads();
    }
#undef G_DMA
}

template <class Epi>
DI void gemm_tile(const bf16_t* __restrict__ A, int lda, const bf16_t* __restrict__ Bt, int ldb, int K, int m0, int n0, unsigned char* smem, const Epi& epi, int wv) {
    const int tid = tid_opaque(wv), lane = tid & 63, wid = tid >> 6, wr = wid >> 2, wc = wid & 3;
    const int lrow = tid >> 3, lc = tid & 7;
    unsigned aoff[4];
    const bool av[4] = {true, true, true, true};
#pragma unroll
    for (int i = 0; i < 4; ++i) aoff[i] = (unsigned)((lrow + 64 * i) * lda + (lc ^ (lrow & 7)) * 8) * 2u;
    const unsigned boff = (unsigned)(lrow * ldb + (lc ^ (lrow & 7)) * 8) * 2u;
    f32x4 acc[8][4];
    gemm_mainloop(A + (size_t)m0 * lda, aoff, av, Bt + (size_t)n0 * ldb, boff, ldb, K / 64, smem, acc, tid, nullptr);
    epi(acc, m0 + wr * 128, n0 + wc * 64, lane);
}

template <class Epi>
DI void gemm_phase(const bf16_t* A, int lda, const bf16_t* Bt, int ldb, int K, int Mrows, int Ncols, unsigned char* smem, const Epi& epi, int wv) {
    const int nN = Ncols / 256, nM = Mrows / 256;
    const int bid = bid_opaque(), G = gridDim.x;
    const int xcd = bid & 7, lb = bid >> 3, nlb = G >> 3, mper = nM >> 3, nloc = mper * nN;
    for (int j = lb; j < nloc; j += nlb) {
        const int g = j / (8 * nN), rem = j - g * 8 * nN;
        const int mt = xcd * mper + g * 8 + (rem & 7), nt = rem >> 3;
        gemm_tile(A, lda, Bt, ldb, K, mt * 256, nt * 256, smem, epi, wv);
    }
}

DI float dot4(f32x4 a) { return (a[0] * a[0] + a[1] * a[1]) + (a[2] * a[2] + a[3] * a[3]); }
DI void st4bf(bf16_t* dst, f32x4 v) { u32x2 w; w.x = pk2(v[0], v[1]); w.y = pk2(v[2], v[3]); *(u32x2*)dst = w; }

template <bool XIN_F32>
struct EpiResid2 {
    const float* Xin; bf16_t* XB; float* SSX;
    DI void operator()(const f32x4 (&acc)[8][4], int mb, int nb, int lane) const {
        const int q = lane >> 4;
        u32x2 xin[XIN_F32 ? 1 : 8][4];
        if (!XIN_F32) {
#pragma unroll
            for (int mi = 0; mi < 8; ++mi)
#pragma unroll
                for (int ni = 0; ni < 4; ++ni) xin[mi][ni] = *(const u32x2*)(XB + (size_t)(mb + mi * 16 + (lane & 15)) * XLD + nb + ni * 16 + q * 4);
        }
#pragma unroll
        for (int mi = 0; mi < 8; ++mi) {
            const int m = mb + mi * 16 + (lane & 15);
            float ss = 0.f;
#pragma unroll
            for (int ni = 0; ni < 4; ++ni) {
                const int col = nb + ni * 16 + q * 4;
                bf16_t* xb = XB + (size_t)m * XLD + col;
                f32x4 r;
                if (XIN_F32) r = *(const f32x4*)(Xin + (size_t)m * 1024 + col);
                else { const u32x2 w = xin[XIN_F32 ? 0 : mi][ni]; r[0] = __uint_as_float(w.x << 16); r[1] = __uint_as_float(w.x & 0xffff0000u); r[2] = __uint_as_float(w.y << 16); r[3] = __uint_as_float(w.y & 0xffff0000u); }
                r += acc[mi][ni];
                st4bf(xb, r);
                ss += dot4(r);
            }
            ss += shflx(ss, 16, lane); ss += shflx(ss, 32, lane);
            if (q == 0) SSX[(size_t)m * 16 + (nb >> 6)] = ss;
        }
    }
};

struct EpiInProj {
    const float *ssx, *tab, *gq, *gk;
    bf16_t *QA, *KA, *VA, *CQ, *CKV, *KB, *QC, *KC, *VC;
    float *sscq, *ssckv;
    DI void operator()(const f32x4 (&acc)[8][4], int mb, int nb, int lane) const {
        const int q = lane >> 4, ml = lane & 15;
        const float qsA = 0.125f * LOG2E, qsC = 0.17677669529663687f * LOG2E;
        float rsv[8];
#pragma unroll
        for (int mi = 0; mi < 8; ++mi) rsv[mi] = row_rstd(ssx, mb + mi * 16 + ml);
        if (nb < 640) {
            const bool isq = nb < 512;
            const int head = isq ? (nb >> 6) : ((nb - 512) >> 6);
            const float* g = isq ? gq : gk;
            f32x4 gv[4];
#pragma unroll
            for (int ni = 0; ni < 4; ++ni) gv[ni] = *(const f32x4*)(g + ni * 16 + q * 4);
#pragma unroll
            for (int mi = 0; mi < 8; ++mi) {
                const int m = mb + mi * 16 + ml, b = m >> 12, s = m & 4095;
                const float rs = rsv[mi];
                f32x4 v[4];
                float ss = 0.f;
#pragma unroll
                for (int ni = 0; ni < 4; ++ni) { v[ni] = acc[mi][ni] * rs; ss += dot4(v[ni]); }
                ss += shflx(ss, 16, lane); ss += shflx(ss, 32, lane);
                const float r2 = rsqrtf(ss * (1.0f / 64.0f) + EPS);
#pragma unroll
                for (int ni = 0; ni < 4; ++ni) v[ni] = v[ni] * r2 * gv[ni];
                const float* tr = tab + (s >> 6) * 16 + q * 4;
                const float* tq = tab + (s & 63) * 16 + q * 4;
                const f32x4 c0 = *(const f32x4*)tr, s0 = *(const f32x4*)(tr + 1024), c1 = *(const f32x4*)tq, s1 = *(const f32x4*)(tq + 1024);
                f32x4 o0 = v[0] * c0 - v[1] * s0, o1 = v[1] * c0 + v[0] * s0, o2 = v[2] * c1 - v[3] * s1, o3 = v[3] * c1 + v[2] * s1;
                bf16_t* dst;
                if (isq) { o0 *= qsA; o1 *= qsA; o2 *= qsA; o3 *= qsA; dst = QA + ((size_t)(b * 8 + head) * SEQ + s) * 64 + q * 4; }
                else dst = KA + ((size_t)(b * 2 + head) * SEQ + s) * 64 + q * 4;
                st4bf(dst, o0); st4bf(dst + 16, o1); st4bf(dst + 32, o2); st4bf(dst + 48, o3);
            }
        } else if (nb < 768) {
            const int head = (nb - 640) >> 6;
#pragma unroll
            for (int mi = 0; mi < 8; ++mi) {
                const int m = mb + mi * 16 + ml, b = m >> 12, s = m & 4095;
                const float rs = rsv[mi];
                bf16_t* dst = VA + ((size_t)(b * 2 + head) * SEQ + s) * 64 + q * 4;
#pragma unroll
                for (int ni = 0; ni < 4; ++ni) st4bf(dst + ni * 16, acc[mi][ni] * rs);
            }
        } else {
            const bool sq = nb < 1088;
#pragma unroll
            for (int mi = 0; mi < 8; ++mi) {
                const int m = mb + mi * 16 + ml, b = m >> 12, s = m & 4095;
                const float rs = rsv[mi];
                float ss = 0.f;
#pragma unroll
                for (int ni = 0; ni < 4; ++ni) {
                    const int n16 = nb + ni * 16;
                    f32x4 v = acc[mi][ni] * rs;
                    if (n16 < 960) { st4bf(CQ + (size_t)m * 192 + (n16 - 768) + q * 4, v); ss += dot4(v); }
                    else if (n16 < 1088) { st4bf(CKV + (size_t)m * 128 + (n16 - 960) + q * 4, v); ss += dot4(v); }
                    else if (n16 < 1120) {
                        f32x4 pr;
#pragma unroll
                        for (int i = 0; i < 4; ++i) pr[i] = shflx(v[i], 32, lane);
                        const int pos = (n16 >= 1104) ? (s & 63) : (s >> 6);
                        const float* tc = tab + 2048 + pos * 8 + (q & 1) * 4;
                        const f32x4 c = *(const f32x4*)tc, sn = *(const f32x4*)(tc + 512);
                        const f32x4 o = (q < 2) ? (v * c - pr * sn) : (v * c + pr * sn);
#pragma unroll
                        for (int hh = 0; hh < 4; ++hh) st4bf(KB + ((size_t)(b * 4 + hh) * SEQ + s) * 96 + 64 + (n16 - 1088) + q * 4, o);
                    } else if (n16 < 1376) { const int c = n16 - 1120 + q * 4; st4bf(QC + ((size_t)(b * 4 + (c >> 6)) * SEQ + s) * 64 + (c & 63), v * qsC); }
                    else if (n16 < 1632) { const int c = n16 - 1376 + q * 4; st4bf(KC + ((size_t)(b * 4 + (c >> 6)) * SEQ + s) * 64 + (c & 63), v); }
                    else if (n16 < 1888) { const int c = n16 - 1632 + q * 4; st4bf(VC + ((size_t)(b * 4 + (c >> 6)) * SEQ + s) * 64 + (c & 63), v); }
                }
                if (sq) {
                    ss += shflx(ss, 16, lane); ss += shflx(ss, 32, lane);
                    if (q == 0) { if (nb < 960) sscq[(size_t)m * 4 + ((nb - 768) >> 6)] = ss; else ssckv[(size_t)m * 2 + ((nb - 960) >> 6)] = ss; }
                }
            }
        }
    }
};
struct EpiMlaQ {
    bf16_t* QB; const float* tab; const float* sscq; float qscale;
    DI void operator()(const f32x4 (&acc)[8][4], int mb, int nb, int lane) const {
#pragma unroll
        for (int mi = 0; mi < 8; ++mi) {
            const int m = mb + mi * 16 + (lane & 15), q = lane >> 4, b = m >> 12, s = m & 4095;
            const f32x4 sp = *(const f32x4*)(sscq + (size_t)m * 4);
            const float rs = rsqrtf((sp[0] + sp[1] + sp[2]) * (1.0f / 192.0f) + EPS) * qscale;
#pragma unroll
            for (int ni = 0; ni < 4; ++ni) {
                const int nt = nb + ni * 16;
                if (nt >= 384) continue;
                const int head = nt / 96, dt = nt - head * 96;
                f32x4 v = acc[mi][ni] * rs;
                f32x4 pr;
#pragma unroll
                for (int i = 0; i < 4; ++i) pr[i] = shflx(v[i], 32, lane);
                if (dt >= 64) {
                    const int pos = (dt >= 80) ? (s & 63) : (s >> 6);
                    const float* tc = tab + 2048 + pos * 8 + (q & 1) * 4;
                    const f32x4 c = *(const f32x4*)tc, sn = *(const f32x4*)(tc + 512);
                    v = (q < 2) ? (v * c - pr * sn) : (v * c + pr * sn);
                }
                st4bf(QB + ((size_t)(b * 4 + head) * SEQ + s) * 96 + dt + q * 4, v);
            }
        }
    }
};
struct EpiMlaKV {
    bf16_t* KB; bf16_t* VB; const float* ssckv;
    DI void operator()(const f32x4 (&acc)[8][4], int mb, int nb, int lane) const {
#pragma unroll
        for (int mi = 0; mi < 8; ++mi) {
            const int m = mb + mi * 16 + (lane & 15), b = m >> 12, s = m & 4095;
            const f32x2 sp = *(const f32x2*)(ssckv + (size_t)m * 2);
            const float rs = rsqrtf((sp[0] + sp[1]) * (1.0f / 128.0f) + EPS);
#pragma unroll
            for (int ni = 0; ni < 4; ++ni) {
                const int n = nb + ni * 16 + (lane >> 4) * 4;
                const int head = n >> 7, d = n & 127;
                const size_t rowi = (size_t)(b * 4 + head) * SEQ + s;
                if (d < 64) st4bf(KB + rowi * 96 + d, acc[mi][ni] * rs);
                else st4bf(VB + rowi * 64 + (d - 64), acc[mi][ni] * rs);
            }
        }
    }
};

DI void up_conv_tile(const bf16_t* __restrict__ XB, const bf16_t* __restrict__ Wt, const float* __restrict__ ssx, const float* __restrict__ cw, const float* __restrict__ cb,
                     bf16_t* __restrict__ ACT, int b, int jt, int nt, unsigned char* smem, int wv, const unsigned char* zline) {
    const int tid = tid_opaque(wv), lane = tid & 63, wid = tid >> 6, wr = wid >> 2, wc = wid & 3;
    const int lrow = tid >> 3, lc = tid & 7;
    const int tbase = jt * 254 - 1;
    unsigned aoff[4];
    bool av[4];
#pragma unroll
    for (int i = 0; i < 4; ++i) {
        const int tl = tbase + lrow + 64 * i;
        av[i] = (unsigned)tl < 4096u;
        const int tc = tl < 0 ? 0 : (tl > 4095 ? 4095 : tl);
        aoff[i] = (unsigned)(tc * XLD + (lc ^ (lrow & 7)) * 8) * 2u;
    }
    const unsigned boff = (unsigned)(lrow * XLD + (lc ^ (lrow & 7)) * 8) * 2u;
    f32x4 acc[8][4];
    gemm_mainloop(XB + (size_t)b * SEQ * XLD, aoff, av, Wt + (size_t)nt * 256 * XLD, boff, XLD, 16, smem, acc, tid, zline);
    bf16_t* T = (bf16_t*)smem;
    constexpr int TLD = 264;
    {
        const int q = lane >> 4, ml = lane & 15;
        float rsv[8];
#pragma unroll
        for (int mi = 0; mi < 8; ++mi) { const int tl = tbase + wr * 128 + mi * 16 + ml; const int tc = tl < 0 ? 0 : (tl > 4095 ? 4095 : tl); rsv[mi] = row_rstd(ssx, b * SEQ + tc); }
#pragma unroll
        for (int mi = 0; mi < 8; ++mi) {
            const int il = wr * 128 + mi * 16 + ml;
            const float rs = rsv[mi];
#pragma unroll
            for (int ni = 0; ni < 4; ++ni) st4bf(T + il * TLD + wc * 64 + ni * 16 + q * 4, acc[mi][ni] * rs);
        }
    }
    __syncthreads();
    {
        const int cq = tid & 31, rg = tid >> 5, ch = nt * 128 + cq * 4;
        const f32x4 wg0 = *(const f32x4*)(cw + ch), wg1 = *(const f32x4*)(cw + DFF2 + ch), wg2 = *(const f32x4*)(cw + 2 * DFF2 + ch), bg = *(const f32x4*)(cb + ch);
        const f32x4 wv0 = *(const f32x4*)(cw + DFF + ch), wv1 = *(const f32x4*)(cw + DFF2 + DFF + ch), wv2 = *(const f32x4*)(cw + 2 * DFF2 + DFF + ch), bv = *(const f32x4*)(cb + DFF + ch);
#define LD4(R, C) ({ const u32x2 w_ = *(const u32x2*)(T + (R) * TLD + (C)); f32x4 r_; r_[0] = __uint_as_float(w_.x << 16); r_[1] = __uint_as_float(w_.x & 0xffff0000u); r_[2] = __uint_as_float(w_.y << 16); r_[3] = __uint_as_float(w_.y & 0xffff0000u); r_; })
        const int r0 = rg * 16, rm = r0 > 0 ? r0 - 1 : 0;
        f32x4 gm = LD4(rm, cq * 4), vm = LD4(rm, 128 + cq * 4);
        f32x4 g0 = LD4(r0, cq * 4), v0 = LD4(r0, 128 + cq * 4);
#pragma unroll
        for (int rr = 0; rr < 16; ++rr) {
            const int r = r0 + rr, rp = r < 255 ? r + 1 : 255;
            const f32x4 gp = LD4(rp, cq * 4), vp = LD4(rp, 128 + cq * 4);
            const f32x4 gg = wg0 * gm + wg1 * g0 + wg2 * gp + bg;
            const f32x4 vv = wv0 * vm + wv1 * v0 + wv2 * vp + bv;
            f32x4 o;
#pragma unroll
            for (int e = 0; e < 4; ++e) o[e] = gg[e] * __builtin_amdgcn_rcpf(1.0f + __builtin_amdgcn_exp2f(-LOG2E * gg[e])) * vv[e];
            const int tl = tbase + r;
            if (r >= 1 && r <= 254 && tl <= 4095) st4bf(ACT + ((size_t)b * SEQ + tl) * ALD + ch, o);
            gm = g0; g0 = gp; vm = v0; v0 = vp;
        }
#undef LD4
    }
    __syncthreads();
}
DI void up_conv_phase(const bf16_t* XB, const bf16_t* Wt, const float* ssx, const float* cw, const float* cb, bf16_t* ACT, unsigned char* smem, int wv, const unsigned char* zline) {
    constexpr int NT = DFF / 128, MT = 17;
    const int bid = bid_opaque(), G = gridDim.x;
    const int xcd = bid & 7, lb = bid >> 3, nlb = G >> 3, nloc = MT * NT, full = (MT / 4) * 4 * NT, gs = MT - (MT / 4) * 4;
    for (int j = lb; j < nloc; j += nlb) {
        int jt, nt;
        if (j < full) { const int g = j / (4 * NT), rem = j - g * 4 * NT; jt = g * 4 + (rem & 3); nt = rem >> 2; }
        else { const int j2 = j - full; jt = (MT / 4) * 4 + j2 % gs; nt = j2 / gs; }
        up_conv_tile(XB, Wt, ssx, cw, cb, ACT, xcd, jt, nt, smem, wv, zline);
    }
}

constexpr int ATT_STAGE = 64 * 208 + 8192;

template <int DQK, int MODE>
DI void attn_tile(const unsigned char* cur, int kt, bool first, f32x16 (&O)[MODE ? 2 : 1][2], float (&mrun)[MODE ? 2 : 1], float (&lsum)[MODE ? 2 : 1], const bf16x8 (&qf)[MODE ? 2 : 1][MODE == 1 ? 2 : DQK / 16],
               int kfo, int vfo0, int vfo1, float qpos, float slope2, int h) {
    constexpr bool DIFF = (MODE == 1);
    constexpr int NQT = MODE ? 2 : 1, KS = DIFF ? 2 : DQK / 16, KSTR = DQK * 2 + 16;
        bf16x8 kfr[2][KS], vfr[2][2][2];
#pragma unroll
        for (int kh = 0; kh < 2; ++kh)
#pragma unroll
            for (int ks = 0; ks < KS; ++ks) kfr[kh][ks] = *(const bf16x8*)(cur + kfo + kh * 32 * KSTR + (ks * 16) * 2);
        if (MODE == 0) {
#pragma unroll
            for (int kh = 0; kh < 2; ++kh)
#pragma unroll
                for (int s2 = 0; s2 < 2; ++s2)
#pragma unroll
                    for (int d = 0; d < 2; ++d) {
                        const unsigned char* va = cur + (d ? vfo1 : vfo0) + (kh * 32 + 16 * s2) * 128;
                        const s16x4 lo = __builtin_amdgcn_ds_read_tr16_b64_v4i16((__attribute__((address_space(3))) s16x4*)(va));
                        const s16x4 hi = __builtin_amdgcn_ds_read_tr16_b64_v4i16((__attribute__((address_space(3))) s16x4*)(va + 8 * 128));
                        vfr[kh][s2][d] = __builtin_shufflevector(lo, hi, 0, 1, 2, 3, 4, 5, 6, 7);
                    }
        }
        __builtin_amdgcn_sched_barrier(0);
#pragma unroll
        for (int qt = 0; qt < NQT; ++qt) {
            bf16x8 pf[2][2];
            f32x16 S[2];
#pragma unroll
            for (int kh = 0; kh < 2; ++kh) {
#pragma unroll
                for (int i = 0; i < 16; ++i) S[kh][i] = 0.f;
#pragma unroll
                for (int ks = 0; ks < KS; ++ks) S[kh] = __builtin_amdgcn_mfma_f32_32x32x16_bf16(kfr[kh][ks], qf[qt][ks], S[kh], 0, 0, 0);
            }
            if (DIFF && qt == 0) {
#pragma unroll
                for (int kh = 0; kh < 2; ++kh)
#pragma unroll
                    for (int ks = 0; ks < KS; ++ks) kfr[kh][ks] = *(const bf16x8*)(cur + kfo + kh * 32 * KSTR + (32 + ks * 16) * 2);
            }
            float kd = 0.f;
            if (DIFF) {
                const float d0 = qpos - (float)(kt * 64 + 4 * h);
                const unsigned long long bl = __builtin_amdgcn_ballot_w64(d0 >= 59.0f), br = __builtin_amdgcn_ballot_w64(d0 <= 0.0f);
                if (bl == ~0ull) {
                    kd = slope2 * d0;
#pragma unroll
                    for (int kh = 0; kh < 2; ++kh)
#pragma unroll
                        for (int i = 0; i < 16; ++i) S[kh][i] = S[kh][i] + slope2 * (float)(kh * 32 + (i & 3) + 8 * (i >> 2));
                } else if (br == ~0ull) {
                    kd = -slope2 * d0;
#pragma unroll
                    for (int kh = 0; kh < 2; ++kh)
#pragma unroll
                        for (int i = 0; i < 16; ++i) S[kh][i] = S[kh][i] - slope2 * (float)(kh * 32 + (i & 3) + 8 * (i >> 2));
                } else {
#pragma unroll
                    for (int kh = 0; kh < 2; ++kh)
#pragma unroll
                        for (int i = 0; i < 16; ++i) S[kh][i] -= slope2 * fabsf(d0 - (float)(kh * 32 + (i & 3) + 8 * (i >> 2)));
                }
            }
            float mx = __builtin_elementwise_maximum(S[0][0], S[1][0]);
#pragma unroll
            for (int i = 1; i < 16; ++i) mx = __builtin_elementwise_maximum(mx, __builtin_elementwise_maximum(S[0][i], S[1][i]));
            mx -= kd;
            { const auto sw = __builtin_amdgcn_permlane32_swap(__float_as_uint(mx), __float_as_uint(mx), false, false); mx = __builtin_elementwise_maximum(__uint_as_float(sw[0]), __uint_as_float(sw[1])); }
            float mref = mrun[qt] + kd;
            const float rel = mx - mrun[qt];
            const bool dead = DIFF && !first && (__builtin_amdgcn_ballot_w64(rel < -160.0f) == ~0ull);
            if (!dead) {
            const bool need = (rel > 8.0f) || (first && rel < -8.0f);
            if (__builtin_amdgcn_ballot_w64(need) != 0ull) {
                const float delta = need ? rel : 0.f;
                const float alpha = first ? 1.0f : __builtin_amdgcn_exp2f(-delta);
                mrun[qt] += delta; mref += delta;
                lsum[qt] *= alpha;
#pragma unroll
                for (int d = 0; d < 2; ++d)
#pragma unroll
                    for (int i = 0; i < 16; ++i) O[qt][d][i] *= alpha;
            }
            float ps = 0.f;
            if (__builtin_amdgcn_ballot_w64(mref != 0.f) != 0ull) {
#pragma unroll
                for (int kh = 0; kh < 2; ++kh)
#pragma unroll
                    for (int i = 0; i < 16; ++i) { const float pv = __builtin_amdgcn_exp2f(S[kh][i] - mref); S[kh][i] = pv; ps += pv; }
            } else {
#pragma unroll
                for (int kh = 0; kh < 2; ++kh)
#pragma unroll
                    for (int i = 0; i < 16; ++i) { const float pv = __builtin_amdgcn_exp2f(S[kh][i]); S[kh][i] = pv; ps += pv; }
            }
            lsum[qt] += ps;
#pragma unroll
            for (int kh = 0; kh < 2; ++kh)
#pragma unroll
                for (int s2 = 0; s2 < 2; ++s2) {
                    u32x4 w;
                    w.x = pk2(S[kh][8 * s2 + 0], S[kh][8 * s2 + 1]); w.y = pk2(S[kh][8 * s2 + 2], S[kh][8 * s2 + 3]);
                    w.z = pk2(S[kh][8 * s2 + 4], S[kh][8 * s2 + 5]); w.w = pk2(S[kh][8 * s2 + 6], S[kh][8 * s2 + 7]);
                    pf[kh][s2] = __builtin_bit_cast(bf16x8, w);
                }
#pragma unroll
            for (int kh = 0; kh < 2; ++kh)
#pragma unroll
                for (int s2 = 0; s2 < 2; ++s2)
#pragma unroll
                    for (int d = 0; d < 2; ++d) {
                        if (MODE != 0) {
                            const unsigned char* va = cur + (d ? vfo1 : vfo0) + (kh * 32 + 16 * s2) * 128;
                            const s16x4 lo = __builtin_amdgcn_ds_read_tr16_b64_v4i16((__attribute__((address_space(3))) s16x4*)(va));
                            const s16x4 hi = __builtin_amdgcn_ds_read_tr16_b64_v4i16((__attribute__((address_space(3))) s16x4*)(va + 8 * 128));
                            vfr[kh][s2][d] = __builtin_shufflevector(lo, hi, 0, 1, 2, 3, 4, 5, 6, 7);
                        }
                        O[qt][d] = __builtin_amdgcn_mfma_f32_32x32x16_bf16(vfr[kh][s2][d], pf[kh][s2], O[qt][d], 0, 0, 0);
                    }
            }
            if (DIFF) __builtin_amdgcn_sched_barrier(0);
        }
}

template <int DQK, int MODE>
DI void attn_unit(const bf16_t* __restrict__ Qg, const bf16_t* __restrict__ Kg, const bf16_t* __restrict__ Vg, int q0, bf16_t* __restrict__ outp,
                  float slope2, float lam, float outmul, const float* __restrict__ subln, unsigned char* smem, int wv) {
    constexpr bool DIFF = (MODE == 1);
    constexpr int NQT = MODE ? 2 : 1, QW = (MODE == 2) ? 64 : 32, KS = DIFF ? 2 : DQK / 16, KSTR = DQK * 2 + 16, CPR = DQK / 8, KCH = (64 * CPR + NTHR - 1) / NTHR, KBYTES = 64 * 208;
    const int tid = tid_opaque(wv), lane = tid & 63, wid = tid >> 6, r = lane & 31, h = lane >> 5;
    const int qrow = q0 + wid * QW + r;
    bf16x8 qf[NQT][KS];
#pragma unroll
    for (int qt = 0; qt < NQT; ++qt)
#pragma unroll
        for (int ks = 0; ks < KS; ++ks) qf[qt][ks] = *(const bf16x8*)(Qg + (size_t)(qrow + (MODE == 2 ? 32 * qt : 0)) * DQK + (DIFF ? qt * 32 : 0) + ks * 16 + h * 8);
    f32x16 O[NQT][2];
    float mrun[NQT], lsum[NQT];
#pragma unroll
    for (int qt = 0; qt < NQT; ++qt) {
        mrun[qt] = 0.f; lsum[qt] = 0.f;
#pragma unroll
        for (int d = 0; d < 2; ++d)
#pragma unroll
            for (int i = 0; i < 16; ++i) O[qt][d][i] = 0.f;
    }
    int koff[KCH], voff;
    bool kval[KCH];
#pragma unroll
    for (int i = 0; i < KCH; ++i) { const int id = tid + NTHR * i, key = id / CPR, c = id % CPR; koff[i] = key * KSTR + c * 16; kval[i] = id < 64 * CPR; }
    { const int key = tid >> 3, c = tid & 7; voff = KBYTES + key * 128 + ((c ^ (((key >> 1) & 1) << 2)) * 16); }
    const int c0 = DIFF ? (q0 >> 6) : 0;
#define ORD(I) (DIFF ? (((I) < SEQ / 64 - c0) ? c0 + (I) : SEQ / 64 - 1 - (I)) : (I))
    u32x4 rk[KCH], rv;
#pragma unroll
    for (int i = 0; i < KCH; ++i) if (kval[i]) rk[i] = *(const u32x4*)(Kg + (size_t)c0 * 64 * DQK + (size_t)(tid + NTHR * i) * 8);
    rv = *(const u32x4*)(Vg + (size_t)c0 * 64 * 64 + (size_t)tid * 8);
#pragma unroll
    for (int i = 0; i < KCH; ++i) if (kval[i]) *(u32x4*)(smem + koff[i]) = rk[i];
    *(u32x4*)(smem + voff) = rv;
    __syncthreads();
    const int kfo = r * KSTR + h * 16;
    const int qq = (lane >> 2) & 3;
    const int colb0 = ((qq >> 1) & 1) * 64 + 32 * ((lane >> 4) & 1) + 8 * (lane & 3);
    const int vfo0 = KBYTES + (4 * h + qq) * 128 + colb0, vfo1 = KBYTES + (4 * h + qq) * 128 + (colb0 ^ 64);
    const float qpos = (float)qrow;

    u32x4 rk2[KCH], rv2;
#define AT_LOAD(RK, RV, T) { const int ti_ = (T) < SEQ / 64 ? (T) : SEQ / 64 - 1; const int tn_ = ORD(ti_); _Pragma("unroll") for (int i = 0; i < KCH; ++i) RK[i] = *(const u32x4*)(Kg + (size_t)tn_ * 64 * DQK + (size_t)(kval[i] ? tid + NTHR * i : tid) * 8);     RV = *(const u32x4*)(Vg + (size_t)tn_ * 64 * 64 + (size_t)tid * 8); }
#define AT_WRITE(RK, RV, SO) { _Pragma("unroll") for (int i = 0; i < KCH; ++i) if (kval[i]) *(u32x4*)(smem + (SO) + koff[i]) = RK[i]; *(u32x4*)(smem + (SO) + voff) = RV; }
    AT_LOAD(rk2, rv2, 1);
    for (int kt = 0; kt < SEQ / 64; kt += 2) {
        AT_LOAD(rk, rv, kt + 2);
        attn_tile<DQK, MODE>(smem, ORD(kt), kt == 0, O, mrun, lsum, qf, kfo, vfo0, vfo1, qpos, slope2, h);
        AT_WRITE(rk2, rv2, ATT_STAGE);
        __syncthreads();
        AT_LOAD(rk2, rv2, kt + 3);
        attn_tile<DQK, MODE>(smem + ATT_STAGE, ORD(kt + 1), false, O, mrun, lsum, qf, kfo, vfo0, vfo1, qpos, slope2, h);
        AT_WRITE(rk, rv, 0);
        __syncthreads();
    }
#undef AT_LOAD
#undef AT_WRITE
#undef ORD
    const int tid2 = tid_opaque(wv), lane2 = tid2 & 63;
    const int h2 = lane2 >> 5;
    float inv[NQT];
#pragma unroll
    for (int qt = 0; qt < NQT; ++qt) { const float lt = lsum[qt] + shflx(lsum[qt], 32, lane2); inv[qt] = 1.0f / lt; }
    if (MODE == 2) {
#pragma unroll
        for (int qt = 0; qt < NQT; ++qt) {
            const int qrow2 = q0 + ((tid2 >> 6) * QW) + 32 * qt + (lane2 & 31);
            bf16_t* orow = outp + (size_t)qrow2 * XLD;
#pragma unroll
            for (int d = 0; d < 2; ++d)
#pragma unroll
                for (int g = 0; g < 4; ++g) {
                    u32x2 w; w.x = pk2(O[qt][d][4 * g] * inv[qt], O[qt][d][4 * g + 1] * inv[qt]); w.y = pk2(O[qt][d][4 * g + 2] * inv[qt], O[qt][d][4 * g + 3] * inv[qt]);
                    *(u32x2*)(orow + d * 32 + 8 * g + 4 * h2) = w;
                }
        }
        return;
    }
    float o[2][16];
    if (DIFF) {
        float ss = 0.f;
#pragma unroll
        for (int d = 0; d < 2; ++d)
#pragma unroll
            for (int i = 0; i < 16; ++i) { const float x = O[0][d][i] * inv[0] - lam * (O[NQT - 1][d][i] * inv[NQT - 1]); o[d][i] = x; ss += x * x; }
        ss += shflx(ss, 32, lane2);
        const float rstd = rsqrtf(ss * (1.0f / 64.0f) + EPS) * outmul;
#pragma unroll
        for (int d = 0; d < 2; ++d)
#pragma unroll
            for (int i = 0; i < 16; ++i) o[d][i] *= rstd * subln[d * 32 + (i & 3) + 8 * (i >> 2) + 4 * h2];
    } else {
#pragma unroll
        for (int d = 0; d < 2; ++d)
#pragma unroll
            for (int i = 0; i < 16; ++i) o[d][i] = O[0][d][i] * inv[0];
    }
    const int qrow2 = q0 + (lane2 & 31) + ((tid2 >> 6) << 5);
    bf16_t* orow = outp + (size_t)qrow2 * XLD;
#pragma unroll
    for (int d = 0; d < 2; ++d)
#pragma unroll
        for (int g = 0; g < 4; ++g) {
            u32x2 w; w.x = pk2(o[d][4 * g], o[d][4 * g + 1]); w.y = pk2(o[d][4 * g + 2], o[d][4 * g + 3]);
            *(u32x2*)(orow + d * 32 + 8 * g + 4 * h2) = w;
        }
}

DI void attn_phase(const Params& p, int layer, float lam_init, float outmul, unsigned char* smem, int wv) {
    unsigned char* ws = p.ws;
    const bf16_t *QA = (const bf16_t*)(ws + OFF_QA), *KA = (const bf16_t*)(ws + OFF_KA), *VA = (const bf16_t*)(ws + OFF_VA), *QB = (const bf16_t*)(ws + OFF_QB),
                 *KB = (const bf16_t*)(ws + OFF_KB), *VB = (const bf16_t*)(ws + OFF_VB), *QC = (const bf16_t*)(ws + OFF_QC), *KC = (const bf16_t*)(ws + OFF_KC),
                 *VC = (const bf16_t*)(ws + OFF_VC);
    bf16_t* MIX = (bf16_t*)(ws + OFF_MIX);
    float s1 = 0.f, s2 = 0.f;
    for (int j = 0; j < 32; ++j) { s1 += p.lq1[layer * 32 + j] * p.lk1[layer * 32 + j]; s2 += p.lq2[layer * 32 + j] * p.lk2[layer * 32 + j]; }
    const float lam = __int_as_float(__builtin_amdgcn_readfirstlane(__float_as_int(expf(s1) - expf(s2) + lam_init)));
    for (int v = bid_opaque(); v < 1536; v += gridDim.x) {
        const int base = v & ~255, i = v & 255, j = i >> 3;
        const int u = base + ((i & 7) * 2 + (j >> 4)) * 16 + (j & 15);
        if (u < 512) {
            const int qb = u & 15, hh = (u >> 4) & 3, b = u >> 6;
            const size_t ro = (size_t)(b * 4 + hh) * SEQ * 64;
            const float slope2 = __int_as_float(__builtin_amdgcn_readfirstlane(__float_as_int(exp2f(-2.0f * (float)(hh + 1)) * LOG2E)));
            attn_unit<64, 1>(QC + ro, KC + ro, VC + ro, qb * 256, MIX + (size_t)b * SEQ * XLD + 768 + hh * 64, slope2, lam, outmul,
                             p.subln + layer * 64, smem, wv);
        } else if (u < 1024) {
            const int w = u - 512, qb = w & 15, hh = (w >> 4) & 3, b = w >> 6;
            const size_t rq = (size_t)(b * 4 + hh) * SEQ;
            attn_unit<96, 0>(QB + rq * 96, KB + rq * 96, VB + rq * 64, qb * 256, MIX + (size_t)b * SEQ * XLD + 512 + hh * 64, 0.f, 0.f, 0.f, nullptr, smem, wv);
        } else {
            const int w = u - 1024, qb = w & 7, hh = (w >> 3) & 7, b = w >> 6;
            const size_t rq = (size_t)(b * 8 + hh) * SEQ, rk = (size_t)(b * 2 + (hh >> 2)) * SEQ;
            attn_unit<64, 2>(QA + rq * 64, KA + rk * 64, VA + rk * 64, qb * 512, MIX + (size_t)b * SEQ * XLD + hh * 64, 0.f, 0.f, 0.f, nullptr, smem, wv);
        }
    }
}

#define GB_XCNT(j) (64 * (j))
#define GB_XSUB(j) (1024 + 64 * (j))
#define GB_XGEN(j) (2048 + 64 * (j))
#define GB_TOP 3072
#define GB_TOPGEN 3136
constexpr int GB_WORDS = 3200;
DI unsigned gb_ld(unsigned* p) { return __hip_atomic_load(p, __ATOMIC_RELAXED, __HIP_MEMORY_SCOPE_AGENT); }
DI unsigned gb_add(unsigned* p) { return __hip_atomic_fetch_add(p, 1u, __ATOMIC_RELAXED, __HIP_MEMORY_SCOPE_AGENT); }
DI unsigned gb_xcc() { return (unsigned)__builtin_amdgcn_s_getreg((3 << 11) | 20) & 0xFu; }
#define GB_SPIN(cond) { unsigned sp_ = 0; while (cond) { __builtin_amdgcn_s_sleep(1); if (++sp_ > (1u << 24)) break; } }
DI void grid_bar(unsigned* bar, unsigned x, unsigned nloc, unsigned nx, unsigned& ep, int wv) {
    asm volatile("s_waitcnt vmcnt(0)" ::: "memory");
    __syncthreads();
    asm volatile("" : "+s"(nloc), "+s"(nx), "+s"(x));
    unsigned epl = ep; asm volatile("" : "+s"(epl));
    if (tid_opaque(wv) == 0) {
        const unsigned old = gb_add(&bar[GB_XSUB(x)]);
        if (old + 1u == (epl + 1u) * nloc) {
            __builtin_amdgcn_fence(__ATOMIC_RELEASE, "agent");
            asm volatile("s_waitcnt vmcnt(0)" ::: "memory");
            const unsigned og = gb_add(&bar[GB_TOP]);
            if (og + 1u == (epl + 1u) * nx) gb_add(&bar[GB_TOPGEN]);
            else GB_SPIN(gb_ld(&bar[GB_TOPGEN]) == epl);
            __builtin_amdgcn_fence(__ATOMIC_ACQUIRE, "agent");
            gb_add(&bar[GB_XGEN(x)]);
            asm volatile("s_waitcnt vmcnt(0)" ::: "memory");
        } else {
            GB_SPIN(gb_ld(&bar[GB_XGEN(x)]) == epl);
            __builtin_amdgcn_fence(__ATOMIC_ACQUIRE, "agent");
            asm volatile("s_waitcnt vmcnt(0)" ::: "memory");
        }
    }
    ep += 1u;
    __syncthreads();
}

__global__ void __launch_bounds__(NTHR, 2) mega(Params p) {
    extern __shared__ __attribute__((aligned(16))) unsigned char smem[];
    cg::grid_group grid = cg::this_grid();
    unsigned char* ws = p.ws;
    const int gtid = blockIdx.x * NTHR + threadIdx.x, gthreads = gridDim.x * NTHR;
    const int wv = __builtin_amdgcn_readfirstlane((int)(threadIdx.x >> 6));
    bf16_t* XB = (bf16_t*)(ws + OFF_XB);
    float* SSX = (float*)(ws + OFF_SSX);
    float* tab = (float*)(ws + OFF_TAB);

    unsigned* bar = (unsigned*)(ws + OFF_BAR);
    const unsigned myx = gb_xcc();
    if (threadIdx.x == 0) gb_add(&bar[GB_XCNT(myx)]);
    for (int l = 0; l < 2; ++l) {
        prep_weight<false>(p.w_in + (size_t)l * 1024 * INW, p.norm_attn + l * 1024, (bf16_t*)(ws + OFF_WIN) + (size_t)l * INWP * XLD, XLD, 1024, INW, INWP, smem, wv);
        prep_weight<false>(p.w_uq + (size_t)l * 192 * 384, p.qan_b + l * 192, (bf16_t*)(ws + OFF_WUQ) + (size_t)l * 512 * 192, 192, 192, 384, 512, smem, wv);
        prep_weight<false>(p.w_ukv + (size_t)l * 128 * 512, p.kvn_b + l * 128, (bf16_t*)(ws + OFF_WUKV) + (size_t)l * 512 * 128, 128, 128, 512, 512, smem, wv);
        prep_weight<false>(p.w_out + (size_t)l * 1024 * 1024, nullptr, (bf16_t*)(ws + OFF_WOUT) + (size_t)l * 1024 * XLD, XLD, 1024, 1024, 1024, smem, wv);
        prep_weight<true>(p.w_up + (size_t)l * 1024 * DFF2, p.norm_ffn + l * 1024, (bf16_t*)(ws + OFF_WUP) + (size_t)l * DFF2 * XLD, XLD, 1024, DFF2, DFF2, smem, wv);
        prep_weight<false>(p.w_down + (size_t)l * DFF * 1024, nullptr, (bf16_t*)(ws + OFF_WDN) + (size_t)l * 1024 * ALD, ALD, DFF, 1024, 1024, smem, wv);
    }
    for (int idx = gtid; idx < 1024 + 512; idx += gthreads) {
        if (idx < 1024) { const int pos = idx >> 4, f = idx & 15; const float ang = (float)pos * powf(10000.0f, -(float)f / 16.0f); tab[idx] = cosf(ang); tab[1024 + idx] = sinf(ang); }
        else { const int k = idx - 1024, pos = k >> 3, f = k & 7; const float ang = (float)pos * powf(10000.0f, -(float)f / 8.0f); tab[2048 + k] = cosf(ang); tab[2560 + k] = sinf(ang); }
    }
    convert_x(p.x, XB, SSX, wv);
    grid.sync();

    unsigned nloc = 1u, nx = 0u, ep = 0u;
    for (unsigned j = 0; j < 16; ++j) { const unsigned c = gb_ld(&bar[GB_XCNT(j)]); nx += (c > 0u) ? 1u : 0u; nloc = (j == myx) ? c : nloc; }
    nloc = __builtin_amdgcn_readfirstlane(nloc > 0u ? nloc : 1u); nx = __builtin_amdgcn_readfirstlane(nx > 0u ? nx : 1u);
    for (int l = 0; l < 2; ++l) {
        const float lam_init = __int_as_float(__builtin_amdgcn_readfirstlane(__float_as_int((l == 0) ? 0.2f : 0.35550906759096984f)));
        gemm_phase(XB, XLD, (const bf16_t*)(ws + OFF_WIN) + (size_t)l * INWP * XLD, XLD, 1024, M_TOK, INWP, smem,
                   EpiInProj{SSX, tab, p.qn_a + l * 64, p.kn_a + l * 64, (bf16_t*)(ws + OFF_QA), (bf16_t*)(ws + OFF_KA), (bf16_t*)(ws + OFF_VA), (bf16_t*)(ws + OFF_CQ),
                             (bf16_t*)(ws + OFF_CKV), (bf16_t*)(ws + OFF_KB), (bf16_t*)(ws + OFF_QC), (bf16_t*)(ws + OFF_KC), (bf16_t*)(ws + OFF_VC),
                             (float*)(ws + OFF_SSCQ), (float*)(ws + OFF_SSCKV)}, wv);
        grid_bar(bar, myx, nloc, nx, ep, wv);
        gemm_phase((const bf16_t*)(ws + OFF_CQ), 192, (const bf16_t*)(ws + OFF_WUQ) + (size_t)l * 512 * 192, 192, 192, M_TOK, 512, smem,
                   EpiMlaQ{(bf16_t*)(ws + OFF_QB), tab, (const float*)(ws + OFF_SSCQ), 0.10206207261596575f * LOG2E}, wv);
        gemm_phase((const bf16_t*)(ws + OFF_CKV), 128, (const bf16_t*)(ws + OFF_WUKV) + (size_t)l * 512 * 128, 128, 128, M_TOK, 512, smem,
                   EpiMlaKV{(bf16_t*)(ws + OFF_KB), (bf16_t*)(ws + OFF_VB), (const float*)(ws + OFF_SSCKV)}, wv);
        grid_bar(bar, myx, nloc, nx, ep, wv);
        attn_phase(p, l, lam_init, __int_as_float(__builtin_amdgcn_readfirstlane(__float_as_int((l == 0) ? 0.8f : 0.64449093240903016f))), smem, wv);
        grid_bar(bar, myx, nloc, nx, ep, wv);
        if (l == 0) gemm_phase((const bf16_t*)(ws + OFF_MIX), XLD, (const bf16_t*)(ws + OFF_WOUT) + (size_t)l * 1024 * XLD, XLD, 1024, M_TOK, 1024, smem, EpiResid2<true>{p.x, XB, SSX}, wv);
        else gemm_phase((const bf16_t*)(ws + OFF_MIX), XLD, (const bf16_t*)(ws + OFF_WOUT) + (size_t)l * 1024 * XLD, XLD, 1024, M_TOK, 1024, smem, EpiResid2<false>{nullptr, XB, SSX}, wv);
        grid_bar(bar, myx, nloc, nx, ep, wv);
        up_conv_phase(XB, (const bf16_t*)(ws + OFF_WUP) + (size_t)l * DFF2 * XLD, SSX, p.conv_w + (size_t)l * 3 * DFF2, p.conv_b + (size_t)l * DFF2, (bf16_t*)(ws + OFF_ACT), smem, wv, ws + OFF_BAR + GB_WORDS * 4);
        grid_bar(bar, myx, nloc, nx, ep, wv);
        gemm_phase((const bf16_t*)(ws + OFF_ACT), ALD, (const bf16_t*)(ws + OFF_WDN) + (size_t)l * 1024 * ALD, ALD, DFF, M_TOK, 1024, smem, EpiResid2<false>{nullptr, XB, SSX}, wv);
        grid_bar(bar, myx, nloc, nx, ep, wv);
    }
    final_norm(XB, p.out, p.final_norm, SSX, wv);
}

extern "C" void kernel_launch(void* const* d_in, const int* in_sizes, int n_in, void* d_out, int out_size, void* d_ws, size_t ws_size, hipStream_t stream) {
    static int grid_blocks = 0;
    if (!grid_blocks) {
        int dev = 0, cus = 0, per_cu = 0;
        hipGetDevice(&dev);
        hipDeviceGetAttribute(&cus, hipDeviceAttributeMultiprocessorCount, dev);
        hipFuncSetAttribute((const void*)mega, hipFuncAttributeMaxDynamicSharedMemorySize, SMEM_TOTAL);
        hipOccupancyMaxActiveBlocksPerMultiprocessor(&per_cu, mega, NTHR, SMEM_TOTAL);
        if (per_cu > 1) per_cu = 1;
        if (per_cu < 1) per_cu = 1;
        grid_blocks = (cus * per_cu) & ~7;
    }
    Params p{};
    const float** pp = (const float**)&p;
    for (int i = 0; i < 21; ++i) pp[i] = (const float*)d_in[i];
    p.out = (float*)d_out;
    p.ws = (unsigned char*)d_ws;
    hipMemsetAsync((unsigned char*)d_ws + OFF_BAR, 0, GB_WORDS * 4 + 256, stream);
    void* args[] = {&p};
    hipError_t e = hipLaunchCooperativeKernel((void*)mega, dim3(grid_blocks), dim3(NTHR), args, SMEM_TOTAL, stream);
    if (e != hipSuccess) fprintf(stderr, "cooperative launch failed: %s (grid %d)\n", hipGetErrorString(e), grid_blocks);
}
```

```cpp
#include <hip/hip_runtime.h>
#include <hip/hip_cooperative_groups.h>
#include <stdint.h>
#include <math.h>
#include <stdio.h>
namespace cg = cooperative_groups;

typedef unsigned short bf16_t;
typedef short bf16x8 __attribute__((ext_vector_type(8)));
typedef short s16x4 __attribute__((ext_vector_type(4)));
typedef float f32x4 __attribute__((ext_vector_type(4)));
typedef float f32x16 __attribute__((ext_vector_type(16)));
typedef unsigned u32x4 __attribute__((ext_vector_type(4)));
typedef unsigned u32x2 __attribute__((ext_vector_type(2)));
typedef __bf16 bf2_t __attribute__((ext_vector_type(2)));
typedef float f32x2 __attribute__((ext_vector_type(2)));
#define DI __device__ __forceinline__

constexpr int M_TOK = 32768, SEQ = 4096, DM = 1024, INW = 1888, INWP = 2048, DFF = 2816, DFF2 = 5632;
constexpr float EPS = 1e-6f;
constexpr float LOG2E = 1.4426950408889634f;
constexpr int NTHR = 512, NWAVE = NTHR / 64;
constexpr int XLD = 1024 + 64, ALD = DFF + 64;

constexpr size_t SZ_WIN = (size_t)2 * INWP * XLD * 2, SZ_WUQ = (size_t)2 * 512 * 192 * 2, SZ_WUKV = (size_t)2 * 512 * 128 * 2,
                 SZ_WOUT = (size_t)2 * 1024 * XLD * 2, SZ_WUP = (size_t)2 * DFF2 * XLD * 2, SZ_WDN = (size_t)2 * 1024 * ALD * 2;
constexpr size_t OFF_WIN = 0, OFF_WUQ = OFF_WIN + SZ_WIN, OFF_WUKV = OFF_WUQ + SZ_WUQ, OFF_WOUT = OFF_WUKV + SZ_WUKV,
                 OFF_WUP = OFF_WOUT + SZ_WOUT, OFF_WDN = OFF_WUP + SZ_WUP, OFF_TAB = OFF_WDN + SZ_WDN, OFF_XB = OFF_TAB + 16384;
constexpr size_t OFF_SSX = OFF_XB + (size_t)M_TOK * XLD * 2, OFF_SSCQ = OFF_SSX + (size_t)M_TOK * 16 * 4, OFF_SSCKV = OFF_SSCQ + (size_t)M_TOK * 4 * 4,
                 OFF_BIG = OFF_SSCKV + (size_t)M_TOK * 2 * 4;
constexpr size_t OFF_QA = OFF_BIG, OFF_KA = OFF_QA + (size_t)M_TOK * 512 * 2,
                 OFF_VA = OFF_KA + (size_t)M_TOK * 128 * 2, OFF_CQ = OFF_VA + (size_t)M_TOK * 128 * 2, OFF_CKV = OFF_CQ + (size_t)M_TOK * 192 * 2,
                 OFF_QB = OFF_CKV + (size_t)M_TOK * 128 * 2, OFF_KB = OFF_QB + (size_t)M_TOK * 384 * 2, OFF_VB = OFF_KB + (size_t)M_TOK * 384 * 2,
                 OFF_QC = OFF_VB + (size_t)M_TOK * 256 * 2, OFF_KC = OFF_QC + (size_t)M_TOK * 256 * 2, OFF_VC = OFF_KC + (size_t)M_TOK * 256 * 2,
                 OFF_MIX = OFF_VC + (size_t)M_TOK * 256 * 2, OFF_END1 = OFF_MIX + (size_t)M_TOK * XLD * 2;
constexpr size_t OFF_ACT = OFF_BIG, OFF_END2 = OFF_ACT + (size_t)M_TOK * ALD * 2;
constexpr size_t OFF_BAR = ((OFF_END1 > OFF_END2 ? OFF_END1 : OFF_END2) + 255) & ~(size_t)255;
static_assert(OFF_BAR + 16384 <= (size_t)512 * 1024 * 1024, "workspace");

struct Params {
    const float *x, *norm_attn, *w_in, *qn_a, *kn_a, *qan_b, *w_uq, *kvn_b, *w_ukv, *lq1, *lk1, *lq2, *lk2, *subln, *w_out, *norm_ffn, *w_up,
        *conv_w, *conv_b, *w_down, *final_norm;
    float* out;
    unsigned char* ws;
};

DI unsigned pk2(float a, float b) { f32x2 v = {a, b}; bf2_t r = __builtin_convertvector(v, bf2_t); return __builtin_bit_cast(unsigned, r); }
DI void unpack8(u32x4 r, float* v) {
    v[0] = __uint_as_float(r.x << 16); v[1] = __uint_as_float(r.x & 0xffff0000u);
    v[2] = __uint_as_float(r.y << 16); v[3] = __uint_as_float(r.y & 0xffff0000u);
    v[4] = __uint_as_float(r.z << 16); v[5] = __uint_as_float(r.z & 0xffff0000u);
    v[6] = __uint_as_float(r.w << 16); v[7] = __uint_as_float(r.w & 0xffff0000u);
}
DI u32x4 pack8(const float* v) { u32x4 r; r.x = pk2(v[0], v[1]); r.y = pk2(v[2], v[3]); r.z = pk2(v[4], v[5]); r.w = pk2(v[6], v[7]); return r; }
DI int tid_opaque(int wv) { int t; asm volatile("v_mbcnt_lo_u32_b32 %0, -1, 0\n\tv_mbcnt_hi_u32_b32 %0, -1, %0" : "=v"(t)); return t | (wv << 6); }
DI int bid_opaque() { int b = blockIdx.x; asm volatile("" : "+s"(b)); return b; }
DI float shflx(float v, int mask, int lane) { return __int_as_float(__builtin_amdgcn_ds_bpermute((lane ^ mask) << 2, __float_as_int(v))); }
DI float wave_sum(float v, int lane) {
#pragma unroll
    for (int o = 32; o >= 1; o >>= 1) v += shflx(v, o, lane);
    return v;
}

template <bool UPPERM>
DI void prep_weight(const float* __restrict__ W, const float* __restrict__ gain, bf16_t* __restrict__ Wt, int ldw, int K, int N, int Npad, unsigned char* smem, int wv) {
    bf16_t* Ts = (bf16_t*)smem;
    const int tid = tid_opaque(wv);
    const int nkt = K / 64, ntile = (Npad / 64) * nkt;
    for (int t = bid_opaque(); t < ntile; t += gridDim.x) {
        const int n0 = (t / nkt) * 64, k0 = (t % nkt) * 64;
        int ns0 = n0;
        if (UPPERM) { const int j = n0 >> 8, r = n0 & 255; ns0 = (r < 128) ? (128 * j + r) : (DFF + 128 * j + r - 128); }
        const int kr = tid >> 4, nc = (tid & 15) * 4;
        if (n0 + 64 <= N) {
            f32x4 v4[2];
#pragma unroll
            for (int hh = 0; hh < 2; ++hh) v4[hh] = *(const f32x4*)(W + (size_t)(k0 + kr + 32 * hh) * N + ns0 + nc);
#pragma unroll
            for (int hh = 0; hh < 2; ++hh) {
                const float gk = gain ? gain[k0 + kr + 32 * hh] : 1.0f;
#pragma unroll
                for (int e = 0; e < 4; ++e) Ts[(nc + e) * 72 + kr + 32 * hh] = (bf16_t)(pk2(v4[hh][e] * gk, 0.f) & 0xffffu);
            }
        } else {
#pragma unroll
        for (int hh = 0; hh < 2; ++hh) {
            const int k = k0 + kr + 32 * hh;
            const float gk = gain ? gain[k] : 1.0f;
#pragma unroll
            for (int e = 0; e < 4; ++e) {
                const float v = (n0 + nc + e < N) ? W[(size_t)k * N + ns0 + nc + e] * gk : 0.f;
                Ts[(nc + e) * 72 + kr + 32 * hh] = (bf16_t)(pk2(v, 0.f) & 0xffffu);
            }
        }
        }
        __syncthreads();
        { const int n = tid >> 3, kc = tid & 7; *(u32x4*)(Wt + (size_t)(n0 + n) * ldw + k0 + kc * 8) = *(const u32x4*)(Ts + n * 72 + kc * 8); }
        __syncthreads();
    }
}

DI void convert_x(const float* X, bf16_t* XB, float* SSX, int wv) {
    const int tid_ = tid_opaque(wv);
    const int lane = tid_ & 63, gw = bid_opaque() * NWAVE + (tid_ >> 6), nw = gridDim.x * NWAVE;
    for (int row = gw; row < M_TOK; row += nw) {
        const f32x4* xr = (const f32x4*)(X + (size_t)row * 1024);
        float ss = 0.f;
#pragma unroll
        for (int i = 0; i < 4; ++i) {
            const f32x4 v = xr[lane + 64 * i];
            ss += v[0] * v[0] + v[1] * v[1] + v[2] * v[2] + v[3] * v[3];
            u32x2 w; w.x = pk2(v[0], v[1]); w.y = pk2(v[2], v[3]);
            *(u32x2*)(XB + (size_t)row * XLD + (lane + 64 * i) * 4) = w;
        }
        ss = wave_sum(ss, lane);
        if (lane < 16) SSX[(size_t)row * 16 + lane] = (lane == 0) ? ss : 0.f;
    }
}
DI void final_norm(const bf16_t* XB, float* Out, const float* __restrict__ g, const float* SSX, int wv) {
    const int tid_ = tid_opaque(wv);
    const int lane = tid_ & 63, gw = bid_opaque() * NWAVE + (tid_ >> 6), nw = gridDim.x * NWAVE;
    for (int row = gw; row < M_TOK; row += nw) {
        float ss = (lane < 16) ? SSX[(size_t)row * 16 + lane] : 0.f;
        ss = wave_sum(ss, lane);
        const float rstd = rsqrtf(ss * (1.0f / 1024.0f) + EPS);
        f32x4* orow = (f32x4*)(Out + (size_t)row * 1024);
#pragma unroll
        for (int i = 0; i < 4; ++i) {
            const u32x2 w = *(const u32x2*)(XB + (size_t)row * XLD + (lane + 64 * i) * 4);
            f32x4 r; r[0] = __uint_as_float(w.x << 16); r[1] = __uint_as_float(w.x & 0xffff0000u); r[2] = __uint_as_float(w.y << 16); r[3] = __uint_as_float(w.y & 0xffff0000u);
            const f32x4 gv = ((const f32x4*)g)[lane + 64 * i];
            orow[lane + 64 * i] = r * rstd * gv;
        }
    }
}
DI float row_rstd(const float* ssx, int m) {
    const f32x4* pp = (const f32x4*)(ssx + (size_t)m * 16);
    const f32x4 a = (pp[0] + pp[1]) + (pp[2] + pp[3]);
    return rsqrtf(((a[0] + a[1]) + (a[2] + a[3])) * (1.0f / 1024.0f) + EPS);
}

constexpr int GSTR = 128, GOP = 256 * GSTR;
constexpr int SMEM_BYTES = 4 * GOP;
constexpr int SMEM_CONV = 256 * 264 * 2;
constexpr int SMEM_TOTAL = SMEM_CONV > SMEM_BYTES ? SMEM_CONV : SMEM_BYTES;

DI void gemm_mainloop(const bf16_t* __restrict__ Ab, const unsigned (&aoff)[4], const bool (&av)[4], const bf16_t* __restrict__ Bb, unsigned boff, int ldb, int nk, unsigned char* smem, f32x4 (&acc)[8][4], int tid,
                      const unsigned char* zline) {
    const int lane = tid & 63, wid = tid >> 6, wr = wid >> 2, wc = wid & 3;
#pragma unroll
    for (int i = 0; i < 8; ++i)
#pragma unroll
        for (int j = 0; j < 4; ++j) acc[i][j] = (f32x4){0.f, 0.f, 0.f, 0.f};
#define G_DMA(KT, BUF) { _Pragma("unroll") for (int i = 0; i < 4; ++i) { \
        const unsigned char* ga_ = av[i] ? ((const unsigned char*)Ab + (size_t)(aoff[i] + (unsigned)((KT) * 128))) : zline; \
        __builtin_amdgcn_global_load_lds((const unsigned*)ga_, (unsigned*)(smem + (BUF) * 2 * GOP + i * 8192 + tid * 16), 16, 0, 0); \
        __builtin_amdgcn_global_load_lds((const unsigned*)((const unsigned char*)Bb + (size_t)(boff + (unsigned)(i * 128 * ldb) + (unsigned)((KT) * 128))), (unsigned*)(smem + (BUF) * 2 * GOP + GOP + i * 8192 + tid * 16), 16, 0, 0); } }
    const int foff = (lane & 15) * GSTR;
    const int fsw[2] = {(((lane >> 4)) ^ (lane & 7)) << 4, (((lane >> 4) + 4) ^ (lane & 7)) << 4};
    G_DMA(0, 0);
    __syncthreads();
    for (int kt = 0; kt < nk; ++kt) {
        { const int kl = (kt + 1 < nk) ? kt + 1 : nk - 1; G_DMA(kl, (kt + 1) & 1); }
        const unsigned char* sa = smem + (kt & 1) * 2 * GOP + wr * 128 * GSTR + foff;
        const unsigned char* sb = smem + (kt & 1) * 2 * GOP + GOP + wc * 64 * GSTR + foff;
#pragma unroll
        for (int kk = 0; kk < 2; ++kk) {
            bf16x8 af[8], bfr[4];
#pragma unroll
            for (int i = 0; i < 4; ++i) bfr[i] = *(const bf16x8*)(sb + i * 16 * GSTR + fsw[kk]);
#pragma unroll
            for (int i = 0; i < 8; ++i) af[i] = *(const bf16x8*)(sa + i * 16 * GSTR + fsw[kk]);
#pragma unroll
            for (int mi = 0; mi < 8; ++mi)
#pragma unroll
                for (int ni = 0; ni < 4; ++ni) acc[mi][ni] = __builtin_amdgcn_mfma_f32_16x16x32_bf16(bfr[ni], af[mi], acc[mi][ni], 0, 0, 0);
        }
        __builtin_amdgcn_sched_group_barrier(0x100, 24, 0);
        __builtin_amdgcn_sched_group_barrier(0x008, 64, 0);
        __syncthreads();
    }
#undef G_DMA
}

template <class Epi>
DI void gemm_tile(const bf16_t* __restrict__ A, int lda, const bf16_t* __restrict__ Bt, int ldb, int K, int m0, int n0, unsigned char* smem, const Epi& epi, int wv) {
    const int tid = tid_opaque(wv), lane = tid & 63, wid = tid >> 6, wr = wid >> 2, wc = wid & 3;
    const int lrow = tid >> 3, lc = tid & 7;
    unsigned aoff[4];
    const bool av[4] = {true, true, true, true};
#pragma unroll
    for (int i = 0; i < 4; ++i) aoff[i] = (unsigned)((lrow + 64 * i) * lda + (lc ^ (lrow & 7)) * 8) * 2u;
    const unsigned boff = (unsigned)(lrow * ldb + (lc ^ (lrow & 7)) * 8) * 2u;
    f32x4 acc[8][4];
    gemm_mainloop(A + (size_t)m0 * lda, aoff, av, Bt + (size_t)n0 * ldb, boff, ldb, K / 64, smem, acc, tid, nullptr);
    epi(acc, m0 + wr * 128, n0 + wc * 64, lane);
}

template <class Epi>
DI void gemm_phase(const bf16_t* A, int lda, const bf16_t* Bt, int ldb, int K, int Mrows, int Ncols, unsigned char* smem, const Epi& epi, int wv) {
    const int nN = Ncols / 256, nM = Mrows / 256;
    const int bid = bid_opaque(), G = gridDim.x;
    const int xcd = bid & 7, lb = bid >> 3, nlb = G >> 3, mper = nM >> 3, nloc = mper * nN;
    for (int j = lb; j < nloc; j += nlb) {
        const int g = j / (8 * nN), rem = j - g * 8 * nN;
        const int mt = xcd * mper + g * 8 + (rem & 7), nt = rem >> 3;
        gemm_tile(A, lda, Bt, ldb, K, mt * 256, nt * 256, smem, epi, wv);
    }
}

DI float dot4(f32x4 a) { return (a[0] * a[0] + a[1] * a[1]) + (a[2] * a[2] + a[3] * a[3]); }
DI void st4bf(bf16_t* dst, f32x4 v) { u32x2 w; w.x = pk2(v[0], v[1]); w.y = pk2(v[2], v[3]); *(u32x2*)dst = w; }

template <bool XIN_F32>
struct EpiResid2 {
    const float* Xin; bf16_t* XB; float* SSX;
    DI void operator()(const f32x4 (&acc)[8][4], int mb, int nb, int lane) const {
        const int q = lane >> 4;
        u32x2 xin[XIN_F32 ? 1 : 8][4];
        if (!XIN_F32) {
#pragma unroll
            for (int mi = 0; mi < 8; ++mi)
#pragma unroll
                for (int ni = 0; ni < 4; ++ni) xin[mi][ni] = *(const u32x2*)(XB + (size_t)(mb + mi * 16 + (lane & 15)) * XLD + nb + ni * 16 + q * 4);
        }
#pragma unroll
        for (int mi = 0; mi < 8; ++mi) {
            const int m = mb + mi * 16 + (lane & 15);
            float ss = 0.f;
#pragma unroll
            for (int ni = 0; ni < 4; ++ni) {
                const int col = nb + ni * 16 + q * 4;
                bf16_t* xb = XB + (size_t)m * XLD + col;
                f32x4 r;
                if (XIN_F32) r = *(const f32x4*)(Xin + (size_t)m * 1024 + col);
                else { const u32x2 w = xin[XIN_F32 ? 0 : mi][ni]; r[0] = __uint_as_float(w.x << 16); r[1] = __uint_as_float(w.x & 0xffff0000u); r[2] = __uint_as_float(w.y << 16); r[3] = __uint_as_float(w.y & 0xffff0000u); }
                r += acc[mi][ni];
                st4bf(xb, r);
                ss += dot4(r);
            }
            ss += shflx(ss, 16, lane); ss += shflx(ss, 32, lane);
            if (q == 0) SSX[(size_t)m * 16 + (nb >> 6)] = ss;
        }
    }
};

struct EpiInProj {
    const float *ssx, *tab, *gq, *gk;
    bf16_t *QA, *KA, *VA, *CQ, *CKV, *KB, *QC, *KC, *VC;
    float *sscq, *ssckv;
    DI void operator()(const f32x4 (&acc)[8][4], int mb, int nb, int lane) const {
        const int q = lane >> 4, ml = lane & 15;
        const float qsA = 0.125f * LOG2E, qsC = 0.17677669529663687f * LOG2E;
        float rsv[8];
#pragma unroll
        for (int mi = 0; mi < 8; ++mi) rsv[mi] = row_rstd(ssx, mb + mi * 16 + ml);
        if (nb < 640) {
            const bool isq = nb < 512;
            const int head = isq ? (nb >> 6) : ((nb - 512) >> 6);
            const float* g = isq ? gq : gk;
            f32x4 gv[4];
#pragma unroll
            for (int ni = 0; ni < 4; ++ni) gv[ni] = *(const f32x4*)(g + ni * 16 + q * 4);
#pragma unroll
            for (int mi = 0; mi < 8; ++mi) {
                const int m = mb + mi * 16 + ml, b = m >> 12, s = m & 4095;
                const float rs = rsv[mi];
                f32x4 v[4];
                float ss = 0.f;
#pragma unroll
                for (int ni = 0; ni < 4; ++ni) { v[ni] = acc[mi][ni] * rs; ss += dot4(v[ni]); }
                ss += shflx(ss, 16, lane); ss += shflx(ss, 32, lane);
                const float r2 = rsqrtf(ss * (1.0f / 64.0f) + EPS);
#pragma unroll
                for (int ni = 0; ni < 4; ++ni) v[ni] = v[ni] * r2 * gv[ni];
                const float* tr = tab + (s >> 6) * 16 + q * 4;
                const float* tq = tab + (s & 63) * 16 + q * 4;
                const f32x4 c0 = *(const f32x4*)tr, s0 = *(const f32x4*)(tr + 1024), c1 = *(const f32x4*)tq, s1 = *(const f32x4*)(tq + 1024);
                f32x4 o0 = v[0] * c0 - v[1] * s0, o1 = v[1] * c0 + v[0] * s0, o2 = v[2] * c1 - v[3] * s1, o3 = v[3] * c1 + v[2] * s1;
                bf16_t* dst;
                if (isq) { o0 *= qsA; o1 *= qsA; o2 *= qsA; o3 *= qsA; dst = QA + ((size_t)(b * 8 + head) * SEQ + s) * 64 + q * 4; }
                else dst = KA + ((size_t)(b * 2 + head) * SEQ + s) * 64 + q * 4;
                st4bf(dst, o0); st4bf(dst + 16, o1); st4bf(dst + 32, o2); st4bf(dst + 48, o3);
            }
        } else if (nb < 768) {
            const int head = (nb - 640) >> 6;
#pragma unroll
            for (int mi = 0; mi < 8; ++mi) {
                const int m = mb + mi * 16 + ml, b = m >> 12, s = m & 4095;
                const float rs = rsv[mi];
                bf16_t* dst = VA + ((size_t)(b * 2 + head) * SEQ + s) * 64 + q * 4;
#pragma unroll
                for (int ni = 0; ni < 4; ++ni) st4bf(dst + ni * 16, acc[mi][ni] * rs);
            }
        } else {
            const bool sq = nb < 1088;
#pragma unroll
            for (int mi = 0; mi < 8; ++mi) {
                const int m = mb + mi * 16 + ml, b = m >> 12, s = m & 4095;
                const float rs = rsv[mi];
                float ss = 0.f;
#pragma unroll
                for (int ni = 0; ni < 4; ++ni) {
                    const int n16 = nb + ni * 16;
                    f32x4 v = acc[mi][ni] * rs;
                    if (n16 < 960) { st4bf(CQ + (size_t)m * 192 + (n16 - 768) + q * 4, v); ss += dot4(v); }
                    else if (n16 < 1088) { st4bf(CKV + (size_t)m * 128 + (n16 - 960) + q * 4, v); ss += dot4(v); }
                    else if (n16 < 1120) {
                        f32x4 pr;
#pragma unroll
                        for (int i = 0; i < 4; ++i) pr[i] = shflx(v[i], 32, lane);
                        const int pos = (n16 >= 1104) ? (s & 63) : (s >> 6);
                        const float* tc = tab + 2048 + pos * 8 + (q & 1) * 4;
                        const f32x4 c = *(const f32x4*)tc, sn = *(const f32x4*)(tc + 512);
                        const f32x4 o = (q < 2) ? (v * c - pr * sn) : (v * c + pr * sn);
#pragma unroll
                        for (int hh = 0; hh < 4; ++hh) st4bf(KB + ((size_t)(b * 4 + hh) * SEQ + s) * 96 + 64 + (n16 - 1088) + q * 4, o);
                    } else if (n16 < 1376) { const int c = n16 - 1120 + q * 4; st4bf(QC + ((size_t)(b * 4 + (c >> 6)) * SEQ + s) * 64 + (c & 63), v * qsC); }
                    else if (n16 < 1632) { const int c = n16 - 1376 + q * 4; st4bf(KC + ((size_t)(b * 4 + (c >> 6)) * SEQ + s) * 64 + (c & 63), v); }
                    else if (n16 < 1888) { const int c = n16 - 1632 + q * 4; st4bf(VC + ((size_t)(b * 4 + (c >> 6)) * SEQ + s) * 64 + (c & 63), v); }
                }
                if (sq) {
                    ss += shflx(ss, 16, lane); ss += shflx(ss, 32, lane);
                    if (q == 0) { if (nb < 960) sscq[(size_t)m * 4 + ((nb - 768) >> 6)] = ss; else ssckv[(size_t)m * 2 + ((nb - 960) >> 6)] = ss; }
                }
            }
        }
    }
};
struct EpiMlaQ {
    bf16_t* QB; const float* tab; const float* sscq; float qscale;
    DI void operator()(const f32x4 (&acc)[8][4], int mb, int nb, int lane) const {
#pragma unroll
        for (int mi = 0; mi < 8; ++mi) {
            const int m = mb + mi * 16 + (lane & 15), q = lane >> 4, b = m >> 12, s = m & 4095;
            const f32x4 sp = *(const f32x4*)(sscq + (size_t)m * 4);
            const float rs = rsqrtf((sp[0] + sp[1] + sp[2]) * (1.0f / 192.0f) + EPS) * qscale;
#pragma unroll
            for (int ni = 0; ni < 4; ++ni) {
                const int nt = nb + ni * 16;
                if (nt >= 384) continue;
                const int head = nt / 96, dt = nt - head * 96;
                f32x4 v = acc[mi][ni] * rs;
                f32x4 pr;
#pragma unroll
                for (int i = 0; i < 4; ++i) pr[i] = shflx(v[i], 32, lane);
                if (dt >= 64) {
                    const int pos = (dt >= 80) ? (s & 63) : (s >> 6);
                    const float* tc = tab + 2048 + pos * 8 + (q & 1) * 4;
                    const f32x4 c = *(const f32x4*)tc, sn = *(const f32x4*)(tc + 512);
                    v = (q < 2) ? (v * c - pr * sn) : (v * c + pr * sn);
                }
                st4bf(QB + ((size_t)(b * 4 + head) * SEQ + s) * 96 + dt + q * 4, v);
            }
        }
    }
};
struct EpiMlaKV {
    bf16_t* KB; bf16_t* VB; const float* ssckv;
    DI void operator()(const f32x4 (&acc)[8][4], int mb, int nb, int lane) const {
#pragma unroll
        for (int mi = 0; mi < 8; ++mi) {
            const int m = mb + mi * 16 + (lane & 15), b = m >> 12, s = m & 4095;
            const f32x2 sp = *(const f32x2*)(ssckv + (size_t)m * 2);
            const float rs = rsqrtf((sp[0] + sp[1]) * (1.0f / 128.0f) + EPS);
#pragma unroll
            for (int ni = 0; ni < 4; ++ni) {
                const int n = nb + ni * 16 + (lane >> 4) * 4;
                const int head = n >> 7, d = n & 127;
                const size_t rowi = (size_t)(b * 4 + head) * SEQ + s;
                if (d < 64) st4bf(KB + rowi * 96 + d, acc[mi][ni] * rs);
                else st4bf(VB + rowi * 64 + (d - 64), acc[mi][ni] * rs);
            }
        }
    }
};

DI void up_conv_tile(const bf16_t* __restrict__ XB, const bf16_t* __restrict__ Wt, const float* __restrict__ ssx, const float* __restrict__ cw, const float* __restrict__ cb,
                     bf16_t* __restrict__ ACT, int b, int jt, int nt, unsigned char* smem, int wv, const unsigned char* zline) {
    const int tid = tid_opaque(wv), lane = tid & 63, wid = tid >> 6, wr = wid >> 2, wc = wid & 3;
    const int lrow = tid >> 3, lc = tid & 7;
    const int tbase = jt * 254 - 1;
    unsigned aoff[4];
    bool av[4];
#pragma unroll
    for (int i = 0; i < 4; ++i) {
        const int tl = tbase + lrow + 64 * i;
        av[i] = (unsigned)tl < 4096u;
        const int tc = tl < 0 ? 0 : (tl > 4095 ? 4095 : tl);
        aoff[i] = (unsigned)(tc * XLD + (lc ^ (lrow & 7)) * 8) * 2u;
    }
    const unsigned boff = (unsigned)(lrow * XLD + (lc ^ (lrow & 7)) * 8) * 2u;
    f32x4 acc[8][4];
    gemm_mainloop(XB + (size_t)b * SEQ * XLD, aoff, av, Wt + (size_t)nt * 256 * XLD, boff, XLD, 16, smem, acc, tid, zline);
    bf16_t* T = (bf16_t*)smem;
    constexpr int TLD = 264;
    {
        const int q = lane >> 4, ml = lane & 15;
        float rsv[8];
#pragma unroll
        for (int mi = 0; mi < 8; ++mi) { const int tl = tbase + wr * 128 + mi * 16 + ml; const int tc = tl < 0 ? 0 : (tl > 4095 ? 4095 : tl); rsv[mi] = row_rstd(ssx, b * SEQ + tc); }
#pragma unroll
        for (int mi = 0; mi < 8; ++mi) {
            const int il = wr * 128 + mi * 16 + ml;
            const float rs = rsv[mi];
#pragma unroll
            for (int ni = 0; ni < 4; ++ni) st4bf(T + il * TLD + wc * 64 + ni * 16 + q * 4, acc[mi][ni] * rs);
        }
    }
    __syncthreads();
    {
        const int cq = tid & 31, rg = tid >> 5, ch = nt * 128 + cq * 4;
        const f32x4 wg0 = *(const f32x4*)(cw + ch), wg1 = *(const f32x4*)(cw + DFF2 + ch), wg2 = *(const f32x4*)(cw + 2 * DFF2 + ch), bg = *(const f32x4*)(cb + ch);
        const f32x4 wv0 = *(const f32x4*)(cw + DFF + ch), wv1 = *(const f32x4*)(cw + DFF2 + DFF + ch), wv2 = *(const f32x4*)(cw + 2 * DFF2 + DFF + ch), bv = *(const f32x4*)(cb + DFF + ch);
#define LD4(R, C) ({ const u32x2 w_ = *(const u32x2*)(T + (R) * TLD + (C)); f32x4 r_; r_[0] = __uint_as_float(w_.x << 16); r_[1] = __uint_as_float(w_.x & 0xffff0000u); r_[2] = __uint_as_float(w_.y << 16); r_[3] = __uint_as_float(w_.y & 0xffff0000u); r_; })
        const int r0 = rg * 16, rm = r0 > 0 ? r0 - 1 : 0;
        f32x4 gm = LD4(rm, cq * 4), vm = LD4(rm, 128 + cq * 4);
        f32x4 g0 = LD4(r0, cq * 4), v0 = LD4(r0, 128 + cq * 4);
#pragma unroll
        for (int rr = 0; rr < 16; ++rr) {
            const int r = r0 + rr, rp = r < 255 ? r + 1 : 255;
            const f32x4 gp = LD4(rp, cq * 4), vp = LD4(rp, 128 + cq * 4);
            const f32x4 gg = wg0 * gm + wg1 * g0 + wg2 * gp + bg;
            const f32x4 vv = wv0 * vm + wv1 * v0 + wv2 * vp + bv;
            f32x4 o;
#pragma unroll
            for (int e = 0; e < 4; ++e) o[e] = gg[e] * __builtin_amdgcn_rcpf(1.0f + __builtin_amdgcn_exp2f(-LOG2E * gg[e])) * vv[e];
            const int tl = tbase + r;
            if (r >= 1 && r <= 254 && tl <= 4095) st4bf(ACT + ((size_t)b * SEQ + tl) * ALD + ch, o);
            gm = g0; g0 = gp; vm = v0; v0 = vp;
        }
#undef LD4
    }
    __syncthreads();
}
DI void up_conv_phase(const bf16_t* XB, const bf16_t* Wt, const float* ssx, const float* cw, const float* cb, bf16_t* ACT, unsigned char* smem, int wv, const unsigned char* zline) {
    constexpr int NT = DFF / 128, MT = 17;
    const int bid = bid_opaque(), G = gridDim.x;
    const int xcd = bid & 7, lb = bid >> 3, nlb = G >> 3, nloc = MT * NT, full = (MT / 4) * 4 * NT, gs = MT - (MT / 4) * 4;
    for (int j = lb; j < nloc; j += nlb) {
        int jt, nt;
        if (j < full) { const int g = j / (4 * NT), rem = j - g * 4 * NT; jt = g * 4 + (rem & 3); nt = rem >> 2; }
        else { const int j2 = j - full; jt = (MT / 4) * 4 + j2 % gs; nt = j2 / gs; }
        up_conv_tile(XB, Wt, ssx, cw, cb, ACT, xcd, jt, nt, smem, wv, zline);
    }
}

constexpr int ATT_STAGE = 64 * 208 + 8192;

template <int DQK, int MODE>
DI void attn_tile(const unsigned char* cur, int kt, bool first, f32x16 (&O)[MODE ? 2 : 1][2], float (&mrun)[MODE ? 2 : 1], float (&lsum)[MODE ? 2 : 1], const bf16x8 (&qf)[MODE ? 2 : 1][MODE == 1 ? 2 : DQK / 16],
               int kfo, int vfo0, int vfo1, float qpos, float slope2, int h) {
    constexpr bool DIFF = (MODE == 1);
    constexpr int NQT = MODE ? 2 : 1, KS = DIFF ? 2 : DQK / 16, KSTR = DQK * 2 + 16;
        bf16x8 kfr[2][KS], vfr[2][2][2];
#pragma unroll
        for (int kh = 0; kh < 2; ++kh)
#pragma unroll
            for (int ks = 0; ks < KS; ++ks) kfr[kh][ks] = *(const bf16x8*)(cur + kfo + kh * 32 * KSTR + (ks * 16) * 2);
        if (MODE == 0) {
#pragma unroll
            for (int kh = 0; kh < 2; ++kh)
#pragma unroll
                for (int s2 = 0; s2 < 2; ++s2)
#pragma unroll
                    for (int d = 0; d < 2; ++d) {
                        const unsigned char* va = cur + (d ? vfo1 : vfo0) + (kh * 32 + 16 * s2) * 128;
                        const s16x4 lo = __builtin_amdgcn_ds_read_tr16_b64_v4i16((__attribute__((address_space(3))) s16x4*)(va));
                        const s16x4 hi = __builtin_amdgcn_ds_read_tr16_b64_v4i16((__attribute__((address_space(3))) s16x4*)(va + 8 * 128));
                        vfr[kh][s2][d] = __builtin_shufflevector(lo, hi, 0, 1, 2, 3, 4, 5, 6, 7);
                    }
        }
        __builtin_amdgcn_sched_barrier(0);
#pragma unroll
        for (int qt = 0; qt < NQT; ++qt) {
            bf16x8 pf[2][2];
            f32x16 S[2];
#pragma unroll
            for (int kh = 0; kh < 2; ++kh) {
#pragma unroll
                for (int i = 0; i < 16; ++i) S[kh][i] = 0.f;
#pragma unroll
                for (int ks = 0; ks < KS; ++ks) S[kh] = __builtin_amdgcn_mfma_f32_32x32x16_bf16(kfr[kh][ks], qf[qt][ks], S[kh], 0, 0, 0);
            }
            if (DIFF && qt == 0) {
#pragma unroll
                for (int kh = 0; kh < 2; ++kh)
#pragma unroll
                    for (int ks = 0; ks < KS; ++ks) kfr[kh][ks] = *(const bf16x8*)(cur + kfo + kh * 32 * KSTR + (32 + ks * 16) * 2);
            }
            float kd = 0.f;
            if (DIFF) {
                const float d0 = qpos - (float)(kt * 64 + 4 * h);
                const unsigned long long bl = __builtin_amdgcn_ballot_w64(d0 >= 59.0f), br = __builtin_amdgcn_ballot_w64(d0 <= 0.0f);
                if (bl == ~0ull) {
                    kd = slope2 * d0;
#pragma unroll
                    for (int kh = 0; kh < 2; ++kh)
#pragma unroll
                        for (int i = 0; i < 16; ++i) S[kh][i] = S[kh][i] + slope2 * (float)(kh * 32 + (i & 3) + 8 * (i >> 2));
                } else if (br == ~0ull) {
                    kd = -slope2 * d0;
#pragma unroll
                    for (int kh = 0; kh < 2; ++kh)
#pragma unroll
                        for (int i = 0; i < 16; ++i) S[kh][i] = S[kh][i] - slope2 * (float)(kh * 32 + (i & 3) + 8 * (i >> 2));
                } else {
#pragma unroll
                    for (int kh = 0; kh < 2; ++kh)
#pragma unroll
                        for (int i = 0; i < 16; ++i) S[kh][i] -= slope2 * fabsf(d0 - (float)(kh * 32 + (i & 3) + 8 * (i >> 2)));
                }
            }
            float mx = __builtin_elementwise_maximum(S[0][0], S[1][0]);
#pragma unroll
            for (int i = 1; i < 16; ++i) mx = __builtin_elementwise_maximum(mx, __builtin_elementwise_maximum(S[0][i], S[1][i]));
            mx -= kd;
            { const auto sw = __builtin_amdgcn_permlane32_swap(__float_as_uint(mx), __float_as_uint(mx), false, false); mx = __builtin_elementwise_maximum(__uint_as_float(sw[0]), __uint_as_float(sw[1])); }
            float mref = mrun[qt] + kd;
            const float rel = mx - mrun[qt];
            const bool dead = DIFF && !first && (__builtin_amdgcn_ballot_w64(rel < -160.0f) == ~0ull);
            if (!dead) {
            const bool need = (rel > 8.0f) || (first && rel < -8.0f);
            if (__builtin_amdgcn_ballot_w64(need) != 0ull) {
                const float delta = need ? rel : 0.f;
                const float alpha = first ? 1.0f : __builtin_amdgcn_exp2f(-delta);
                mrun[qt] += delta; mref += delta;
                lsum[qt] *= alpha;
#pragma unroll
                for (int d = 0; d < 2; ++d)
#pragma unroll
                    for (int i = 0; i < 16; ++i) O[qt][d][i] *= alpha;
            }
            float ps = 0.f;
            if (__builtin_amdgcn_ballot_w64(mref != 0.f) != 0ull) {
#pragma unroll
                for (int kh = 0; kh < 2; ++kh)
#pragma unroll
                    for (int i = 0; i < 16; ++i) { const float pv = __builtin_amdgcn_exp2f(S[kh][i] - mref); S[kh][i] = pv; ps += pv; }
            } else {
#pragma unroll
                for (int kh = 0; kh < 2; ++kh)
#pragma unroll
                    for (int i = 0; i < 16; ++i) { const float pv = __builtin_amdgcn_exp2f(S[kh][i]); S[kh][i] = pv; ps += pv; }
            }
            lsum[qt] += ps;
#pragma unroll
            for (int kh = 0; kh < 2; ++kh)
#pragma unroll
                for (int s2 = 0; s2 < 2; ++s2) {
                    u32x4 w;
                    w.x = pk2(S[kh][8 * s2 + 0], S[kh][8 * s2 + 1]); w.y = pk2(S[kh][8 * s2 + 2], S[kh][8 * s2 + 3]);
                    w.z = pk2(S[kh][8 * s2 + 4], S[kh][8 * s2 + 5]); w.w = pk2(S[kh][8 * s2 + 6], S[kh][8 * s2 + 7]);
                    pf[kh][s2] = __builtin_bit_cast(bf16x8, w);
                }
#pragma unroll
            for (int kh = 0; kh < 2; ++kh)
#pragma unroll
                for (int s2 = 0; s2 < 2; ++s2)
#pragma unroll
                    for (int d = 0; d < 2; ++d) {
                        if (MODE != 0) {
                            const unsigned char* va = cur + (d ? vfo1 : vfo0) + (kh * 32 + 16 * s2) * 128;
                            const s16x4 lo = __builtin_amdgcn_ds_read_tr16_b64_v4i16((__attribute__((address_space(3))) s16x4*)(va));
                            const s16x4 hi = __builtin_amdgcn_ds_read_tr16_b64_v4i16((__attribute__((address_space(3))) s16x4*)(va + 8 * 128));
                            vfr[kh][s2][d] = __builtin_shufflevector(lo, hi, 0, 1, 2, 3, 4, 5, 6, 7);
                        }
                        O[qt][d] = __builtin_amdgcn_mfma_f32_32x32x16_bf16(vfr[kh][s2][d], pf[kh][s2], O[qt][d], 0, 0, 0);
                    }
            }
            if (DIFF) __builtin_amdgcn_sched_barrier(0);
        }
}

template <int DQK, int MODE>
DI void attn_unit(const bf16_t* __restrict__ Qg, const bf16_t* __restrict__ Kg, const bf16_t* __restrict__ Vg, int q0, bf16_t* __restrict__ outp,
                  float slope2, float lam, float outmul, const float* __restrict__ subln, unsigned char* smem, int wv) {
    constexpr bool DIFF = (MODE == 1);
    constexpr int NQT = MODE ? 2 : 1, QW = (MODE == 2) ? 64 : 32, KS = DIFF ? 2 : DQK / 16, KSTR = DQK * 2 + 16, CPR = DQK / 8, KCH = (64 * CPR + NTHR - 1) / NTHR, KBYTES = 64 * 208;
    const int tid = tid_opaque(wv), lane = tid & 63, wid = tid >> 6, r = lane & 31, h = lane >> 5;
    const int qrow = q0 + wid * QW + r;
    bf16x8 qf[NQT][KS];
#pragma unroll
    for (int qt = 0; qt < NQT; ++qt)
#pragma unroll
        for (int ks = 0; ks < KS; ++ks) qf[qt][ks] = *(const bf16x8*)(Qg + (size_t)(qrow + (MODE == 2 ? 32 * qt : 0)) * DQK + (DIFF ? qt * 32 : 0) + ks * 16 + h * 8);
    f32x16 O[NQT][2];
    float mrun[NQT], lsum[NQT];
#pragma unroll
    for (int qt = 0; qt < NQT; ++qt) {
        mrun[qt] = 0.f; lsum[qt] = 0.f;
#pragma unroll
        for (int d = 0; d < 2; ++d)
#pragma unroll
            for (int i = 0; i < 16; ++i) O[qt][d][i] = 0.f;
    }
    int koff[KCH], voff;
    bool kval[KCH];
#pragma unroll
    for (int i = 0; i < KCH; ++i) { const int id = tid + NTHR * i, key = id / CPR, c = id % CPR; koff[i] = key * KSTR + c * 16; kval[i] = id < 64 * CPR; }
    { const int key = tid >> 3, c = tid & 7; voff = KBYTES + key * 128 + ((c ^ (((key >> 1) & 1) << 2)) * 16); }
    const int c0 = DIFF ? (q0 >> 6) : 0;
#define ORD(I) (DIFF ? (((I) < SEQ / 64 - c0) ? c0 + (I) : SEQ / 64 - 1 - (I)) : (I))
    u32x4 rk[KCH], rv;
#pragma unroll
    for (int i = 0; i < KCH; ++i) if (kval[i]) rk[i] = *(const u32x4*)(Kg + (size_t)c0 * 64 * DQK + (size_t)(tid + NTHR * i) * 8);
    rv = *(const u32x4*)(Vg + (size_t)c0 * 64 * 64 + (size_t)tid * 8);
#pragma unroll
    for (int i = 0; i < KCH; ++i) if (kval[i]) *(u32x4*)(smem + koff[i]) = rk[i];
    *(u32x4*)(smem + voff) = rv;
    __syncthreads();
    const int kfo = r * KSTR + h * 16;
    const int qq = (lane >> 2) & 3;
    const int colb0 = ((qq >> 1) & 1) * 64 + 32 * ((lane >> 4) & 1) + 8 * (lane & 3);
    const int vfo0 = KBYTES + (4 * h + qq) * 128 + colb0, vfo1 = KBYTES + (4 * h + qq) * 128 + (colb0 ^ 64);
    const float qpos = (float)qrow;

    u32x4 rk2[KCH], rv2;
#define AT_LOAD(RK, RV, T) { const int ti_ = (T) < SEQ / 64 ? (T) : SEQ / 64 - 1; const int tn_ = ORD(ti_); _Pragma("unroll") for (int i = 0; i < KCH; ++i) RK[i] = *(const u32x4*)(Kg + (size_t)tn_ * 64 * DQK + (size_t)(kval[i] ? tid + NTHR * i : tid) * 8);     RV = *(const u32x4*)(Vg + (size_t)tn_ * 64 * 64 + (size_t)tid * 8); }
#define AT_WRITE(RK, RV, SO) { _Pragma("unroll") for (int i = 0; i < KCH; ++i) if (kval[i]) *(u32x4*)(smem + (SO) + koff[i]) = RK[i]; *(u32x4*)(smem + (SO) + voff) = RV; }
    AT_LOAD(rk2, rv2, 1);
    for (int kt = 0; kt < SEQ / 64; kt += 2) {
        AT_LOAD(rk, rv, kt + 2);
        attn_tile<DQK, MODE>(smem, ORD(kt), kt == 0, O, mrun, lsum, qf, kfo, vfo0, vfo1, qpos, slope2, h);
        AT_WRITE(rk2, rv2, ATT_STAGE);
        __syncthreads();
        AT_LOAD(rk2, rv2, kt + 3);
        attn_tile<DQK, MODE>(smem + ATT_STAGE, ORD(kt + 1), false, O, mrun, lsum, qf, kfo, vfo0, vfo1, qpos, slope2, h);
        AT_WRITE(rk, rv, 0);
        __syncthreads();
    }
#undef AT_LOAD
#undef AT_WRITE
#undef ORD
    const int tid2 = tid_opaque(wv), lane2 = tid2 & 63;
    const int h2 = lane2 >> 5;
    float inv[NQT];
#pragma unroll
    for (int qt = 0; qt < NQT; ++qt) { const float lt = lsum[qt] + shflx(lsum[qt], 32, lane2); inv[qt] = 1.0f / lt; }
    if (MODE == 2) {
#pragma unroll
        for (int qt = 0; qt < NQT; ++qt) {
            const int qrow2 = q0 + ((tid2 >> 6) * QW) + 32 * qt + (lane2 & 31);
            bf16_t* orow = outp + (size_t)qrow2 * XLD;
#pragma unroll
            for (int d = 0; d < 2; ++d)
#pragma unroll
                for (int g = 0; g < 4; ++g) {
                    u32x2 w; w.x = pk2(O[qt][d][4 * g] * inv[qt], O[qt][d][4 * g + 1] * inv[qt]); w.y = pk2(O[qt][d][4 * g + 2] * inv[qt], O[qt][d][4 * g + 3] * inv[qt]);
                    *(u32x2*)(orow + d * 32 + 8 * g + 4 * h2) = w;
                }
        }
        return;
    }
    float o[2][16];
    if (DIFF) {
        float ss = 0.f;
#pragma unroll
        for (int d = 0; d < 2; ++d)
#pragma unroll
            for (int i = 0; i < 16; ++i) { const float x = O[0][d][i] * inv[0] - lam * (O[NQT - 1][d][i] * inv[NQT - 1]); o[d][i] = x; ss += x * x; }
        ss += shflx(ss, 32, lane2);
        const float rstd = rsqrtf(ss * (1.0f / 64.0f) + EPS) * outmul;
#pragma unroll
        for (int d = 0; d < 2; ++d)
#pragma unroll
            for (int i = 0; i < 16; ++i) o[d][i] *= rstd * subln[d * 32 + (i & 3) + 8 * (i >> 2) + 4 * h2];
    } else {
#pragma unroll
        for (int d = 0; d < 2; ++d)
#pragma unroll
            for (int i = 0; i < 16; ++i) o[d][i] = O[0][d][i] * inv[0];
    }
    const int qrow2 = q0 + (lane2 & 31) + ((tid2 >> 6) << 5);
    bf16_t* orow = outp + (size_t)qrow2 * XLD;
#pragma unroll
    for (int d = 0; d < 2; ++d)
#pragma unroll
        for (int g = 0; g < 4; ++g) {
            u32x2 w; w.x = pk2(o[d][4 * g], o[d][4 * g + 1]); w.y = pk2(o[d][4 * g + 2], o[d][4 * g + 3]);
            *(u32x2*)(orow + d * 32 + 8 * g + 4 * h2) = w;
        }
}

DI void attn_phase(const Params& p, int layer, float lam_init, float outmul, unsigned char* smem, int wv) {
    unsigned char* ws = p.ws;
    const bf16_t *QA = (const bf16_t*)(ws + OFF_QA), *KA = (const bf16_t*)(ws + OFF_KA), *VA = (const bf16_t*)(ws + OFF_VA), *QB = (const bf16_t*)(ws + OFF_QB),
                 *KB = (const bf16_t*)(ws + OFF_KB), *VB = (const bf16_t*)(ws + OFF_VB), *QC = (const bf16_t*)(ws + OFF_QC), *KC = (const bf16_t*)(ws + OFF_KC),
                 *VC = (const bf16_t*)(ws + OFF_VC);
    bf16_t* MIX = (bf16_t*)(ws + OFF_MIX);
    float s1 = 0.f, s2 = 0.f;
    for (int j = 0; j < 32; ++j) { s1 += p.lq1[layer * 32 + j] * p.lk1[layer * 32 + j]; s2 += p.lq2[layer * 32 + j] * p.lk2[layer * 32 + j]; }
    const float lam = __int_as_float(__builtin_amdgcn_readfirstlane(__float_as_int(expf(s1) - expf(s2) + lam_init)));
    for (int v = bid_opaque(); v < 1536; v += gridDim.x) {
        const int base = v & ~255, i = v & 255, j = i >> 3;
        const int u = base + ((i & 7) * 2 + (j >> 4)) * 16 + (j & 15);
        if (u < 512) {
            const int qb = u & 15, hh = (u >> 4) & 3, b = u >> 6;
            const size_t ro = (size_t)(b * 4 + hh) * SEQ * 64;
            const float slope2 = __int_as_float(__builtin_amdgcn_readfirstlane(__float_as_int(exp2f(-2.0f * (float)(hh + 1)) * LOG2E)));
            attn_unit<64, 1>(QC + ro, KC + ro, VC + ro, qb * 256, MIX + (size_t)b * SEQ * XLD + 768 + hh * 64, slope2, lam, outmul,
                             p.subln + layer * 64, smem, wv);
        } else if (u < 1024) {
            const int w = u - 512, qb = w & 15, hh = (w >> 4) & 3, b = w >> 6;
            const size_t rq = (size_t)(b * 4 + hh) * SEQ;
            attn_unit<96, 0>(QB + rq * 96, KB + rq * 96, VB + rq * 64, qb * 256, MIX + (size_t)b * SEQ * XLD + 512 + hh * 64, 0.f, 0.f, 0.f, nullptr, smem, wv);
        } else {
            const int w = u - 1024, qb = w & 7, hh = (w >> 3) & 7, b = w >> 6;
            const size_t rq = (size_t)(b * 8 + hh) * SEQ, rk = (size_t)(b * 2 + (hh >> 2)) * SEQ;
            attn_unit<64, 2>(QA + rq * 64, KA + rk * 64, VA + rk * 64, qb * 512, MIX + (size_t)b * SEQ * XLD + hh * 64, 0.f, 0.f, 0.f, nullptr, smem, wv);
        }
    }
}

#define GB_XCNT(j) (64 * (j))
#define GB_XSUB(j) (1024 + 64 * (j))
#define GB_XGEN(j) (2048 + 64 * (j))
#define GB_TOP 3072
#define GB_TOPGEN 3136
constexpr int GB_WORDS = 3200;
DI unsigned gb_ld(unsigned* p) { return __hip_atomic_load(p, __ATOMIC_RELAXED, __HIP_MEMORY_SCOPE_AGENT); }
DI unsigned gb_add(unsigned* p) { return __hip_atomic_fetch_add(p, 1u, __ATOMIC_RELAXED, __HIP_MEMORY_SCOPE_AGENT); }
DI unsigned gb_xcc() { return (unsigned)__builtin_amdgcn_s_getreg((3 << 11) | 20) & 0xFu; }
#define GB_SPIN(cond) { unsigned sp_ = 0; while (cond) { __builtin_amdgcn_s_sleep(1); if (++sp_ > (1u << 24)) break; } }
DI void grid_bar(unsigned* bar, unsigned x, unsigned nloc, unsigned nx, unsigned& ep, int wv) {
    asm volatile("s_waitcnt vmcnt(0)" ::: "memory");
    __syncthreads();
    asm volatile("" : "+s"(nloc), "+s"(nx), "+s"(x));
    unsigned epl = ep; asm volatile("" : "+s"(epl));
    if (tid_opaque(wv) == 0) {
        const unsigned old = gb_add(&bar[GB_XSUB(x)]);
        if (old + 1u == (epl + 1u) * nloc) {
            __builtin_amdgcn_fence(__ATOMIC_RELEASE, "agent");
            asm volatile("s_waitcnt vmcnt(0)" ::: "memory");
            const unsigned og = gb_add(&bar[GB_TOP]);
            if (og + 1u == (epl + 1u) * nx) gb_add(&bar[GB_TOPGEN]);
            else GB_SPIN(gb_ld(&bar[GB_TOPGEN]) == epl);
            __builtin_amdgcn_fence(__ATOMIC_ACQUIRE, "agent");
            gb_add(&bar[GB_XGEN(x)]);
            asm volatile("s_waitcnt vmcnt(0)" ::: "memory");
        } else {
            GB_SPIN(gb_ld(&bar[GB_XGEN(x)]) == epl);
            __builtin_amdgcn_fence(__ATOMIC_ACQUIRE, "agent");
            asm volatile("s_waitcnt vmcnt(0)" ::: "memory");
        }
    }
    ep += 1u;
    __syncthreads();
}

__global__ void __launch_bounds__(NTHR, 2) mega(Params p) {
    extern __shared__ __attribute__((aligned(16))) unsigned char smem[];
    cg::grid_group grid = cg::this_grid();
    unsigned char* ws = p.ws;
    const int gtid = blockIdx.x * NTHR + threadIdx.x, gthreads = gridDim.x * NTHR;
    const int wv = __builtin_amdgcn_readfirstlane((int)(threadIdx.x >> 6));
    bf16_t* XB = (bf16_t*)(ws + OFF_XB);
    float* SSX = (float*)(ws + OFF_SSX);
    float* tab = (float*)(ws + OFF_TAB);

    unsigned* bar = (unsigned*)(ws + OFF_BAR);
    const unsigned myx = gb_xcc();
    if (threadIdx.x == 0) gb_add(&bar[GB_XCNT(myx)]);
    for (int l = 0; l < 2; ++l) {
        prep_weight<false>(p.w_in + (size_t)l * 1024 * INW, p.norm_attn + l * 1024, (bf16_t*)(ws + OFF_WIN) + (size_t)l * INWP * XLD, XLD, 1024, INW, INWP, smem, wv);
        prep_weight<false>(p.w_uq + (size_t)l * 192 * 384, p.qan_b + l * 192, (bf16_t*)(ws + OFF_WUQ) + (size_t)l * 512 * 192, 192, 192, 384, 512, smem, wv);
        prep_weight<false>(p.w_ukv + (size_t)l * 128 * 512, p.kvn_b + l * 128, (bf16_t*)(ws + OFF_WUKV) + (size_t)l * 512 * 128, 128, 128, 512, 512, smem, wv);
        prep_weight<false>(p.w_out + (size_t)l * 1024 * 1024, nullptr, (bf16_t*)(ws + OFF_WOUT) + (size_t)l * 1024 * XLD, XLD, 1024, 1024, 1024, smem, wv);
        prep_weight<true>(p.w_up + (size_t)l * 1024 * DFF2, p.norm_ffn + l * 1024, (bf16_t*)(ws + OFF_WUP) + (size_t)l * DFF2 * XLD, XLD, 1024, DFF2, DFF2, smem, wv);
        prep_weight<false>(p.w_down + (size_t)l * DFF * 1024, nullptr, (bf16_t*)(ws + OFF_WDN) + (size_t)l * 1024 * ALD, ALD, DFF, 1024, 1024, smem, wv);
    }
    for (int idx = gtid; idx < 1024 + 512; idx += gthreads) {
        if (idx < 1024) { const int pos = idx >> 4, f = idx & 15; const float ang = (float)pos * powf(10000.0f, -(float)f / 16.0f); tab[idx] = cosf(ang); tab[1024 + idx] = sinf(ang); }
        else { const int k = idx - 1024, pos = k >> 3, f = k & 7; const float ang = (float)pos * powf(10000.0f, -(float)f / 8.0f); tab[2048 + k] = cosf(ang); tab[2560 + k] = sinf(ang); }
    }
    convert_x(p.x, XB, SSX, wv);
    grid.sync();

    unsigned nloc = 1u, nx = 0u, ep = 0u;
    for (unsigned j = 0; j < 16; ++j) { const unsigned c = gb_ld(&bar[GB_XCNT(j)]); nx += (c > 0u) ? 1u : 0u; nloc = (j == myx) ? c : nloc; }
    nloc = __builtin_amdgcn_readfirstlane(nloc > 0u ? nloc : 1u); nx = __builtin_amdgcn_readfirstlane(nx > 0u ? nx : 1u);
    for (int l = 0; l < 2; ++l) {
        const float lam_init = __int_as_float(__builtin_amdgcn_readfirstlane(__float_as_int((l == 0) ? 0.2f : 0.35550906759096984f)));
        gemm_phase(XB, XLD, (const bf16_t*)(ws + OFF_WIN) + (size_t)l * INWP * XLD, XLD, 1024, M_TOK, INWP, smem,
                   EpiInProj{SSX, tab, p.qn_a + l * 64, p.kn_a + l * 64, (bf16_t*)(ws + OFF_QA), (bf16_t*)(ws + OFF_KA), (bf16_t*)(ws + OFF_VA), (bf16_t*)(ws + OFF_CQ),
                             (bf16_t*)(ws + OFF_CKV), (bf16_t*)(ws + OFF_KB), (bf16_t*)(ws + OFF_QC), (bf16_t*)(ws + OFF_KC), (bf16_t*)(ws + OFF_VC),
                             (float*)(ws + OFF_SSCQ), (float*)(ws + OFF_SSCKV)}, wv);
        grid_bar(bar, myx, nloc, nx, ep, wv);
        gemm_phase((const bf16_t*)(ws + OFF_CQ), 192, (const bf16_t*)(ws + OFF_WUQ) + (size_t)l * 512 * 192, 192, 192, M_TOK, 512, smem,
                   EpiMlaQ{(bf16_t*)(ws + OFF_QB), tab, (const float*)(ws + OFF_SSCQ), 0.10206207261596575f * LOG2E}, wv);
        gemm_phase((const bf16_t*)(ws + OFF_CKV), 128, (const bf16_t*)(ws + OFF_WUKV) + (size_t)l * 512 * 128, 128, 128, M_TOK, 512, smem,
                   EpiMlaKV{(bf16_t*)(ws + OFF_KB), (bf16_t*)(ws + OFF_VB), (const float*)(ws + OFF_SSCKV)}, wv);
        grid_bar(bar, myx, nloc, nx, ep, wv);
        attn_phase(p, l, lam_init, __int_as_float(__builtin_amdgcn_readfirstlane(__float_as_int((l == 0) ? 0.8f : 0.64449093240903016f))), smem, wv);
        grid_bar(bar, myx, nloc, nx, ep, wv);
        if (l == 0) gemm_phase((const bf16_t*)(ws + OFF_MIX), XLD, (const bf16_t*)(ws + OFF_WOUT) + (size_t)l * 1024 * XLD, XLD, 1024, M_TOK, 1024, smem, EpiResid2<true>{p.x, XB, SSX}, wv);
        else gemm_phase((const bf16_t*)(ws + OFF_MIX), XLD, (const bf16_t*)(ws + OFF_WOUT) + (size_t)l * 1024 * XLD, XLD, 1024, M_TOK, 1024, smem, EpiResid2<false>{nullptr, XB, SSX}, wv);
        grid_bar(bar, myx, nloc, nx, ep, wv);
        up_conv_phase(XB, (const bf16_t*)(ws + OFF_WUP) + (size_t)l * DFF2 * XLD, SSX, p.conv_w + (size_t)l * 3 * DFF2, p.conv_b + (size_t)l * DFF2, (bf16_t*)(ws + OFF_ACT), smem, wv, ws + OFF_BAR + GB_WORDS * 4);
        grid_bar(bar, myx, nloc, nx, ep, wv);
        gemm_phase((const bf16_t*)(ws + OFF_ACT), ALD, (const bf16_t*)(ws + OFF_WDN) + (size_t)l * 1024 * ALD, ALD, DFF, M_TOK, 1024, smem, EpiResid2<false>{nullptr, XB, SSX}, wv);
        grid_bar(bar, myx, nloc, nx, ep, wv);
    }
    final_norm(XB, p.out, p.final_norm, SSX, wv);
}

extern "C" void kernel_launch(void* const* d_in, const int* in_sizes, int n_in, void* d_out, int out_size, void* d_ws, size_t ws_size, hipStream_t stream) {
    static int grid_blocks = 0;
    if (!grid_blocks) {
        int dev = 0, cus = 0, per_cu = 0;
        hipGetDevice(&dev);
        hipDeviceGetAttribute(&cus, hipDeviceAttributeMultiprocessorCount, dev);
        hipFuncSetAttribute((const void*)mega, hipFuncAttributeMaxDynamicSharedMemorySize, SMEM_TOTAL);
        hipOccupancyMaxActiveBlocksPerMultiprocessor(&per_cu, mega, NTHR, SMEM_TOTAL);
        if (per_cu > 1) per_cu = 1;
        if (per_cu < 1) per_cu = 1;
        grid_blocks = (cus * per_cu) & ~7;
    }
    Params p{};
    const float** pp = (const float**)&p;
    for (int i = 0; i < 21; ++i) pp[i] = (const float*)d_in[i];
    p.out = (float*)d_out;
    p.ws = (unsigned char*)d_ws;
    hipMemsetAsync((unsigned char*)d_ws + OFF_BAR, 0, GB_WORDS * 4 + 256, stream);
    void* args[] = {&p};
    hipError_t e = hipLaunchCooperativeKernel((void*)mega, dim3(grid_blocks), dim3(NTHR), args, SMEM_TOTAL, stream);
    if (e != hipSuccess) fprintf(stderr, "cooperative launch failed: %s (grid %d)\n", hipGetErrorString(e), grid_blocks);
}
```
